# Optimizing an MI355X kernel written in HIP

```python
import jax, jax.numpy as jnp
from jax import lax
import numpy as np

D_MODEL = 1024
BATCH = 16
SEQ = 2048
DEPTH = 2

HEAD_DIM = 64
A_HEADS = 6
B_HEADS = 6
C_HEADS = 4
A_WIDTH = A_HEADS * HEAD_DIM
B_WIDTH = B_HEADS * HEAD_DIM
C_WIDTH = C_HEADS * HEAD_DIM
MIX_WIDTH = A_WIDTH + B_WIDTH + C_WIDTH
DECAY_LORA = 64
AAA_LORA = 64
GATE_LORA = 128
VRES_LORA = 32
A_COLS = 3 * A_WIDTH + DECAY_LORA + AAA_LORA + GATE_LORA
B_COLS = 3 * B_WIDTH + B_HEADS
C_COLS = 3 * C_WIDTH
IN_COLS = A_COLS + B_COLS + C_COLS
A_SPLITS = (A_WIDTH, 2 * A_WIDTH, 3 * A_WIDTH, 3 * A_WIDTH + DECAY_LORA, 3 * A_WIDTH + DECAY_LORA + AAA_LORA)
B_SPLITS = (B_WIDTH, 2 * B_WIDTH, 3 * B_WIDTH)
C_SPLITS = (C_WIDTH, 2 * C_WIDTH)
MEM_LEN = 256
MEM_HEADS = 4
MEM_HEAD_DIM = D_MODEL // MEM_HEADS
D_FF = -(-(8 * D_MODEL) // (3 * 256)) * 256
Q_BLOCK = 128
RMS_EPS = 1e-6
GN_EPS = 64e-5
ATTN_SCALE = HEAD_DIM ** -0.5
MEM_SCALE = MEM_HEAD_DIM ** -0.5

kernel_name = "hybrid_rwkv7_fox_stickbreak_block"


def _rmsnorm(x, g):
    xf = x.astype(jnp.float32)
    y = xf * lax.rsqrt(jnp.mean(xf * xf, axis=-1, keepdims=True) + RMS_EPS)
    return (y * g.astype(jnp.float32)).astype(x.dtype)


def _split_heads(z, n_heads):
    b, t, _ = z.shape
    return z.reshape(b, t, n_heads, -1).transpose(0, 2, 1, 3)


def _merge_heads(z):
    b, h, t, d = z.shape
    return z.transpose(0, 2, 1, 3).reshape(b, t, h * d)


def _query_blocks(z):
    b, h, t = z.shape[:3]
    z = z.reshape((b, h, t // Q_BLOCK, Q_BLOCK) + z.shape[3:])
    return jnp.moveaxis(z, 2, 0)


def _unblock(o):
    nb, b, h, q, d = o.shape
    return jnp.moveaxis(o, 0, 2).reshape(b, h, nb * q, d)


def _rwkv7_scan(r, w, k, v, a, b):
    bsz, t, h, n = r.shape
    seq_first = lambda u: jnp.moveaxis(u.astype(jnp.float32), 1, 0)

    def step(S, inp):
        r_t, w_t, k_t, v_t, a_t, b_t = inp
        Sa = jnp.einsum('bhij,bhj->bhi', S, a_t)
        S = S * w_t[:, :, None, :] + Sa[..., None] * b_t[:, :, None, :] + v_t[..., None] * k_t[:, :, None, :]
        return S, jnp.einsum('bhij,bhj->bhi', S, r_t)

    S0 = jnp.zeros((bsz, h, n, n), jnp.float32)
    _, y = lax.scan(step, S0, (seq_first(r), seq_first(w), seq_first(k), seq_first(v), seq_first(a), seq_first(b)))
    return jnp.moveaxis(y, 0, 1)


def _rwkv7_mixer(z, mu, w0, w_up, a0, a_up, g_up, k_k, k_a, r_k, gn_g, gn_b, v_first, vres):
    z_prev = jnp.pad(z[:, :-1], ((0, 0), (1, 0), (0, 0)))
    z = z + (z_prev - z) * mu
    r, k, v, wd, ad, gd = jnp.split(z, A_SPLITS, axis=-1)
    w_log = -jax.nn.softplus(-(w0 + jnp.tanh(wd) @ w_up)) - 0.5
    decay = jnp.exp(-jnp.exp(w_log.astype(jnp.float32)))
    a = jax.nn.sigmoid(a0 + ad @ a_up)
    g = jax.nn.sigmoid(gd) @ g_up
    if vres is None:
        v_first = v
    else:
        v_bias, v_down, v_up = vres
        v = v + (v_first - v) * jax.nn.sigmoid(v_bias + (v @ v_down) @ v_up)
    bsz, t, _ = z.shape
    hs = lambda u: u.reshape(bsz, t, A_HEADS, HEAD_DIM)
    kk = hs(k * k_k).astype(jnp.float32)
    kk = kk * lax.rsqrt(jnp.maximum(jnp.sum(kk * kk, axis=-1, keepdims=True), 1e-24))
    k = k * (1.0 + (a - 1.0) * k_a)
    r4, k4, v4, a4 = hs(r), hs(k), hs(v), hs(a)
    y = _rwkv7_scan(r4, hs(decay), k4, v4, -kk, kk * a4.astype(jnp.float32))
    mean = jnp.mean(y, axis=-1, keepdims=True)
    var = jnp.mean(jnp.square(y - mean), axis=-1, keepdims=True)
    y = ((y - mean) * lax.rsqrt(var + GN_EPS)).reshape(bsz, t, A_WIDTH) * gn_g + gn_b
    bonus = (jnp.sum(r4 * k4 * r_k, axis=-1, keepdims=True) * v4).reshape(bsz, t, A_WIDTH)
    return (y.astype(z.dtype) + bonus) * g, v_first


def _fox_mixer(z, f_bias):
    q, k, v, fl = jnp.split(z, B_SPLITS, axis=-1)
    logf = jax.nn.log_sigmoid((fl + f_bias).astype(jnp.float32))
    c = jnp.cumsum(logf, axis=1).transpose(0, 2, 1)
    q, k, v = (_split_heads(u, B_HEADS) for u in (q, k, v))
    t = q.shape[2]
    k_pos = jnp.arange(t)

    def block(args):
        q_blk, c_blk, blk = args
        s = jnp.einsum('bhqd,bhkd->bhqk', q_blk, k).astype(jnp.float32) * ATTN_SCALE
        s = s + c_blk[..., None] - c[:, :, None, :]
        q_pos = blk * Q_BLOCK + jnp.arange(Q_BLOCK)
        s = jnp.where(k_pos[None, :] <= q_pos[:, None], s, -jnp.inf)
        p = jax.nn.softmax(s, axis=-1)
        return jnp.einsum('bhqk,bhkd->bhqd', p.astype(v.dtype), v)

    o = lax.map(block, (_query_blocks(q), _query_blocks(c), jnp.arange(t // Q_BLOCK)))
    return _merge_heads(_unblock(o))


def _stick_breaking_mixer(z):
    q, k, v = jnp.split(z, C_SPLITS, axis=-1)
    q, k, v = (_split_heads(u, C_HEADS) for u in (q, k, v))
    t = q.shape[2]
    k_pos = jnp.arange(t)

    def block(args):
        q_blk, blk = args
        logits = jnp.einsum('bhqd,bhkd->bhqk', q_blk, k).astype(jnp.float32) * ATTN_SCALE
        q_pos = blk * Q_BLOCK + jnp.arange(Q_BLOCK)
        mask = k_pos[None, :] < q_pos[:, None]
        log_rest = jnp.where(mask, jax.nn.log_sigmoid(-logits), 0.0)
        later = lax.cumsum(log_rest, axis=3, reverse=True) - log_rest
        att = jnp.where(mask, jnp.exp(jax.nn.log_sigmoid(logits) + later), 0.0)
        return jnp.einsum('bhqk,bhkd->bhqd', att.astype(v.dtype), v)

    o = lax.map(block, (_query_blocks(q), jnp.arange(t // Q_BLOCK)))
    return _merge_heads(_unblock(o))


def _memory_attention(h, mem_n, wq, wkv, wo):
    q = _split_heads(h @ wq, MEM_HEADS)
    mk, mv = jnp.split(mem_n @ wkv, 2, axis=-1)
    mk, mv = _split_heads(mk, MEM_HEADS), _split_heads(mv, MEM_HEADS)
    s = jnp.einsum('bhqd,bhkd->bhqk', q, mk).astype(jnp.float32) * MEM_SCALE
    p = jax.nn.softmax(s, axis=-1)
    o = jnp.einsum('bhqk,bhkd->bhqd', p.astype(mv.dtype), mv)
    return _merge_heads(o) @ wo


def setup_inputs(seed: int = 0) -> dict:
    key = jax.random.key(seed)
    keys = iter(jax.random.split(key, 48))
    nrm = lambda shape, scale: jax.random.normal(next(keys), shape, jnp.float32) * scale
    uni = lambda shape, lo, hi: jax.random.uniform(next(keys), shape, jnp.float32, lo, hi)
    gain = lambda shape: 1.0 + nrm(shape, 0.02)
    L, D = DEPTH, D_MODEL
    return {
        "x": nrm((BATCH, SEQ, D), 1.0),
        "mem": nrm((BATCH, MEM_LEN, D), 1.0),
        "norm_mix_pre": gain((L, D)),
        "norm_mix_post": gain((L, D)),
        "w_in": nrm((L, D, IN_COLS), D ** -0.5),
        "shift_mu": uni((L, A_COLS), 0.0, 1.0),
        "rwkv_w0": uni((L, A_WIDTH), -6.5, -1.0),
        "rwkv_w_up": nrm((L, DECAY_LORA, A_WIDTH), 0.1 * DECAY_LORA ** -0.5),
        "rwkv_a0": nrm((L, A_WIDTH), 0.1),
        "rwkv_a_up": nrm((L, AAA_LORA, A_WIDTH), 0.5 * AAA_LORA ** -0.5),
        "rwkv_g_up": nrm((L, GATE_LORA, A_WIDTH), GATE_LORA ** -0.5),
        "rwkv_k_k": 0.85 + nrm((L, A_WIDTH), 0.02),
        "rwkv_k_a": gain((L, A_WIDTH)),
        "rwkv_r_k": -0.04 + nrm((L, A_HEADS, HEAD_DIM), 0.02),
        "rwkv_gn_g": gain((L, A_WIDTH)),
        "rwkv_gn_b": nrm((L, A_WIDTH), 0.02),
        "vres_bias": 1.0 + nrm((L - 1, A_WIDTH), 0.1),
        "vres_down": nrm((L - 1, A_WIDTH, VRES_LORA), A_WIDTH ** -0.5),
        "vres_up": nrm((L - 1, VRES_LORA, A_WIDTH), 0.5 * VRES_LORA ** -0.5),
        "fox_f_bias": uni((L, B_HEADS), 1.0, 4.0),
        "w_out": nrm((L, MIX_WIDTH, D), MIX_WIDTH ** -0.5),
        "norm_mem_pre": gain((L, D)),
        "norm_mem_post": gain((L, D)),
        "norm_mem_kv": gain((L, D)),
        "mem_wq": nrm((L, D, D), D ** -0.5),
        "mem_wkv": nrm((L, D, 2 * D), D ** -0.5),
        "mem_wo": nrm((L, D, D), D ** -0.5),
        "norm_ffn_pre": gain((L, D)),
        "norm_ffn_post": gain((L, D)),
        "ffn_w_gu": nrm((L, D, 2 * D_FF), D ** -0.5),
        "ffn_w_down": nrm((L, D_FF, D), D_FF ** -0.5),
    }


def reference(x, mem, norm_mix_pre, norm_mix_post, w_in, shift_mu, rwkv_w0, rwkv_w_up, rwkv_a0, rwkv_a_up,
              rwkv_g_up, rwkv_k_k, rwkv_k_a, rwkv_r_k, rwkv_gn_g, rwkv_gn_b, vres_bias, vres_down, vres_up,
              fox_f_bias, w_out, norm_mem_pre, norm_mem_post, norm_mem_kv, mem_wq, mem_wkv, mem_wo,
              norm_ffn_pre, norm_ffn_post, ffn_w_gu, ffn_w_down):
    v_first = None
    for l in range(DEPTH):
        h = _rmsnorm(x, norm_mix_pre[l])
        z_a, z_b, z_c = jnp.split(h @ w_in[l], (A_COLS, A_COLS + B_COLS), axis=-1)
        vres = None if l == 0 else (vres_bias[l - 1], vres_down[l - 1], vres_up[l - 1])
        y_a, v_first = _rwkv7_mixer(z_a, shift_mu[l], rwkv_w0[l], rwkv_w_up[l], rwkv_a0[l], rwkv_a_up[l],
                                    rwkv_g_up[l], rwkv_k_k[l], rwkv_k_a[l], rwkv_r_k[l], rwkv_gn_g[l],
                                    rwkv_gn_b[l], v_first, vres)
        y_b = _fox_mixer(z_b, fox_f_bias[l])
        y_c = _stick_breaking_mixer(z_c)
        mixed = jnp.concatenate([y_a, y_b, y_c], axis=-1) @ w_out[l]
        x = x + _rmsnorm(mixed, norm_mix_post[l])
        h = _rmsnorm(x, norm_mem_pre[l])
        mem_n = _rmsnorm(mem, norm_mem_kv[l])
        x = x + _rmsnorm(_memory_attention(h, mem_n, mem_wq[l], mem_wkv[l], mem_wo[l]), norm_mem_post[l])
        h = _rmsnorm(x, norm_ffn_pre[l])
        gate, up = jnp.split(h @ ffn_w_gu[l], 2, axis=-1)
        x = x + _rmsnorm((jax.nn.silu(gate) * up) @ ffn_w_down[l], norm_ffn_post[l])
    return x
```

```cpp
#include <hip/hip_runtime.h>
#include <hip/hip_cooperative_groups.h>
#include <cstdio>
#include <cstdint>
namespace cg = cooperative_groups;
__device__ __forceinline__ int fresh_tid() { int t = threadIdx.x; asm volatile("" : "+v"(t)); return t; }
__device__ __forceinline__ int fresh_s(int v) { asm volatile("" : "+s"(v)); return v; }
namespace pg8 {
#define PG8_LAS __attribute__((address_space(3)))
typedef unsigned short bf16_t;
typedef short bf16x8 __attribute__((ext_vector_type(8)));
typedef float f32x4 __attribute__((ext_vector_type(4)));
typedef unsigned u32x4 __attribute__((ext_vector_type(4)));
constexpr int BM = 256, BK = 64, HALF = 128, HTB = HALF * BK * 2  , STAGE_BYTES = 8 * HTB, NXCD = 8, WGM = 8;

__host__ __device__ __forceinline__ int lds_byte(int r, int c) { const int st = (r >> 4) * 2 + (c >> 5), rr = r & 15, cc = c & 31, ob = rr * 64 + cc * 2; return st * 1024 + (ob ^ (((ob >> 9) & 1) << 5)); }
__host__ __device__ __forceinline__ void stage_rc(int b, int& R, int& C) { const int st = b / 1024, sb = b % 1024, swz = sb ^ (((sb >> 9) & 1) << 5); R = (st >> 1) * 16 + swz / 64; C = (st & 1) * 32 + (swz % 64) / 2; }
__host__ __device__ __forceinline__ int perm32(int rho) { const int n = rho >> 4, i = rho & 15; return 8 * (i >> 2) + 4 * n + (i & 3); }

struct Unit { int pm, pn; };
struct Gemm { const bf16_t* A; const bf16_t* Bt; int M, N, K; int lda; int s1, d1, s2, d2; };

struct StaticOrder {
    int nM, nN, nwg, G, c;
    __host__ __device__ void init(int M, int N, int G_, int c_) { nM = M / BM; nN = N / BM; nwg = nM * nN; G = G_; c = c_; }
    __host__ __device__ bool next(int i, Unit& u) const {
        const long L = (long)i * G + c; if (L >= nwg) return false;
        int wgid = (int)L; { const int q = nwg / NXCD, r = nwg % NXCD, xcd = wgid % NXCD, off = wgid / NXCD; wgid = (xcd < r ? xcd * (q + 1) : r * (q + 1) + (xcd - r) * q) + off; }
        const int nig = WGM * nN, gid = wgid / nig, fm = gid * WGM, gsz = (nM - fm) < WGM ? (nM - fm) : WGM;
        u.pm = fm + ((wgid % nig) % gsz); u.pn = (wgid % nig) / gsz; return true;
    }
    __device__ __forceinline__ void a_ready(const Unit&) const {}
    __device__ __forceinline__ void done(const Unit&) const {}
};

__device__ __forceinline__ unsigned cvt_pk_bf16(float lo, float hi) { unsigned r; asm("v_cvt_pk_bf16_f32 %0, %1, %2" : "=v"(r) : "v"(lo), "v"(hi)); return r; }
typedef float f32x2 __attribute__((ext_vector_type(2)));
template <class Epi, class Sched, bool ALIGN_EPI = false, bool SP2 = false>
__device__ __forceinline__ void gemm_phase(PG8_LAS unsigned char* lds, const Gemm g, const Sched& S, const Epi& E) {
    static_assert(SP2, "only the SP2 loop carries the lda / segment changes");
    const int tid = fresh_tid(), wid = __builtin_amdgcn_readfirstlane(tid >> 6), lane = tid & 63, wr = wid >> 2, wc = wid & 3, fr = lane & 15, fq = lane >> 4;
    const int K = g.K, nt = K / BK;
    unsigned voffA[2], voffB[2];
#pragma unroll
    for (int i = 0; i < 2; ++i) { int R, C; stage_rc(tid * 16 + i * 8192, R, C); const int Rb = Epi::PERM ? ((R & ~31) + perm32(R & 31)) : R;
        voffA[i] = (unsigned)(R * g.lda + C) * 2u; voffB[i] = (unsigned)(Rb * K + C) * 2u; }
    const size_t kstep = (size_t)(BK * 2);
    const size_t hstep = (size_t)HALF * K * 2, hstepA = (size_t)HALF * g.lda * 2;
    const size_t tstep = 2 * hstep, tstepA = 2 * hstepA;
#define PG8_KA(t) ((size_t)(t) * 128 + ((t) >= g.s1 ? (size_t)g.d1 : 0) + ((t) >= g.s2 ? (size_t)g.d2 : 0))
    const unsigned ldsw = (unsigned)wid * 1024u;
    const int aoff = lds_byte(wr * 64 + fr, fq * 8), boff = lds_byte(wc * 32 + fr, fq * 8);
#define PG8_SA(b, h) (((b) * 2 + (h)) * HTB)
#define PG8_SB(b, h) ((4 + (b) * 2 + (h)) * HTB)
#define PG8_STAGE(bufoff, gbase, voff) do { _Pragma("unroll") for (int _i = 0; _i < 2; ++_i) \
        __builtin_amdgcn_global_load_lds((const unsigned*)((const char*)(gbase) + (voff)[_i]), (PG8_LAS unsigned*)(lds + (bufoff) + ldsw + _i * 8192), 16, 0, 0); } while (0)
#define PG8_LDA(dst, b, h) do { _Pragma("unroll") for (int m = 0; m < 4; ++m) _Pragma("unroll") for (int k = 0; k < 2; ++k) dst[m][k] = *(const PG8_LAS bf16x8*)(lds + PG8_SA(b, h) + aoff + m * 2048 + k * 1024); } while (0)
#define PG8_LDB(dst, b, h) do { _Pragma("unroll") for (int n = 0; n < 2; ++n) _Pragma("unroll") for (int k = 0; k < 2; ++k) dst[n][k] = *(const PG8_LAS bf16x8*)(lds + PG8_SB(b, h) + boff + n * 2048 + k * 1024); } while (0)
#define PG8_MMA(ai, bj, At, Bt) do { __builtin_amdgcn_s_setprio(1); _Pragma("unroll") for (int m = 0; m < 4; ++m) _Pragma("unroll") for (int n = 0; n < 2; ++n) _Pragma("unroll") for (int k = 0; k < 2; ++k) \
        acc[ai][bj][m][n] = __builtin_amdgcn_mfma_f32_16x16x32_bf16(Bt[n][k], At[m][k], acc[ai][bj][m][n], 0, 0, 0); __builtin_amdgcn_s_setprio(0); } while (0)
#define PG8_WAIT_V(n) asm volatile("s_waitcnt vmcnt(" #n ")" ::: "memory")
#define PG8_WAIT_L(n) asm volatile("s_waitcnt lgkmcnt(" #n ")" ::: "memory")
#define PG8_BAR __builtin_amdgcn_s_barrier()
#define PG8_SCHED __builtin_amdgcn_sched_barrier(0)
    Unit cur, nxt; int ui = 0;
    if (!S.next(0, cur)) return;
    f32x4 acc[2][2][4][2];
#pragma unroll
    for (int a = 0; a < 2; ++a)
#pragma unroll
        for (int b = 0; b < 2; ++b)
#pragma unroll
            for (int m = 0; m < 4; ++m)
#pragma unroll
                for (int n = 0; n < 2; ++n) acc[a][b][m][n] = (f32x4){0.f, 0.f, 0.f, 0.f};
    bf16x8 At[4][2], B0[2][2], B1[2][2];
    const char* cA = (const char*)g.A + (size_t)cur.pm * tstepA; const char* cB = (const char*)g.Bt + (size_t)cur.pn * tstep;
    S.a_ready(cur);
    if constexpr (SP2) {
        PG8_STAGE(PG8_SB(0, 0), cB, voffB); PG8_STAGE(PG8_SB(0, 1), cB + hstep, voffB); PG8_STAGE(PG8_SA(0, 0), cA, voffA); PG8_STAGE(PG8_SA(0, 1), cA + hstepA, voffA);
        if (wr == 1) PG8_BAR;
        PG8_WAIT_V(2); PG8_BAR;
        PG8_STAGE(PG8_SB(1, 0), cB + kstep, voffB); PG8_STAGE(PG8_SA(1, 0), cA + PG8_KA(1), voffA); PG8_STAGE(PG8_SB(1, 1), cB + hstep + kstep, voffB);
        PG8_WAIT_V(6); PG8_BAR;
    } else {
        PG8_STAGE(PG8_SB(0, 0), cB, voffB); PG8_STAGE(PG8_SA(0, 0), cA, voffA); PG8_STAGE(PG8_SB(0, 1), cB + hstep, voffB); PG8_STAGE(PG8_SA(0, 1), cA + hstep, voffA);
        if (wr == 1) PG8_BAR;
        PG8_WAIT_V(4); PG8_BAR;
        PG8_STAGE(PG8_SB(1, 0), cB + kstep, voffB); PG8_STAGE(PG8_SA(1, 0), cA + kstep, voffA); PG8_STAGE(PG8_SB(1, 1), cB + hstep + kstep, voffB);
        PG8_WAIT_V(6); PG8_BAR;
    }
    for (;;) {
        const bool has_next = S.next(ui + 1, nxt);
        const char* nA = has_next ? (const char*)g.A + (size_t)nxt.pm * tstepA : cA; const char* nB = has_next ? (const char*)g.Bt + (size_t)nxt.pn * tstep : cB;
        for (int t = 0; t < nt; t += 2) {
            const bool last = (t == nt - 2);
            const char* a1 = cA + PG8_KA(t + 1);
            const char* a2 = last ? nA : cA + PG8_KA(t + 2); const char* b2 = last ? nB : cB + (size_t)(t + 2) * kstep;
            const char* a3 = last ? nA + PG8_KA(1) : cA + PG8_KA(t + 3); const char* b3 = b2 + kstep;
            if (last && has_next) S.a_ready(nxt);
            if constexpr (SP2) {
            PG8_LDB(B0, 0, 0); PG8_LDB(B1, 0, 1); PG8_SCHED; PG8_LDA(At, 0, 0); PG8_STAGE(PG8_SA(1, 1), a1 + hstepA, voffA);
            PG8_WAIT_V(8); PG8_WAIT_L(0); PG8_BAR; PG8_MMA(0, 0, At, B0); PG8_MMA(0, 1, At, B1); PG8_BAR; PG8_SCHED;
            PG8_LDA(At, 0, 1); PG8_STAGE(PG8_SB(0, 0), b2, voffB); PG8_STAGE(PG8_SB(0, 1), b2 + hstep, voffB); PG8_STAGE(PG8_SA(0, 0), a2, voffA);
            PG8_WAIT_V(8); PG8_WAIT_L(0); PG8_BAR; PG8_MMA(1, 0, At, B0); PG8_MMA(1, 1, At, B1); PG8_BAR; PG8_SCHED;
            PG8_LDB(B0, 1, 0); PG8_LDB(B1, 1, 1); PG8_SCHED; PG8_LDA(At, 1, 0); PG8_STAGE(PG8_SA(0, 1), a2 + hstepA, voffA);
            PG8_WAIT_V(8); PG8_WAIT_L(0); PG8_BAR; PG8_MMA(0, 0, At, B0); PG8_MMA(0, 1, At, B1); PG8_BAR; PG8_SCHED;
            PG8_LDA(At, 1, 1); PG8_STAGE(PG8_SB(1, 0), b3, voffB); PG8_STAGE(PG8_SB(1, 1), b3 + hstep, voffB); PG8_STAGE(PG8_SA(1, 0), a3, voffA);
            PG8_WAIT_V(8); PG8_WAIT_L(0); PG8_BAR; PG8_MMA(1, 0, At, B0); PG8_MMA(1, 1, At, B1); PG8_BAR; PG8_SCHED;
            } else {
            PG8_LDB(B0, 0, 0); PG8_SCHED; PG8_LDA(At, 0, 0); PG8_STAGE(PG8_SA(1, 1), a1 + hstep, voffA);
            PG8_WAIT_L(8); PG8_BAR; PG8_WAIT_L(0); PG8_MMA(0, 0, At, B0); PG8_BAR; PG8_SCHED;
            PG8_LDB(B1, 0, 1); PG8_STAGE(PG8_SB(0, 0), b2, voffB);
            PG8_BAR; PG8_WAIT_L(0); PG8_MMA(0, 1, At, B1); PG8_BAR;
            PG8_LDA(At, 0, 1); PG8_STAGE(PG8_SA(0, 0), a2, voffA);
            PG8_BAR; PG8_WAIT_L(0); PG8_MMA(1, 0, At, B0); PG8_BAR; PG8_SCHED;
            PG8_STAGE(PG8_SB(0, 1), b2 + hstep, voffB);
            PG8_WAIT_V(6); PG8_BAR; PG8_MMA(1, 1, At, B1); PG8_BAR;
            PG8_LDB(B0, 1, 0); PG8_SCHED; PG8_LDA(At, 1, 0); PG8_STAGE(PG8_SA(0, 1), a2 + hstep, voffA);
            PG8_WAIT_L(8); PG8_BAR; PG8_WAIT_L(0); PG8_MMA(0, 0, At, B0); PG8_BAR; PG8_SCHED;
            PG8_LDB(B1, 1, 1); PG8_STAGE(PG8_SB(1, 0), b3, voffB);
            PG8_BAR; PG8_WAIT_L(0); PG8_MMA(0, 1, At, B1); PG8_BAR;
            PG8_LDA(At, 1, 1); PG8_STAGE(PG8_SA(1, 0), a3, voffA);
            PG8_BAR; PG8_WAIT_L(0); PG8_MMA(1, 0, At, B0); PG8_BAR; PG8_SCHED;
            PG8_STAGE(PG8_SB(1, 1), b3 + hstep, voffB);
            PG8_WAIT_V(6); PG8_BAR; PG8_MMA(1, 1, At, B1); PG8_BAR;
            }
        }
        if constexpr (ALIGN_EPI) { if (wr == 0) PG8_BAR; }
        if constexpr (!Epi::AFTER_DRAIN) { E(acc, cur, wr, wc, fr, fq); S.done(cur); }
        if (!has_next) break;
#pragma unroll
        for (int a = 0; a < 2; ++a)
#pragma unroll
            for (int b = 0; b < 2; ++b)
#pragma unroll
                for (int m = 0; m < 4; ++m)
#pragma unroll
                    for (int n = 0; n < 2; ++n) acc[a][b][m][n] = (f32x4){0.f, 0.f, 0.f, 0.f};
        cur = nxt; cA = nA; cB = nB; ++ui;
        if constexpr (ALIGN_EPI) { if (wr == 1) PG8_BAR; }
    }
    PG8_WAIT_V(0);
    if constexpr (!ALIGN_EPI) { if (wr == 0) PG8_BAR; }
    PG8_BAR;
    if constexpr (Epi::AFTER_DRAIN) { E.fused(acc, cur, wr, wc, fr, fq, lds, wid, lane); S.done(cur); }
#undef PG8_SA
#undef PG8_KA
#undef PG8_SB
#undef PG8_STAGE
#undef PG8_LDA
#undef PG8_LDB
#undef PG8_MMA
#undef PG8_WAIT_V
#undef PG8_WAIT_L
#undef PG8_BAR
#undef PG8_SCHED
}
}

namespace pg8 {
struct EpiBf16 {
    static constexpr bool PERM = true, AFTER_DRAIN = false;
    bf16_t* O; int ldc; float* fl; int flcol;
    __device__ __forceinline__ void operator()(const f32x4 (&acc)[2][2][4][2], const Unit& u, int wr, int wc, int fr, int fq) const {
        const int row0 = u.pm * BM + wr * 64 + fr; const int colt = u.pn * BM; const int col0 = colt + wc * 32 + 8 * fq;
#pragma unroll
        for (int ai = 0; ai < 2; ++ai)
#pragma unroll
            for (int m = 0; m < 4; ++m) { bf16_t* rowp = O + (size_t)(row0 + ai * HALF + m * 16) * ldc + col0;
#pragma unroll
                for (int bj = 0; bj < 2; ++bj) { const f32x4 v0 = acc[ai][bj][m][0], v1 = acc[ai][bj][m][1];
                    u32x4 w; w.x = cvt_pk_bf16(v0[0], v0[1]); w.y = cvt_pk_bf16(v0[2], v0[3]); w.z = cvt_pk_bf16(v1[0], v1[1]); w.w = cvt_pk_bf16(v1[2], v1[3]);
                    *(u32x4*)(rowp + bj * HALF) = w; } }
        if (fl != nullptr && colt == flcol && wc == 0 && fq == 0) {
#pragma unroll
            for (int ai = 0; ai < 2; ++ai)
#pragma unroll
                for (int m = 0; m < 4; ++m) { float* p = fl + (size_t)(row0 + ai * HALF + m * 16) * 8; *(f32x4*)p = acc[ai][0][m][0]; *(f32x4*)(p + 4) = acc[ai][0][m][1]; }
        }
    }
};

struct EpiVT {
    static constexpr bool PERM = true, AFTER_DRAIN = false;
    bf16_t* VT;
    __device__ __forceinline__ void operator()(const f32x4 (&acc)[2][2][4][2], const Unit& u, int wr, int wc, int fr, int fq) const {
        {
            bf16_t* lanebase = VT + (size_t)(u.pm * 4 + u.pn) * 65536 + (size_t)(wc * 32 + 8 * fq) * 256 + wr * 64 + fr;
#pragma unroll
            for (int ai = 0; ai < 2; ++ai)
#pragma unroll
                for (int m = 0; m < 4; ++m) { bf16_t* pk = lanebase + ai * HALF + m * 16; asm volatile("" : "+v"(pk));
#pragma unroll
                    for (int bj = 0; bj < 2; ++bj)
#pragma unroll
                        for (int n = 0; n < 2; ++n) { const int d0 = bj * HALF + 4 * n; const f32x4 v = acc[ai][bj][m][n];
                            const unsigned w0 = cvt_pk_bf16(v[0], v[1]), w1 = cvt_pk_bf16(v[2], v[3]);
                            pk[(d0 + 0) * 256] = (bf16_t)(w0 & 0xffffu); pk[(d0 + 1) * 256] = (bf16_t)(w0 >> 16);
                            pk[(d0 + 2) * 256] = (bf16_t)(w1 & 0xffffu); pk[(d0 + 3) * 256] = (bf16_t)(w1 >> 16); }
                    asm volatile("" ::: "memory"); }
        }
    }
};
struct EpiSwiGLU {
    static constexpr bool PERM = true, AFTER_DRAIN = false;
    bf16_t* O; int ldc;
    __device__ __forceinline__ void operator()(const f32x4 (&acc)[2][2][4][2], const Unit& u, int wr, int wc, int fr, int fq) const {
        const int row0 = u.pm * BM + wr * 64 + fr; const int col0 = u.pn * HALF + wc * 32 + 8 * fq;
#pragma unroll
        for (int ai = 0; ai < 2; ++ai)
#pragma unroll
            for (int m = 0; m < 4; ++m) { bf16_t* rowp = O + (size_t)(row0 + ai * HALF + m * 16) * ldc + col0;
                float h[8];
#pragma unroll
                for (int n = 0; n < 2; ++n)
#pragma unroll
                    for (int i = 0; i < 4; ++i) { const float g = acc[ai][0][m][n][i], up = acc[ai][1][m][n][i]; h[n * 4 + i] = g * __builtin_amdgcn_rcpf(1.0f + __expf(-g)) * up; }
                u32x4 w; w.x = cvt_pk_bf16(h[0], h[1]); w.y = cvt_pk_bf16(h[2], h[3]); w.z = cvt_pk_bf16(h[4], h[5]); w.w = cvt_pk_bf16(h[6], h[7]);
                *(u32x4*)rowp = w; }
    }
};
}

typedef unsigned short bf16_t;
typedef short bf16x8 __attribute__((ext_vector_type(8)));
typedef float f32x4 __attribute__((ext_vector_type(4)));
typedef unsigned u32x4 __attribute__((ext_vector_type(4)));
typedef unsigned u32x2 __attribute__((ext_vector_type(2)));

constexpr int NB = 16, T = 2048, D = 1024, M = NB * T;
constexpr int ZP = 3584;
constexpr int A_COLS = 1408, IN_COLS = 3334, DFF = 2816;
constexpr int MEMR = NB * 256;
constexpr float RMS_EPS = 1e-6f, GN_EPS = 64e-5f;
constexpr float LOG2E = 1.4426950408889634f;
constexpr size_t MiB = 1u << 20;
constexpr size_t WS_CTL = 0, WS_WIN = 1 * MiB, WS_WLORA = 8 * MiB, WS_WOUT = 10 * MiB, WS_WQ = 12 * MiB, WS_WKV = 14 * MiB, WS_WO = 18 * MiB, WS_WGU = 20 * MiB, WS_WDN = 31 * MiB,
                 WS_CBUF = 37 * MiB, WS_FL = 38 * MiB, WS_MKV = 40 * MiB, WS_VFIRST = 56 * MiB, WS_R3 = 80 * MiB, WS_R2 = 144 * MiB, WS_R1 = 240 * MiB, WS_MEMN = 464 * MiB, WS_VFIN = 472 * MiB, WS_GEND = 496 * MiB, WS_SCAL = 502 * MiB, WS_END = 505 * MiB;
constexpr int NTHREADS = 512, NWAVES = 8;
constexpr int LDS_BYTES = 147456;

struct Params { const float* in[31]; float* out; unsigned char* ws; int pad[2]; };

__device__ __forceinline__ float bf2f(bf16_t v) { return __uint_as_float((unsigned)v << 16); }
__device__ __forceinline__ unsigned f2bf(float f) { return pg8::cvt_pk_bf16(f, 0.f) & 0xffffu; }
__device__ __forceinline__ unsigned pk2(float lo, float hi) { return pg8::cvt_pk_bf16(lo, hi); }
__device__ __forceinline__ float lo16(unsigned w) { return __uint_as_float(w << 16); }
__device__ __forceinline__ float hi16(unsigned w) { return __uint_as_float(w & 0xffff0000u); }
#define WS_DPP(x, ctrl) ((x) + __int_as_float(__builtin_amdgcn_update_dpp(0, __float_as_int(x), (ctrl), 0xF, 0xF, true)))
__device__ __forceinline__ float wave_sum(float v) {
    v = WS_DPP(v, 0xB1); v = WS_DPP(v, 0x4E); v = WS_DPP(v, 0x141); v = WS_DPP(v, 0x140);
    const int iv = __float_as_int(v);
    return (__int_as_float(__builtin_amdgcn_readlane(iv, 0)) + __int_as_float(__builtin_amdgcn_readlane(iv, 16))) + (__int_as_float(__builtin_amdgcn_readlane(iv, 32)) + __int_as_float(__builtin_amdgcn_readlane(iv, 48)));
}
__device__ __forceinline__ float sigmoidf_(float x) { return __builtin_amdgcn_rcpf(1.0f + __expf(-x)); }
__device__ __forceinline__ float logsigmoidf_(float x) { return fminf(x, 0.f) - __logf(1.0f + __expf(-fabsf(x))); }

__device__ __forceinline__ int colmap(int mode, int n) {
    if (mode == 1) { if (n < 2560) return n; if (n < 3328) return n + 6; if (n < 3334) return n - 768; return -1; }
    if (mode == 2) { const int tile = n >> 8, w = n & 255; return w < 128 ? tile * 128 + w : DFF + tile * 128 + (w - 128); }
    return n;
}
__device__ __forceinline__ void transpose_item(const float* __restrict__ W, int Nsrc, int K, bf16_t* WT, int nblk, int mode, float* scr, int item, int lane) {
    const int kb = item / nblk, nb = item % nblk, k0 = 64 * kb, n0 = 32 * nb;
    const int src = colmap(mode, n0 + (lane & 31));
#pragma unroll 8
    for (int i = 0; i < 32; ++i) { const int kk = 2 * i + (lane >> 5); scr[kk * 33 + (lane & 31)] = src >= 0 ? W[(size_t)(k0 + kk) * Nsrc + src] : 0.f; }
    asm volatile("s_waitcnt lgkmcnt(0)" ::: "memory");
    const int c = lane & 7;
#pragma unroll
    for (int j = 0; j < 4; ++j) { const int n = (lane >> 3) + 8 * j; const float* s = scr + (8 * c) * 33 + n;
        u32x4 o; o.x = pk2(s[0 * 33], s[1 * 33]); o.y = pk2(s[2 * 33], s[3 * 33]); o.z = pk2(s[4 * 33], s[5 * 33]); o.w = pk2(s[6 * 33], s[7 * 33]);
        *(u32x4*)(WT + (size_t)(n0 + n) * K + k0 + 8 * c) = o; }
    asm volatile("s_waitcnt lgkmcnt(0)" ::: "memory");
}
__device__ __forceinline__ void convert_weights(const Params& p, int l, unsigned char* lds, int gw, int ngw, int lane, int wave) {
    unsigned char* ws = p.ws;
    float* scr = (float*)(lds + wave * 16384);
    constexpr int I_IN = 16 * (ZP / 32), I_SQ = 16 * 32, I_KV = 16 * 64, I_GU = 16 * (2 * DFF / 32), I_DN = (DFF / 64) * 32;
    constexpr int NITEMS = I_IN + 3 * I_SQ + I_KV + I_GU + I_DN;
    for (int it = gw; it < NITEMS; it += ngw) {
        int r = it;
        if (r < I_IN) { transpose_item(p.in[4] + (size_t)l * D * IN_COLS, IN_COLS, D, (bf16_t*)(ws + WS_WIN), ZP / 32, 1, scr, r, lane); continue; } r -= I_IN;
        if (r < I_SQ) { transpose_item(p.in[20] + (size_t)l * D * D, D, D, (bf16_t*)(ws + WS_WOUT), 32, 0, scr, r, lane); continue; } r -= I_SQ;
        if (r < I_SQ) { transpose_item(p.in[24] + (size_t)l * D * D, D, D, (bf16_t*)(ws + WS_WQ), 32, 0, scr, r, lane); continue; } r -= I_SQ;
        if (r < I_SQ) { transpose_item(p.in[26] + (size_t)l * D * D, D, D, (bf16_t*)(ws + WS_WO), 32, 0, scr, r, lane); continue; } r -= I_SQ;
        if (r < I_KV) { transpose_item(p.in[25] + (size_t)l * D * 2 * D, 2 * D, D, (bf16_t*)(ws + WS_WKV), 64, 0, scr, r, lane); continue; } r -= I_KV;
        if (r < I_GU) { transpose_item(p.in[29] + (size_t)l * D * 2 * DFF, 2 * DFF, D, (bf16_t*)(ws + WS_WGU), 2 * DFF / 32, 2, scr, r, lane); continue; } r -= I_GU;
        transpose_item(p.in[30] + (size_t)l * DFF * D, D, DFF, (bf16_t*)(ws + WS_WDN), 32, 0, scr, r, lane);
    }
    const int Kl = l ? 640 : 256, Nl = l ? 1536 : 1280, kch = Kl / 8;
    const float* w_up = p.in[7] + (size_t)l * 64 * 384; const float* a_up = p.in[9] + (size_t)l * 64 * 384; const float* g_up = p.in[10] + (size_t)l * 128 * 384;
    const float* vdn = p.in[17]; const float* vup = p.in[18];
    bf16_t* WL = (bf16_t*)(ws + WS_WLORA);
    for (int ci = gw * 64 + lane; ci < Nl * kch; ci += ngw * 64) {
        const int n = ci / kch, k0 = (ci % kch) * 8; float v[8];
#pragma unroll
        for (int e = 0; e < 8; ++e) { const int k = k0 + e; float x = 0.f;
            if (n < 384) { if (k < 64) x = w_up[k * 384 + n]; }
            else if (n < 768) { if (k >= 64 && k < 128) x = a_up[(k - 64) * 384 + n - 384]; }
            else if (n < 1152) { if (k >= 128 && k < 256) x = g_up[(k - 128) * 384 + n - 768]; }
            else if (n < 1536 && l == 1) { if (k >= 256) { float s = 0.f; for (int r = 0; r < 32; ++r) s += vdn[(k - 256) * 32 + r] * vup[r * 384 + n - 1152]; x = s; } }
            v[e] = x; }
        u32x4 o; o.x = pk2(v[0], v[1]); o.y = pk2(v[2], v[3]); o.z = pk2(v[4], v[5]); o.w = pk2(v[6], v[7]);
        *(u32x4*)(WL + (size_t)n * Kl + k0) = o;
    }
}

template <bool XIB, bool XOB>
__device__ __forceinline__ void norm_rows(int gw, int ngw, int lane, int rows, const void* xin_, const bf16_t* y, const float* gpost, void* xout_, const float* gpre, bf16_t* hout) {
    constexpr int NR = 4;
    const float* xin = (const float*)xin_; const bf16_t* xinb = (const bf16_t*)xin_; float* xout = (float*)xout_; bf16_t* xoutb = (bf16_t*)xout_;
    for (int row0 = gw; row0 < rows; row0 += NR * ngw) {
        int rw[NR]; bool ok[NR];
#pragma unroll
        for (int k = 0; k < NR; ++k) { const int r = row0 + k * ngw; ok[k] = r < rows; rw[k] = ok[k] ? r : row0; }
        f32x4 x[NR][4]; u32x2 yy[NR][4];
#pragma unroll
        for (int k = 0; k < NR; ++k)
#pragma unroll
            for (int j = 0; j < 4; ++j) {
                if (XIB) { const u32x2 w = *(const u32x2*)(xinb + (size_t)rw[k] * D + 256 * j + 4 * lane); x[k][j] = (f32x4){lo16(w.x), hi16(w.x), lo16(w.y), hi16(w.y)}; }
                else x[k][j] = *(const f32x4*)(xin + (size_t)rw[k] * D + 256 * j + 4 * lane); }
        if (y != nullptr) {
#pragma unroll
            for (int k = 0; k < NR; ++k)
#pragma unroll
                for (int j = 0; j < 4; ++j) yy[k][j] = *(const u32x2*)(y + (size_t)rw[k] * D + 256 * j + 4 * lane);
#pragma unroll
            for (int k = 0; k < NR; ++k) {
                f32x4 v[4]; float ss = 0.f;
#pragma unroll
                for (int j = 0; j < 4; ++j) { v[j] = (f32x4){lo16(yy[k][j].x), hi16(yy[k][j].x), lo16(yy[k][j].y), hi16(yy[k][j].y)}; ss += (v[j].x * v[j].x + v[j].y * v[j].y) + (v[j].z * v[j].z + v[j].w * v[j].w); }
                const float r = rsqrtf(wave_sum(ss) * (1.0f / D) + RMS_EPS);
#pragma unroll
                for (int j = 0; j < 4; ++j) { const f32x4 g = *(const f32x4*)(gpost + 256 * j + 4 * lane); x[k][j] = x[k][j] + v[j] * r * g; }
            }
        }
        if (xout_ != nullptr) {
#pragma unroll
            for (int k = 0; k < NR; ++k) if (ok[k]) {
#pragma unroll
                for (int j = 0; j < 4; ++j) {
                    if (XOB) { u32x2 w; w.x = pk2(x[k][j].x, x[k][j].y); w.y = pk2(x[k][j].z, x[k][j].w); *(u32x2*)(xoutb + (size_t)rw[k] * D + 256 * j + 4 * lane) = w; }
                    else *(f32x4*)(xout + (size_t)rw[k] * D + 256 * j + 4 * lane) = x[k][j]; } }
        }
        if (gpre != nullptr) {
#pragma unroll
            for (int k = 0; k < NR; ++k) {
                float ss = 0.f;
#pragma unroll
                for (int j = 0; j < 4; ++j) ss += (x[k][j].x * x[k][j].x + x[k][j].y * x[k][j].y) + (x[k][j].z * x[k][j].z + x[k][j].w * x[k][j].w);
                const float r = rsqrtf(wave_sum(ss) * (1.0f / D) + RMS_EPS);
                if (ok[k]) {
#pragma unroll
                    for (int j = 0; j < 4; ++j) { const f32x4 g = *(const f32x4*)(gpre + 256 * j + 4 * lane); const f32x4 h = x[k][j] * r * g;
                        u32x2 w; w.x = pk2(h.x, h.y); w.y = pk2(h.z, h.w); *(u32x2*)(hout + (size_t)rw[k] * D + 256 * j + 4 * lane) = w; } }
            }
        }
    }
}

__device__ __forceinline__ void rwkv_pre(const Params& p, int l, int gw, int ngw, int lane) {
    const bf16_t* z = (const bf16_t*)(p.ws + WS_R1); bf16_t* lin = (bf16_t*)p.out; bf16_t* vfirst = (bf16_t*)(p.ws + WS_VFIRST);
    const float* mu = p.in[5] + (size_t)l * A_COLS; const int Kl = l ? 640 : 256;
    constexpr int NU = 4; const int nlanes = ngw * 64;
    for (int base = gw * 64 + lane; base < M * 80; base += NU * nlanes) {
        u32x4 zc[NU], zp[NU]; int tokv[NU], chv[NU]; bool okv[NU];
#pragma unroll
        for (int k = 0; k < NU; ++k) { const int idx = base + k * nlanes; okv[k] = idx < M * 80; const int id2 = okv[k] ? idx : base; tokv[k] = id2 / 80; chv[k] = id2 % 80;
            const int col = chv[k] < 48 ? 768 + 8 * chv[k] : 1152 + 8 * (chv[k] - 48);
            zc[k] = *(const u32x4*)(z + (size_t)tokv[k] * ZP + col);
            zp[k] = (u32x4){0u, 0u, 0u, 0u}; if ((tokv[k] % T) > 0) zp[k] = *(const u32x4*)(z + (size_t)(tokv[k] - 1) * ZP + col); }
#pragma unroll
        for (int k = 0; k < NU; ++k) { const int tok = tokv[k], ch = chv[k];
            const int col = ch < 48 ? 768 + 8 * ch : 1152 + 8 * (ch - 48);
            const f32x4 m0 = *(const f32x4*)(mu + col), m1 = *(const f32x4*)(mu + col + 4);
            float s[8];
            { const float c0 = lo16(zc[k].x), c1 = hi16(zc[k].x), c2 = lo16(zc[k].y), c3 = hi16(zc[k].y), c4 = lo16(zc[k].z), c5 = hi16(zc[k].z), c6 = lo16(zc[k].w), c7 = hi16(zc[k].w);
              s[0] = c0 + (lo16(zp[k].x) - c0) * m0.x; s[1] = c1 + (hi16(zp[k].x) - c1) * m0.y; s[2] = c2 + (lo16(zp[k].y) - c2) * m0.z; s[3] = c3 + (hi16(zp[k].y) - c3) * m0.w;
              s[4] = c4 + (lo16(zp[k].z) - c4) * m1.x; s[5] = c5 + (hi16(zp[k].z) - c5) * m1.y; s[6] = c6 + (lo16(zp[k].w) - c6) * m1.z; s[7] = c7 + (hi16(zp[k].w) - c7) * m1.w; }
            bf16_t* dst;
            if (ch < 48) { dst = (l == 0) ? vfirst + (size_t)tok * 384 + 8 * ch : lin + (size_t)tok * Kl + 256 + 8 * ch; }
            else { const int c2 = 8 * (ch - 48); dst = lin + (size_t)tok * Kl + c2;
                if (c2 < 64) {
#pragma unroll
                    for (int e = 0; e < 8; ++e) s[e] = 1.0f - 2.0f * __builtin_amdgcn_rcpf(__expf(2.0f * s[e]) + 1.0f);
                } else if (c2 >= 128) {
#pragma unroll
                    for (int e = 0; e < 8; ++e) s[e] = sigmoidf_(s[e]);
                } }
            u32x4 o; o.x = pk2(s[0], s[1]); o.y = pk2(s[2], s[3]); o.z = pk2(s[4], s[5]); o.w = pk2(s[6], s[7]);
            if (okv[k]) *(u32x4*)dst = o;
        }
    }
    if (gw < 96) {
        const int b = gw / 6, h = gw % 6; const float* fl = (const float*)(p.ws + WS_FL); float* cb = (float*)(p.ws + WS_CBUF) + (size_t)gw * T;
        const float fb = p.in[19][l * 6 + h]; float carry = 0.f;
        for (int i0 = 0; i0 < 32; i0 += 8) {
            float fv[8];
#pragma unroll
            for (int i = 0; i < 8; ++i) fv[i] = fl[(size_t)(b * T + 64 * (i0 + i) + lane) * 8 + h];
#pragma unroll
            for (int i = 0; i < 8; ++i) {
                float v = logsigmoidf_(fv[i] + fb);
#pragma unroll
                for (int o = 1; o < 64; o <<= 1) { const float u = __shfl_up(v, o); if (lane >= o) v += u; }
                v += carry; cb[64 * (i0 + i) + lane] = v * LOG2E; carry = __shfl(v, 63);
            }
        }
    }
}

typedef float f32x2 __attribute__((ext_vector_type(2)));
__device__ __forceinline__ void rwkv_prep2(const Params& p, int l, int gw, int ngw, int lane) {
    const bf16_t* z = (const bf16_t*)(p.ws + WS_R1); bf16_t* lo = (bf16_t*)(p.ws + WS_R2); const bf16_t* vfirst = (const bf16_t*)(p.ws + WS_VFIRST);
    bf16_t* rk = (bf16_t*)p.out; bf16_t* vfin = (bf16_t*)(p.ws + WS_VFIN); float* gend = (float*)(p.ws + WS_GEND); float* scal = (float*)(p.ws + WS_SCAL);
    const int Nl = l ? 1536 : 1280;
    for (int item = gw; item < NB * 256 * 6; item += ngw) {
        const int h = item % 6, bw = item / 6, b = bw >> 8, win = bw & 255; const int hj = h * 64 + lane;
        const float mu_r = p.in[5][l * A_COLS + hj], mu_k = p.in[5][l * A_COLS + 384 + hj], mu_v = p.in[5][l * A_COLS + 768 + hj];
        const float w0 = p.in[6][l * 384 + hj], a0 = p.in[8][l * 384 + hj], k_k = p.in[11][l * 384 + hj], k_a = p.in[12][l * 384 + hj], r_k = p.in[13][l * 384 + hj];
        const float vbias = l ? p.in[16][hj] : 0.f;
        const size_t tok0 = (size_t)b * T + 8 * win;
        float pr = 0.f, pk = 0.f, pv = 0.f;
        if (win > 0) { const bf16_t* zq = z + (tok0 - 1) * ZP; pr = bf2f(zq[hj]); pk = bf2f(zq[384 + hj]); pv = bf2f(zq[768 + hj]); }
        float zr[8], zk[8], zv[8], wl[8], al[8], vl[8], vf[8];
#pragma unroll
        for (int i = 0; i < 8; ++i) { const size_t tok = tok0 + i; const bf16_t* zp_ = z + tok * ZP; const bf16_t* lor = lo + tok * Nl;
            zr[i] = bf2f(zp_[hj]); zk[i] = bf2f(zp_[384 + hj]); zv[i] = bf2f(zp_[768 + hj]); wl[i] = bf2f(lor[hj]); al[i] = bf2f(lor[384 + hj]);
            vl[i] = 0.f; vf[i] = 0.f; if (l) { vl[i] = bf2f(lor[1152 + hj]); vf[i] = bf2f(vfirst[tok * 384 + hj]); } }
        float G = 1.0f;
#pragma unroll
        for (int i = 0; i < 8; ++i) { const size_t tok = tok0 + i;
            const float r = zr[i] + (pr - zr[i]) * mu_r, k = zk[i] + (pk - zk[i]) * mu_k; float v = zv[i] + (pv - zv[i]) * mu_v;
            pr = zr[i]; pk = zk[i]; pv = zv[i];
            if (l) v = v + (vf[i] - v) * sigmoidf_(vbias + vl[i]);
            const float xw = w0 + wl[i];
            const float wlog = -(fmaxf(-xw, 0.f) + __logf(1.0f + __expf(-fabsf(xw)))) - 0.5f;
            const float dec = __expf(-__expf(wlog));
            const float a = sigmoidf_(a0 + al[i]);
            float kk = k * k_k; const float n2 = wave_sum(kk * kk); kk *= rsqrtf(fmaxf(n2, 1e-24f));
            const float k2 = k * (1.0f + (a - 1.0f) * k_a);
            const float bvv = kk * a;
            const float br = wave_sum(bvv * r), kr = wave_sum(k2 * r), bon = wave_sum(r * k2 * r_k);
            const float Gp = G; G = Gp * dec; const float iG = __builtin_amdgcn_rcpf(G);
            lo[tok * Nl + hj] = (bf16_t)f2bf(-kk * Gp); lo[tok * Nl + 384 + hj] = (bf16_t)f2bf(bvv * iG);
            rk[tok * 768 + hj] = (bf16_t)f2bf(r * G); rk[tok * 768 + 384 + hj] = (bf16_t)f2bf(k2 * iG);
            vfin[tok * 384 + hj] = (bf16_t)f2bf(v);
            if (lane == 0) *(f32x4*)(scal + (tok * 6 + h) * 4) = (f32x4){br, kr, bon, 0.f};
        }
        gend[(tok0 >> 3) * 384 + hj] = G;
    }
}

#define DPP_ADD(x, ctrl) ((x) + __int_as_float(__builtin_amdgcn_update_dpp(0, __float_as_int(x), (ctrl), 0xF, 0xF, true)))
__device__ __forceinline__ float red8(float x) { x = DPP_ADD(x, 0xB1); x = DPP_ADD(x, 0x4E); x = DPP_ADD(x, 0x141); return x; }
__device__ __forceinline__ f32x2 fma2(f32x2 a, f32x2 b, f32x2 c) { return __builtin_elementwise_fma(a, b, c); }
#define SCAN_BAR() asm volatile("s_waitcnt vmcnt(0) lgkmcnt(0)\n\ts_barrier" ::: "memory")
#define SCAN_BAR_L() asm volatile("s_waitcnt lgkmcnt(0)\n\ts_barrier" ::: "memory")

__device__ __forceinline__ void scan_unit(const Params& p, int l, int bh, unsigned char* ldsb, int tid, int lane, int wave, bool store) {
    const int b = bh / 6, h = bh % 6;
    constexpr int BUFSZ = 6 * 2048 + 128 + 256;
    float* base = (float*)ldsb; float* Ybase = base + 2 * BUFSZ;
    if (wave < 4) {
        const int rp = tid >> 3, cgp = tid & 7;
        f32x2 Sa0 = {0.f, 0.f}, Sa1 = Sa0, Sa2 = Sa0, Sa3 = Sa0, Sb0 = Sa0, Sb1 = Sa0, Sb2 = Sa0, Sb3 = Sa0;
        SCAN_BAR();
        for (int c = 0; c < T / 32; ++c) {
            const float* buf = base + (c & 1) * BUFSZ; float* Y = Ybase + (c & 1) * 2048;
            const float* AT = buf; const float* RT = buf + 2048; const float* BH = buf + 4096; const float* KH = buf + 6144; const float* Vv = buf + 8192; const float* SC = buf + 12288; const float* GE = buf + 12416;
#define SCAN_LD(X, tt_) do { const int t_ = (tt_) < 32 ? (tt_) : 31; const int o_ = t_ * 64 + 8 * cgp; \
                X##a0 = *(const f32x4*)(AT + o_); X##a1 = *(const f32x4*)(AT + o_ + 4); X##q0 = *(const f32x4*)(RT + o_); X##q1 = *(const f32x4*)(RT + o_ + 4); \
                X##b0 = *(const f32x4*)(BH + o_); X##b1 = *(const f32x4*)(BH + o_ + 4); X##k0 = *(const f32x4*)(KH + o_); X##k1 = *(const f32x4*)(KH + o_ + 4); \
                X##va = Vv[t_ * 64 + rp]; X##vb = Vv[t_ * 64 + rp + 32]; X##br = SC[t_ * 4]; X##kr = SC[t_ * 4 + 1]; } while (0)
#define SCAN_STEP(X, tt_) do { \
                f32x2 t0 = Sa0 * X##a0.xy; t0 = fma2(Sa1, X##a0.zw, t0); t0 = fma2(Sa2, X##a1.xy, t0); t0 = fma2(Sa3, X##a1.zw, t0); \
                f32x2 t1 = Sb0 * X##a0.xy; t1 = fma2(Sb1, X##a0.zw, t1); t1 = fma2(Sb2, X##a1.xy, t1); t1 = fma2(Sb3, X##a1.zw, t1); \
                f32x2 u0 = Sa0 * X##q0.xy; u0 = fma2(Sa1, X##q0.zw, u0); u0 = fma2(Sa2, X##q1.xy, u0); u0 = fma2(Sa3, X##q1.zw, u0); \
                f32x2 u1 = Sb0 * X##q0.xy; u1 = fma2(Sb1, X##q0.zw, u1); u1 = fma2(Sb2, X##q1.xy, u1); u1 = fma2(Sb3, X##q1.zw, u1); \
                const float sa = red8(t0.x + t0.y), sb = red8(t1.x + t1.y), ya = red8(u0.x + u0.y), yb = red8(u1.x + u1.y); \
                const f32x2 sav = {sa, sa}, sbv = {sb, sb}, vav = {X##va, X##va}, vbv = {X##vb, X##vb}; \
                Sa0 = fma2(sav, X##b0.xy, fma2(vav, X##k0.xy, Sa0)); Sa1 = fma2(sav, X##b0.zw, fma2(vav, X##k0.zw, Sa1)); Sa2 = fma2(sav, X##b1.xy, fma2(vav, X##k1.xy, Sa2)); Sa3 = fma2(sav, X##b1.zw, fma2(vav, X##k1.zw, Sa3)); \
                Sb0 = fma2(sbv, X##b0.xy, fma2(vbv, X##k0.xy, Sb0)); Sb1 = fma2(sbv, X##b0.zw, fma2(vbv, X##k0.zw, Sb1)); Sb2 = fma2(sbv, X##b1.xy, fma2(vbv, X##k1.xy, Sb2)); Sb3 = fma2(sbv, X##b1.zw, fma2(vbv, X##k1.zw, Sb3)); \
                const float y0_ = ya + sa * X##br + X##va * X##kr, y1_ = yb + sb * X##br + X##vb * X##kr; \
                if (cgp == 0) { Y[(tt_) * 64 + rp] = y0_; Y[(tt_) * 64 + rp + 32] = y1_; } } while (0)
            f32x4 Pa0, Pa1, Pq0, Pq1, Pb0, Pb1, Pk0, Pk1, Qa0, Qa1, Qq0, Qq1, Qb0, Qb1, Qk0, Qk1; float Pva, Pvb, Pbr, Pkr, Qva, Qvb, Qbr, Qkr;
            SCAN_LD(P, 0);
#pragma unroll 1
            for (int w8 = 0; w8 < 4; ++w8) {
#pragma unroll
                for (int s = 0; s < 8; s += 2) {
                    const int tt = w8 * 8 + s;
                    SCAN_LD(Q, tt + 1); __builtin_amdgcn_sched_barrier(0);
                    SCAN_STEP(P, tt); __builtin_amdgcn_sched_barrier(0);
                    SCAN_LD(P, tt + 2); __builtin_amdgcn_sched_barrier(0);
                    SCAN_STEP(Q, tt + 1); __builtin_amdgcn_sched_barrier(0);
                }
                const f32x4 g0 = *(const f32x4*)(GE + w8 * 64 + 8 * cgp), g1 = *(const f32x4*)(GE + w8 * 64 + 8 * cgp + 4);
                Sa0 *= g0.xy; Sa1 *= g0.zw; Sa2 *= g1.xy; Sa3 *= g1.zw; Sb0 *= g0.xy; Sb1 *= g0.zw; Sb2 *= g1.xy; Sb3 *= g1.zw;
            }
#undef SCAN_LD
#undef SCAN_STEP
            SCAN_BAR();
        }
    } else {
        bf16_t* z = (bf16_t*)(p.ws + WS_R1); const bf16_t* lo = (const bf16_t*)(p.ws + WS_R2); const bf16_t* rk = (const bf16_t*)p.out;
        const bf16_t* vfin = (const bf16_t*)(p.ws + WS_VFIN); const float* gend = (const float*)(p.ws + WS_GEND); const float* scal = (const float*)(p.ws + WS_SCAL);
        const int Nl = l ? 1536 : 1280; const int pw = wave - 4; const int hj = h * 64 + lane;
        const float gn_g = p.in[14][l * 384 + hj], gn_b = p.in[15][l * 384 + hj];
        const int li = lane >> 3, lc = 8 * (lane & 7);
        u32x4 rAT, rBH, rGL, rRT, rKH, rV; float rGE = 0.f; f32x4 rSC = (f32x4){0.f, 0.f, 0.f, 0.f};
#define SCAN_LOAD(c_) do { const int cc = (c_); const size_t tok = (size_t)b * T + 32 * cc + 8 * pw + li; \
            rAT = *(const u32x4*)(lo + tok * Nl + h * 64 + lc); rBH = *(const u32x4*)(lo + tok * Nl + 384 + h * 64 + lc); rGL = *(const u32x4*)(lo + tok * Nl + 768 + h * 64 + lc); \
            rRT = *(const u32x4*)(rk + tok * 768 + h * 64 + lc); rKH = *(const u32x4*)(rk + tok * 768 + 384 + h * 64 + lc); rV = *(const u32x4*)(vfin + tok * 384 + h * 64 + lc); \
            rGE = gend[(((size_t)b * T + 32 * cc + 8 * pw) >> 3) * 384 + hj]; \
            if (lane < 8) rSC = *(const f32x4*)(scal + (((size_t)b * T + 32 * cc + 8 * pw + lane) * 6 + h) * 4); } while (0)
#define SCAN_ST1(arr_, reg_) do { float* d_ = buf + (arr_) + (8 * pw + li) * 64 + lc; \
            *(f32x4*)d_ = (f32x4){lo16(reg_.x), hi16(reg_.x), lo16(reg_.y), hi16(reg_.y)}; *(f32x4*)(d_ + 4) = (f32x4){lo16(reg_.z), hi16(reg_.z), lo16(reg_.w), hi16(reg_.w)}; } while (0)
#define SCAN_STORE(c_) do { const int cc = (c_); float* buf = base + (cc & 1) * BUFSZ; \
            SCAN_ST1(0, rAT); SCAN_ST1(2048, rRT); SCAN_ST1(4096, rBH); SCAN_ST1(6144, rKH); SCAN_ST1(8192, rV); SCAN_ST1(10240, rGL); \
            buf[12416 + pw * 64 + lane] = rGE; if (lane < 8) *(f32x4*)(buf + 12288 + (8 * pw + lane) * 4) = rSC; } while (0)
#define SCAN_POST(c_) do { const int cc = (c_); const float* buf = base + (cc & 1) * BUFSZ; const float* Y = Ybase + (cc & 1) * 2048; \
            _Pragma("unroll") for (int i = 0; i < 8; ++i) { const int tt = 8 * pw + i; const int o = tt * 64 + lane; const float y = Y[o]; \
                const float mean = wave_sum(y) * (1.0f / 64.0f); const float d = y - mean; const float var = wave_sum(d * d) * (1.0f / 64.0f); \
                const float yn = d * rsqrtf(var + GN_EPS) * gn_g + gn_b; \
                const float outv = (yn + buf[12288 + tt * 4 + 2] * buf[8192 + o]) * buf[10240 + o]; \
                if (store) z[((size_t)b * T + 32 * cc + tt) * ZP + hj] = (bf16_t)f2bf(outv); } } while (0)
        SCAN_LOAD(0);
        SCAN_STORE(0);
        SCAN_LOAD(1);
        SCAN_BAR_L();
        for (int c = 0; c < T / 32; ++c) {
            if (c > 0) SCAN_POST(c - 1);
            if (c + 1 < T / 32) SCAN_STORE(c + 1);
            if (c + 2 < T / 32) SCAN_LOAD(c + 2);
            SCAN_BAR_L();
        }
        SCAN_POST(T / 32 - 1);
#undef SCAN_LOAD
#undef SCAN_ST1
#undef SCAN_STORE
#undef SCAN_POST
    }
    __syncthreads();
}

template <int HD, int MODE>
__device__ __forceinline__ void attn_unit(unsigned char* ldsb, const bf16_t* Qg, int qpitch, const bf16_t* Kg, const bf16_t* Vg, int kvpitch, bf16_t* Og, int q0, int nkeys, const float* cseq, float scale,
                                          int tid, int lane, int wave, bool store) {
    constexpr int KP = (HD + 8) * 2;
    constexpr int VP = 72 * 2;
    constexpr int NCH = HD / 64;
    constexpr int NKB = HD / 32, NDT = HD / 16;
    unsigned char* Ks = ldsb; unsigned char* Vts = ldsb + 64 * KP; float* cs = (float*)(Vts + HD * VP);
    const int r16 = lane & 15, fq = lane >> 4;
    const int qrow = q0 + 16 * wave + r16;
    bf16x8 qf[NKB];
#pragma unroll
    for (int kb = 0; kb < NKB; ++kb) qf[kb] = *(const bf16x8*)(Qg + (size_t)qrow * qpitch + 32 * kb + 8 * fq);
    f32x4 o[NDT];
#pragma unroll
    for (int dt = 0; dt < NDT; ++dt) o[dt] = (f32x4){0.f, 0.f, 0.f, 0.f};
    float m_run = -INFINITY, l_part = 0.f, Rtot = 0.f;
    float cq = 0.f; if (MODE == 0) cq = cseq[qrow];
    const int ntiles = (MODE == 2) ? nkeys / 64 : (q0 + 128) / 64;
    u32x4 kreg[NCH], vreg[NCH]; float creg = 0.f;
#define ATT_ISSUE(tt_) do { const int k0_ = (tt_) * 64; \
        _Pragma("unroll") for (int it = 0; it < NCH; ++it) { const int ci = tid + 512 * it; const int row = ci / (HD / 8), ch = ci % (HD / 8); \
            kreg[it] = *(const u32x4*)(Kg + (size_t)(k0_ + row) * kvpitch + 8 * ch); \
            vreg[it] = *(const u32x4*)(Vg + (size_t)((tid >> 3) + 64 * it) * 256 + k0_ + 8 * (tid & 7)); } \
        if (MODE == 0 && tid < 64) creg = cseq[k0_ + tid]; } while (0)
    int t = (MODE == 1) ? ntiles - 1 : 0;
    ATT_ISSUE(t);
    for (int it_ = 0; it_ < ntiles; ++it_) {
        __syncthreads();
#pragma unroll
        for (int it = 0; it < NCH; ++it) { const int ci = tid + 512 * it; const int row = ci / (HD / 8), ch = ci % (HD / 8);
            *(u32x4*)(Ks + row * KP + ch * 16) = kreg[it];
            unsigned char* vp_ = Vts + ((tid >> 3) + 64 * it) * VP + (32 * ((tid & 7) >> 2) + 16 * (tid & 1) + 4 * ((tid >> 1) & 1)) * 2; const u32x4 v = vreg[it];
            *(u32x2*)vp_ = (u32x2){v.x, v.y}; *(u32x2*)(vp_ + 16) = (u32x2){v.z, v.w}; }
        if (MODE == 0 && tid < 64) cs[tid] = creg;
        __syncthreads();
        const int k0 = t * 64;
        const int tn = (MODE == 1) ? t - 1 : t + 1;
        if (it_ + 1 < ntiles) ATT_ISSUE(tn);
        f32x4 s[4];
#pragma unroll
        for (int j = 0; j < 4; ++j) { s[j] = (f32x4){0.f, 0.f, 0.f, 0.f};
#pragma unroll
            for (int kb = 0; kb < NKB; ++kb) { const bf16x8 a = *(const bf16x8*)(Ks + (16 * j + r16) * KP + (32 * kb + 8 * fq) * 2); s[j] = __builtin_amdgcn_mfma_f32_16x16x32_bf16(a, qf[kb], s[j], 0, 0, 0); } }
        if (MODE == 0 || MODE == 2) {
            float tmax = -INFINITY;
#pragma unroll
            for (int j = 0; j < 4; ++j) {
                f32x4 ck = (f32x4){0.f, 0.f, 0.f, 0.f}; if (MODE == 0) ck = *(const f32x4*)(cs + 16 * j + 4 * fq);
#pragma unroll
                for (int i = 0; i < 4; ++i) { float v = s[j][i] * scale; if (MODE == 0) { v += (cq - ck[i]) * LOG2E; if (k0 + 16 * j + 4 * fq + i > qrow) v = -INFINITY; } s[j][i] = v; tmax = fmaxf(tmax, v); } }
            tmax = fmaxf(tmax, __shfl_xor(tmax, 16)); tmax = fmaxf(tmax, __shfl_xor(tmax, 32));
            const float mnew = fmaxf(m_run, tmax); const float alpha = __builtin_amdgcn_exp2f(m_run - mnew); m_run = mnew;
            float ps = 0.f;
#pragma unroll
            for (int j = 0; j < 4; ++j)
#pragma unroll
                for (int i = 0; i < 4; ++i) { const float pv = __builtin_amdgcn_exp2f(s[j][i] - mnew); s[j][i] = pv; ps += pv; }
            l_part = l_part * alpha + ps;
#pragma unroll
            for (int dt = 0; dt < NDT; ++dt) o[dt] = o[dt] * alpha;
        } else {
            float lr[4][4], ls[4][4], g[4];
#pragma unroll
            for (int j = 0; j < 4; ++j) { g[j] = 0.f;
#pragma unroll
                for (int i = 0; i < 4; ++i) { const float lg = s[j][i] * scale; const float lsg = logsigmoidf_(lg); const bool valid = (k0 + 16 * j + 4 * fq + i) < qrow;
                    ls[j][i] = lsg; lr[j][i] = valid ? lsg - lg : 0.f; g[j] += lr[j][i]; } }
            float suffix = Rtot;
#pragma unroll
            for (int j = 3; j >= 0; --j) {
                const float ga = g[j], gb = __shfl_xor(ga, 16), gc = __shfl_xor(ga, 32), gd = __shfl_xor(ga, 48);
                const float within = (fq == 0) ? (gb + gc + gd) : (fq == 1) ? (gc + gd) : (fq == 2) ? gb : 0.f;
                float run = suffix + within;
#pragma unroll
                for (int i = 3; i >= 0; --i) { const bool valid = (k0 + 16 * j + 4 * fq + i) < qrow; s[j][i] = valid ? __expf(ls[j][i] + run) : 0.f; run += lr[j][i]; }
                suffix += (ga + gb) + (gc + gd);
            }
            Rtot = suffix;
        }
        bf16x8 pf[2];
#pragma unroll
        for (int kvb = 0; kvb < 2; ++kvb) { u32x4 w; w.x = pk2(s[2 * kvb][0], s[2 * kvb][1]); w.y = pk2(s[2 * kvb][2], s[2 * kvb][3]); w.z = pk2(s[2 * kvb + 1][0], s[2 * kvb + 1][1]); w.w = pk2(s[2 * kvb + 1][2], s[2 * kvb + 1][3]);
            pf[kvb] = __builtin_bit_cast(bf16x8, w); }
#pragma unroll
        for (int dt = 0; dt < NDT; ++dt)
#pragma unroll
            for (int kvb = 0; kvb < 2; ++kvb) { const bf16x8 a = *(const bf16x8*)(Vts + (16 * dt + r16) * VP + (32 * kvb + 8 * fq) * 2); o[dt] = __builtin_amdgcn_mfma_f32_16x16x32_bf16(a, pf[kvb], o[dt], 0, 0, 0); }
        if (MODE == 1) { if (__syncthreads_and(Rtot < -105.0f)) break; }
        t = tn;
    }
    float inv = 1.0f;
    if (MODE != 1) { float lt = l_part; lt += __shfl_xor(lt, 16); lt += __shfl_xor(lt, 32); inv = 1.0f / lt; }
#pragma unroll
    for (int dt = 0; dt < NDT; ++dt) { const f32x4 v = o[dt] * inv; u32x2 w; w.x = pk2(v.x, v.y); w.y = pk2(v.z, v.w);
        if (store) *(u32x2*)(Og + (size_t)qrow * qpitch + 16 * dt + 4 * fq) = w; }
    __syncthreads();
#undef ATT_ISSUE
}

typedef float f32x16 __attribute__((ext_vector_type(16)));
__device__ __forceinline__ int crow_(int r, int hi) { return (r & 3) + 8 * (r >> 2) + 4 * hi; }
template <int MODE>
__device__ __forceinline__ void attn64_unit(unsigned char* ldsb, const bf16_t* Qg, const bf16_t* Kg, const bf16_t* Vg, int pitch, bf16_t* Og, int q0, const float* cseq, float scale,
                                            int tid, int lane, int wave, bool store) {
    constexpr int KP = 144, VP = 144, BUF = 64 * KP + 64 * VP + 256;
    const int r32 = lane & 31, hi = lane >> 5;
    const int qrow = q0 + 32 * wave + r32;
    bf16x8 qf[4];
#pragma unroll
    for (int ks = 0; ks < 4; ++ks) qf[ks] = *(const bf16x8*)(Qg + (size_t)qrow * pitch + 16 * ks + 8 * hi);
    f32x16 o0, o1;
#pragma unroll
    for (int r = 0; r < 16; ++r) { o0[r] = 0.f; o1[r] = 0.f; }
    float m_run = -INFINITY, l_part = 0.f, Rtot = 0.f;
    float cq = 0.f; if (MODE == 0) cq = cseq[qrow];
    const int ntiles = (q0 + 256) / 64;
    const int qlo = q0 + 32 * wave;
    u32x4 kreg, vreg; float creg = 0.f;
    const int krow = tid >> 3, kch = tid & 7, vrow = tid & 63, vch = tid >> 6;
    const int vperm = (vrow & 0x33) | ((vrow & 4) << 1) | ((vrow & 8) >> 1);
#define A64_ISSUE(tt_) do { const int k0_ = (tt_) * 64; \
        kreg = *(const u32x4*)(Kg + (size_t)(k0_ + krow) * pitch + 8 * kch); vreg = *(const u32x4*)(Vg + (size_t)(k0_ + vrow) * pitch + 8 * vch); \
        if (MODE == 0 && tid < 64) creg = cseq[k0_ + tid]; } while (0)
#define A64_STORE(b_) do { unsigned char* B_ = ldsb + (b_) * BUF; *(u32x4*)(B_ + krow * KP + kch * 16) = kreg; \
        bf16_t* vd = (bf16_t*)(B_ + 64 * KP + (8 * vch) * VP + vperm * 2); const u32x4 v = vreg; \
        vd[0 * 72] = (bf16_t)(v.x & 0xffffu); vd[1 * 72] = (bf16_t)(v.x >> 16); vd[2 * 72] = (bf16_t)(v.y & 0xffffu); vd[3 * 72] = (bf16_t)(v.y >> 16); \
        vd[4 * 72] = (bf16_t)(v.z & 0xffffu); vd[5 * 72] = (bf16_t)(v.z >> 16); vd[6 * 72] = (bf16_t)(v.w & 0xffffu); vd[7 * 72] = (bf16_t)(v.w >> 16); \
        if (MODE == 0 && tid < 64) ((float*)(B_ + 64 * KP + 64 * VP))[tid] = creg; } while (0)
    int t = (MODE == 1) ? ntiles - 1 : 0;
    const int dt_ = (MODE == 1) ? -1 : 1;
    A64_ISSUE(t);
    A64_STORE(0);
    if (ntiles > 1) A64_ISSUE(t + dt_);
    __syncthreads();
    for (int it_ = 0; it_ < ntiles; ++it_) {
        const unsigned char* Bc = ldsb + (it_ & 1) * BUF; const unsigned char* Ks = Bc; const unsigned char* Vts = Bc + 64 * KP; const float* cs = (const float*)(Bc + 64 * KP + 64 * VP);
        if (it_ + 1 < ntiles) A64_STORE((it_ + 1) & 1);
        if (it_ + 2 < ntiles) A64_ISSUE(t + 2 * dt_);
        const int k0 = t * 64;
        if (k0 <= qlo + 31) {
            f32x16 p0, p1;
#pragma unroll
            for (int r = 0; r < 16; ++r) { p0[r] = 0.f; p1[r] = 0.f; }
#pragma unroll
            for (int ks = 0; ks < 4; ++ks) {
                const bf16x8 a0 = *(const bf16x8*)(Ks + r32 * KP + (16 * ks + 8 * hi) * 2), a1 = *(const bf16x8*)(Ks + (32 + r32) * KP + (16 * ks + 8 * hi) * 2);
                p0 = __builtin_amdgcn_mfma_f32_32x32x16_bf16(a0, qf[ks], p0, 0, 0, 0); p1 = __builtin_amdgcn_mfma_f32_32x32x16_bf16(a1, qf[ks], p1, 0, 0, 0); }
            const bool diag = (k0 + 63 >= qlo);
            if (MODE == 0) {
#pragma unroll
                for (int g = 0; g < 4; ++g) { const f32x4 c0 = *(const f32x4*)(cs + 8 * g + 4 * hi), c1 = *(const f32x4*)(cs + 32 + 8 * g + 4 * hi);
#pragma unroll
                    for (int i = 0; i < 4; ++i) { p0[4 * g + i] = __builtin_fmaf(p0[4 * g + i], scale, cq - c0[i]); p1[4 * g + i] = __builtin_fmaf(p1[4 * g + i], scale, cq - c1[i]); } }
                if (diag) {
#pragma unroll
                    for (int r = 0; r < 16; ++r) { const int kv = k0 + crow_(r, hi); if (kv > qrow) p0[r] = -INFINITY; if (kv + 32 > qrow) p1[r] = -INFINITY; }
                }
                float tmax = fmaxf(p0[0], p1[0]);
#pragma unroll
                for (int r = 1; r < 16; ++r) tmax = fmaxf(tmax, fmaxf(p0[r], p1[r]));
                tmax = fmaxf(tmax, __shfl_xor(tmax, 32));
                const float mnew = fmaxf(m_run, tmax); const float alpha = __builtin_amdgcn_exp2f(m_run - mnew); m_run = mnew;
                float ps = 0.f;
#pragma unroll
                for (int r = 0; r < 16; ++r) { p0[r] = __builtin_amdgcn_exp2f(p0[r] - mnew); p1[r] = __builtin_amdgcn_exp2f(p1[r] - mnew); ps += p0[r] + p1[r]; }
                l_part = l_part * alpha + ps;
                o0 = o0 * alpha; o1 = o1 * alpha;
            } else {
                float G[8]; f32x16 l0, l1;
#pragma unroll
                for (int r = 0; r < 16; ++r) { l0[r] = p0[r] * scale; l1[r] = p1[r] * scale; p0[r] = logsigmoidf_(l0[r]); p1[r] = logsigmoidf_(l1[r]);
                    const int kv = k0 + crow_(r, hi); l0[r] = (kv < qrow) ? p0[r] - l0[r] : 0.f; l1[r] = (kv + 32 < qrow) ? p1[r] - l1[r] : 0.f; }
#pragma unroll
                for (int g = 0; g < 4; ++g) { G[g] = (l0[4 * g] + l0[4 * g + 1]) + (l0[4 * g + 2] + l0[4 * g + 3]); G[4 + g] = (l1[4 * g] + l1[4 * g + 1]) + (l1[4 * g + 2] + l1[4 * g + 3]); }
                float suffix = Rtot;
#pragma unroll
                for (int th = 1; th >= 0; --th)
#pragma unroll
                    for (int g = 3; g >= 0; --g) { const float mine = G[th * 4 + g]; const float other = __shfl_xor(mine, 32);
                        float run = suffix + (hi == 0 ? other : 0.f);
#pragma unroll
                        for (int i = 3; i >= 0; --i) { const int r = 4 * g + i; const bool valid = (k0 + 32 * th + crow_(r, hi)) < qrow;
                            const float lsg = th ? p1[r] : p0[r]; const float lrr = th ? l1[r] : l0[r];
                            const float att = valid ? __expf(lsg + run) : 0.f; run += lrr; if (th) p1[r] = att; else p0[r] = att; }
                        suffix += mine + other; }
                Rtot = suffix;
            }
            bf16x8 pf[4];
#pragma unroll
            for (int s = 0; s < 4; ++s) { u32x4 w;
                if (s < 2) { const int b8 = 8 * s; w.x = pg8::cvt_pk_bf16(p0[b8], p0[b8 + 1]); w.y = pg8::cvt_pk_bf16(p0[b8 + 2], p0[b8 + 3]); w.z = pg8::cvt_pk_bf16(p0[b8 + 4], p0[b8 + 5]); w.w = pg8::cvt_pk_bf16(p0[b8 + 6], p0[b8 + 7]); }
                else { const int b8 = 8 * (s - 2); w.x = pg8::cvt_pk_bf16(p1[b8], p1[b8 + 1]); w.y = pg8::cvt_pk_bf16(p1[b8 + 2], p1[b8 + 3]); w.z = pg8::cvt_pk_bf16(p1[b8 + 4], p1[b8 + 5]); w.w = pg8::cvt_pk_bf16(p1[b8 + 6], p1[b8 + 7]); }
                pf[s] = __builtin_bit_cast(bf16x8, w); }
#pragma unroll
            for (int s = 0; s < 4; ++s) {
                const bf16x8 v0 = *(const bf16x8*)(Vts + r32 * VP + (16 * s + 8 * hi) * 2), v1 = *(const bf16x8*)(Vts + (32 + r32) * VP + (16 * s + 8 * hi) * 2);
                o0 = __builtin_amdgcn_mfma_f32_32x32x16_bf16(v0, pf[s], o0, 0, 0, 0); o1 = __builtin_amdgcn_mfma_f32_32x32x16_bf16(v1, pf[s], o1, 0, 0, 0); }
        }
        if (MODE == 1) { if (__syncthreads_and(Rtot < -105.0f)) break; } else __syncthreads();
        t += dt_;
    }
    float inv = 1.0f;
    if (MODE == 0) { float lt = l_part; lt += __shfl_xor(lt, 32); inv = 1.0f / lt; }
#pragma unroll
    for (int g = 0; g < 4; ++g) {
        u32x2 w0, w1; w0.x = pg8::cvt_pk_bf16(o0[4 * g] * inv, o0[4 * g + 1] * inv); w0.y = pg8::cvt_pk_bf16(o0[4 * g + 2] * inv, o0[4 * g + 3] * inv);
        w1.x = pg8::cvt_pk_bf16(o1[4 * g] * inv, o1[4 * g + 1] * inv); w1.y = pg8::cvt_pk_bf16(o1[4 * g + 2] * inv, o1[4 * g + 3] * inv);
        if (store) { *(u32x2*)(Og + (size_t)qrow * pitch + 8 * g + 4 * hi) = w0; *(u32x2*)(Og + (size_t)qrow * pitch + 32 + 8 * g + 4 * hi) = w1; } }
    __syncthreads();
#undef A64_ISSUE
#undef A64_STORE
}

#define GAS __attribute__((address_space(1)))
#define LAS __attribute__((address_space(3)))
#define RLX_AGENT __ATOMIC_RELAXED, __HIP_MEMORY_SCOPE_AGENT
#define XB_TMO      128
#define XB_XCNT(j)  (256  + 64 * (j))
#define XB_XSUB(j)  (1280 + 64 * (j))
#define XB_XGEN(j)  (2304 + 64 * (j))
#define XB_TOP      3328
#define XB_TOPGEN   3392
#define XCD_BAR_WORDS 3456
#define XB_SPIN_CAP (1u << 18)

__device__ __forceinline__ unsigned xb_ld(unsigned* p)              { return __hip_atomic_load(p, __ATOMIC_RELAXED, __HIP_MEMORY_SCOPE_AGENT); }
__device__ __forceinline__ unsigned xb_add(unsigned* p, unsigned v) { return __hip_atomic_fetch_add(p, v, __ATOMIC_RELAXED, __HIP_MEMORY_SCOPE_AGENT); }
__device__ __forceinline__ unsigned xb_xcc_id() { return (unsigned)__builtin_amdgcn_s_getreg((3 << 11) | 20) & 0xFu; }
#define XB_SPIN(cond, bar) do { unsigned _sp = 0; while (cond) { __builtin_amdgcn_s_sleep(1); \
    if ((++_sp & 255u) == 0u) { if (xb_ld(&(bar)[XB_TMO])) break; if (_sp > XB_SPIN_CAP) { atomicAdd(&(bar)[XB_TMO], 1u); break; } } } } while (0)

struct XcdBarrier {
    unsigned* bar; unsigned x;
    volatile LAS unsigned* st;
};

__device__ __forceinline__ XcdBarrier xcd_barrier_post(unsigned* bar, volatile LAS unsigned* st) {
    XcdBarrier b; b.bar = bar; b.x = xb_xcc_id(); b.st = st;
    if (threadIdx.x == 0) (void)xb_add(&bar[XB_XCNT(b.x)], 1u);
    return b;
}
__device__ __forceinline__ void xcd_barrier_complete(unsigned* bar, unsigned x, unsigned& nloc, unsigned& nx) {
    const unsigned G = gridDim.x * gridDim.y * gridDim.z;
    unsigned sum, cnt, mine, sp = 0u;
    for (;;) {
        sum = 0u; cnt = 0u; mine = 0u;
#pragma unroll
        for (unsigned j = 0; j < 16; ++j) { const unsigned c = xb_ld(&bar[XB_XCNT(j)]); sum += c; cnt += (c > 0u) ? 1u : 0u; mine = (j == x) ? c : mine; }
        if (sum == G) break;
        __builtin_amdgcn_s_sleep(1);
        if ((++sp & 255u) == 0u) { if (xb_ld(&bar[XB_TMO])) break; if (sp > XB_SPIN_CAP) { atomicAdd(&bar[XB_TMO], 1u); break; } }
    }
    nloc = mine > 0u ? mine : 1u; nx = cnt > 0u ? cnt : 1u;
}

__device__ __forceinline__ void xcd_barrier(const XcdBarrier& b) {
    asm volatile("s_waitcnt vmcnt(0)" ::: "memory");
    __syncthreads();
    if (threadIdx.x == 0) {
        unsigned* bar = b.bar;
        __builtin_amdgcn_s_waitcnt(0);
        unsigned nloc = b.st[0], nx = b.st[1];
        if (nloc == 0u) { xcd_barrier_complete(bar, b.x, nloc, nx); b.st[0] = nloc; b.st[1] = nx; }
        const unsigned old = xb_add(&bar[XB_XSUB(b.x)], 1u);
        const unsigned gen = old / nloc;
        if (old + 1u == (gen + 1u) * nloc) {
            __builtin_amdgcn_fence(__ATOMIC_RELEASE, "agent");
            asm volatile("s_waitcnt vmcnt(0)" ::: "memory");
            const unsigned og = xb_add(&bar[XB_TOP], 1u);
            const unsigned tg = og / nx;
            if (og + 1u == (tg + 1u) * nx) xb_add(&bar[XB_TOPGEN], 1u);
            else XB_SPIN(xb_ld(&bar[XB_TOPGEN]) == tg, bar);
            __builtin_amdgcn_fence(__ATOMIC_ACQUIRE, "agent");
            xb_add(&bar[XB_XGEN(b.x)], 1u);
            asm volatile("s_waitcnt vmcnt(0)" ::: "memory");
        } else {
            XB_SPIN(xb_ld(&bar[XB_XGEN(b.x)]) == gen, bar);
            __builtin_amdgcn_fence(__ATOMIC_ACQUIRE, "agent");
            asm volatile("s_waitcnt vmcnt(0)" ::: "memory");
        }
    }
    __syncthreads();
}

__global__ void __launch_bounds__(NTHREADS, 2) fwd_megakernel(Params p) {
    extern __shared__ __attribute__((aligned(16))) unsigned char lds[];
    cg::grid_group grid = cg::this_grid();
    __shared__ int s_unit;
    __shared__ unsigned s_bst[2];
    if (threadIdx.x < 2) s_bst[threadIdx.x] = 0u;
    __syncthreads();
    const XcdBarrier xbar = xcd_barrier_post((unsigned*)(p.ws + WS_CTL) + 4096, (volatile LAS unsigned*)s_bst);
#define FRESH() const int tid = fresh_tid(), lane = tid & 63, wave = __builtin_amdgcn_readfirstlane(tid >> 6); const int bx = fresh_s((int)blockIdx.x), G = fresh_s((int)gridDim.x); \
    const int gw = bx * NWAVES + wave, ngw = G * NWAVES; unsigned char* ws = p.ws; PG8_LAS unsigned char* ldsl = (PG8_LAS unsigned char*)lds; \
    bf16_t* R1 = (bf16_t*)(ws + WS_R1); bf16_t* R2 = (bf16_t*)(ws + WS_R2); bf16_t* R3 = (bf16_t*)p.out; bf16_t* XB = (bf16_t*)(ws + WS_R3); bf16_t* MEMN = (bf16_t*)(ws + WS_MEMN); bf16_t* MKV = (bf16_t*)(ws + WS_MKV); float* xres = p.out; \
    (void)tid; (void)lane; (void)wave; (void)gw; (void)ngw; (void)ldsl; (void)R1; (void)R2; (void)R3; (void)XB; (void)MEMN; (void)MKV; (void)xres; (void)bx; (void)G;
#define NOSEG 1 << 30, 0, 1 << 30, 0
#ifdef PROBE_DUP_SYNC
#define GSYNC() do { xcd_barrier(xbar); xcd_barrier(xbar); } while (0)
#else
#define GSYNC() xcd_barrier(xbar)
#endif
#ifdef PROBE_DUP_GEMM
#define GEMM_REP for (int rep_ = 0; rep_ < 2; ++rep_)
#else
#define GEMM_REP
#endif
#ifdef PROBE_DUP_NORM
#define NORM_DRY(...) norm_rows(__VA_ARGS__)
#else
#define NORM_DRY(...)
#endif

    { FRESH();
#ifdef PROBE_DUP_CONV
      convert_weights(p, 0, lds, gw, ngw, lane, wave);
#endif
      convert_weights(p, 0, lds, gw, ngw, lane, wave);
      norm_rows<false, false>(gw, ngw, lane, MEMR, p.in[1], nullptr, nullptr, nullptr, p.in[23], MEMN);
      norm_rows<false, true>(gw, ngw, lane, M, p.in[0], nullptr, nullptr, XB, p.in[2], R3); }
    if (p.pad[1] == 0x5eed) grid.sync();
    GSYNC();

    for (int l = 0; l < 2; ++l) {
        { FRESH(); pg8::Gemm g{R3, (const bf16_t*)(ws + WS_WIN), M, ZP, D, D, NOSEG}; pg8::StaticOrder S; S.init(M, ZP, G, bx);
          pg8::EpiBf16 E{R1, ZP, (float*)(ws + WS_FL), 3328};
          GEMM_REP pg8::gemm_phase<pg8::EpiBf16, pg8::StaticOrder, true, true>(ldsl, g, S, E); }
        { FRESH(); pg8::Gemm g{MEMN, (const bf16_t*)(ws + WS_WKV), MEMR, D, D, D, NOSEG}; pg8::StaticOrder S; S.init(MEMR, D, G, bx);
          pg8::EpiBf16 E{MKV, 2 * D, nullptr, 0};
          GEMM_REP pg8::gemm_phase<pg8::EpiBf16, pg8::StaticOrder, true, true>(ldsl, g, S, E); }
        { FRESH(); pg8::Gemm g{MEMN, (const bf16_t*)(ws + WS_WKV) + (size_t)D * D, MEMR, D, D, D, NOSEG}; pg8::StaticOrder S; S.init(MEMR, D, G, (bx + G - 64) % G);
          pg8::EpiVT E{(bf16_t*)p.out + (size_t)32 * 1024 * 1024};
          GEMM_REP pg8::gemm_phase<pg8::EpiVT, pg8::StaticOrder, true, true>(ldsl, g, S, E); }
        GSYNC();
#ifdef PROBE_DUP_PRE
        { FRESH(); rwkv_pre(p, l, gw, ngw, lane); }
#endif
        { FRESH(); rwkv_pre(p, l, gw, ngw, lane); }
        GSYNC();
        { FRESH(); const int Kl = l ? 640 : 256, Nl = l ? 1536 : 1280;
          pg8::Gemm g{R3, (const bf16_t*)(ws + WS_WLORA), M, Nl, Kl, Kl, NOSEG}; pg8::StaticOrder S; S.init(M, Nl, G, bx);
          pg8::EpiBf16 E{R2, Nl, nullptr, 0};
          GEMM_REP pg8::gemm_phase<pg8::EpiBf16, pg8::StaticOrder, true, true>(ldsl, g, S, E); }
        GSYNC();
#ifdef PROBE_DUP_PREP2
        { FRESH(); rwkv_prep2(p, l, gw, ngw, lane); }
#endif
        { FRESH(); rwkv_prep2(p, l, gw, ngw, lane); }
        GSYNC();
#ifdef PROBE_DUP_SCAN
        { FRESH(); if (bx < 96) scan_unit(p, l, bx, lds, tid, lane, wave, p.pad[0] != 0); }
#endif
        { FRESH(); if (bx < 96) scan_unit(p, l, bx, lds, tid, lane, wave, true); }
#ifdef PROBE_DUP_ATT
        { FRESH(); unsigned* ctl = (unsigned*)(ws + WS_CTL);
        for (;;) {
            if (tid == 0) s_unit = (int)atomicAdd(&ctl[64 * (3 + l)], 1u);
            __syncthreads();
            const int u = s_unit;
            __syncthreads();
            if (u >= 768 + 512) break;
            if (u < 768) { const int qb = 7 - u / 96, bh = u % 96, b = bh / 6, h = bh % 6;
                bf16_t* base = R1 + (size_t)b * T * ZP + 1408 + h * 64;
                attn64_unit<0>(lds, base, base + 384, base + 768, ZP, base, qb * 256, (const float*)(ws + WS_CBUF) + (size_t)bh * T, 0.125f * LOG2E, tid, lane, wave, p.pad[0] != 0);
            } else { const int u2 = u - 768; const int qb = 7 - u2 / 64, bh = u2 % 64, b = bh / 4, h = bh % 4;
                bf16_t* base = R1 + (size_t)b * T * ZP + 2560 + h * 64;
                attn64_unit<1>(lds, base, base + 256, base + 512, ZP, base, qb * 256, nullptr, 0.125f, tid, lane, wave, p.pad[0] != 0);
            }
        } }
#endif
        { FRESH(); unsigned* ctl = (unsigned*)(ws + WS_CTL);
        for (;;) {
            if (tid == 0) s_unit = (int)atomicAdd(&ctl[64 * (1 + l)], 1u);
            __syncthreads();
            const int u = s_unit;
            __syncthreads();
            if (u >= 768 + 512) break;
            if (u < 768) { const int qb = 7 - u / 96, bh = u % 96, b = bh / 6, h = bh % 6;
                bf16_t* base = R1 + (size_t)b * T * ZP + 1408 + h * 64;
                attn64_unit<0>(lds, base, base + 384, base + 768, ZP, base, qb * 256, (const float*)(ws + WS_CBUF) + (size_t)bh * T, 0.125f * LOG2E, tid, lane, wave, true);
            } else { const int u2 = u - 768; const int qb = 7 - u2 / 64, bh = u2 % 64, b = bh / 4, h = bh % 4;
                bf16_t* base = R1 + (size_t)b * T * ZP + 2560 + h * 64;
                attn64_unit<1>(lds, base, base + 256, base + 512, ZP, base, qb * 256, nullptr, 0.125f, tid, lane, wave, true);
            }
        } }
        GSYNC();
        { FRESH(); pg8::Gemm g{R1, (const bf16_t*)(ws + WS_WOUT), M, D, D, ZP, 6, 2048, 12, 1536}; pg8::StaticOrder S; S.init(M, D, G, bx);
          pg8::EpiBf16 E{R2, D, nullptr, 0};
          GEMM_REP pg8::gemm_phase<pg8::EpiBf16, pg8::StaticOrder, true, true>(ldsl, g, S, E); }
        GSYNC();
        { FRESH(); norm_rows<true, true>(gw, ngw, lane, M, XB, R2, p.in[3] + l * D, XB, p.in[21] + l * D, R3); }
        GSYNC();
        { FRESH(); pg8::Gemm g{R3, (const bf16_t*)(ws + WS_WQ), M, D, D, D, NOSEG}; pg8::StaticOrder S; S.init(M, D, G, bx);
          pg8::EpiBf16 E{R1, D, nullptr, 0};
          GEMM_REP pg8::gemm_phase<pg8::EpiBf16, pg8::StaticOrder, true, true>(ldsl, g, S, E); }
        GSYNC();
#ifdef PROBE_DUP_MEM
        { FRESH();
        for (int u = bx; u < 1024; u += G) { const int qb = u & 15, bh = u >> 4, b = bh >> 2, hh = bh & 3;
            bf16_t* qbase = R1 + (size_t)b * T * D + hh * 256; const bf16_t* kbase = MKV + (size_t)b * 256 * (2 * D) + hh * 256;
            attn_unit<256, 2>(lds, qbase, D, kbase, (const bf16_t*)p.out + (size_t)32 * 1024 * 1024 + (size_t)bh * 65536, 2 * D, qbase, qb * 128, 256, nullptr, 0.0625f * LOG2E, tid, lane, wave, p.pad[0] != 0); } }
#endif
        { FRESH();
        for (int u = bx; u < 1024; u += G) { const int qb = u & 15, bh = u >> 4, b = bh >> 2, hh = bh & 3;
            bf16_t* qbase = R1 + (size_t)b * T * D + hh * 256; const bf16_t* kbase = MKV + (size_t)b * 256 * (2 * D) + hh * 256;
            attn_unit<256, 2>(lds, qbase, D, kbase, (const bf16_t*)p.out + (size_t)32 * 1024 * 1024 + (size_t)bh * 65536, 2 * D, qbase, qb * 128, 256, nullptr, 0.0625f * LOG2E, tid, lane, wave, true); } }
        GSYNC();
        { FRESH(); pg8::Gemm g{R1, (const bf16_t*)(ws + WS_WO), M, D, D, D, NOSEG}; pg8::StaticOrder S; S.init(M, D, G, bx);
          pg8::EpiBf16 E{R2, D, nullptr, 0};
          GEMM_REP pg8::gemm_phase<pg8::EpiBf16, pg8::StaticOrder, true, true>(ldsl, g, S, E); }
        GSYNC();
        { FRESH(); norm_rows<true, true>(gw, ngw, lane, M, XB, R2, p.in[22] + l * D, XB, p.in[27] + l * D, R3); }
        GSYNC();
        { FRESH(); pg8::Gemm g{R3, (const bf16_t*)(ws + WS_WGU), M, 2 * DFF, D, D, NOSEG}; pg8::StaticOrder S; S.init(M, 2 * DFF, G, bx);
          pg8::EpiSwiGLU E{R1, DFF};
          GEMM_REP pg8::gemm_phase<pg8::EpiSwiGLU, pg8::StaticOrder, true, true>(ldsl, g, S, E); }
        GSYNC();
        { FRESH(); pg8::Gemm g{R1, (const bf16_t*)(ws + WS_WDN), M, D, DFF, DFF, NOSEG}; pg8::StaticOrder S; S.init(M, D, G, bx);
          pg8::EpiBf16 E{R2, D, nullptr, 0};
          GEMM_REP pg8::gemm_phase<pg8::EpiBf16, pg8::StaticOrder, true, true>(ldsl, g, S, E); }
        GSYNC();
        if (l == 0) {
            { FRESH(); norm_rows<true, true>(gw, ngw, lane, M, XB, R2, p.in[28], XB, p.in[2] + D, R3);
#ifdef PROBE_DUP_CONV
              convert_weights(p, 1, lds, gw, ngw, lane, wave);
#endif
              convert_weights(p, 1, lds, gw, ngw, lane, wave);
              norm_rows<false, false>(gw, ngw, lane, MEMR, p.in[1], nullptr, nullptr, nullptr, p.in[23] + D, MEMN); }
            GSYNC();
        } else {
            { FRESH(); norm_rows<true, false>(gw, ngw, lane, M, XB, R2, p.in[28] + D, xres, nullptr, nullptr); }
        }
    }
}

extern "C" void kernel_launch(void* const* d_in, const int* in_sizes, int n_in, void* d_out, int out_size, void* d_ws, size_t ws_size, hipStream_t stream) {
    static int grid_blocks = 0;
    if (grid_blocks == 0) {
        if (n_in != 31 || out_size != M * D || ws_size < WS_END) { fprintf(stderr, "kernel_launch: unexpected shapes (n_in %d out %d ws %zu)\n", n_in, out_size, ws_size); grid_blocks = -1; return; }
        int dev = 0, cus = 0, per_cu = 0;
        hipGetDevice(&dev); hipDeviceGetAttribute(&cus, hipDeviceAttributeMultiprocessorCount, dev);
        if (hipFuncSetAttribute((const void*)fwd_megakernel, hipFuncAttributeMaxDynamicSharedMemorySize, LDS_BYTES) != hipSuccess) { fprintf(stderr, "kernel_launch: hipFuncSetAttribute failed\n"); grid_blocks = -1; return; }
        if (hipOccupancyMaxActiveBlocksPerMultiprocessor(&per_cu, (const void*)fwd_megakernel, NTHREADS, LDS_BYTES) != hipSuccess || per_cu < 1) { fprintf(stderr, "kernel_launch: occupancy query gave %d\n", per_cu); per_cu = 1; }
        (void)hipGetLastError();
        grid_blocks = cus * 1;
    }
    if (grid_blocks < 0) return;
    (void)hipMemsetAsync((char*)d_ws + WS_CTL, 0, 65536, stream);
    Params p{};
    for (int i = 0; i < 31; ++i) p.in[i] = (const float*)d_in[i];
    p.out = (float*)d_out; p.ws = (unsigned char*)d_ws;
    void* args[] = {&p};
    hipError_t e = hipLaunchCooperativeKernel((const void*)fwd_megakernel, dim3(grid_blocks), dim3(NTHREADS), args, LDS_BYTES, stream);
    if (e != hipSuccess) fprintf(stderr, "cooperative launch failed: %s (grid %d)\n", hipGetErrorString(e), grid_blocks);
}
```

```cpp
#include <hip/hip_runtime.h>
#include <hip/hip_cooperative_groups.h>
#include <cstdio>
#include <cstdint>
namespace cg = cooperative_groups;
__device__ __forceinline__ int fresh_tid() { int t = threadIdx.x; asm volatile("" : "+v"(t)); return t; }
__device__ __forceinline__ int fresh_s(int v) { asm volatile("" : "+s"(v)); return v; }
namespace pg8 {
#define PG8_LAS __attribute__((address_space(3)))
typedef unsigned short bf16_t;
typedef short bf16x8 __attribute__((ext_vector_type(8)));
typedef float f32x4 __attribute__((ext_vector_type(4)));
typedef unsigned u32x4 __attribute__((ext_vector_type(4)));
constexpr int BM = 256, BK = 64, HALF = 128, HTB = HALF * BK * 2  , STAGE_BYTES = 8 * HTB, NXCD = 8, WGM = 8;

__host__ __device__ __forceinline__ int lds_byte(int r, int c) { const int st = (r >> 4) * 2 + (c >> 5), rr = r & 15, cc = c & 31, ob = rr * 64 + cc * 2; return st * 1024 + (ob ^ (((ob >> 9) & 1) << 5)); }
__host__ __device__ __forceinline__ void stage_rc(int b, int& R, int& C) { const int st = b / 1024, sb = b % 1024, swz = sb ^ (((sb >> 9) & 1) << 5); R = (st >> 1) * 16 + swz / 64; C = (st & 1) * 32 + (swz % 64) / 2; }
__host__ __device__ __forceinline__ int perm32(int rho) { const int n = rho >> 4, i = rho & 15; return 8 * (i >> 2) + 4 * n + (i & 3); }

struct Unit { int pm, pn; };
struct Gemm { const bf16_t* A; const bf16_t* Bt; int M, N, K; int lda; int s1, d1, s2, d2; };

struct StaticOrder {
    int nM, nN, nwg, G, c;
    __host__ __device__ void init(int M, int N, int G_, int c_) { nM = M / BM; nN = N / BM; nwg = nM * nN; G = G_; c = c_; }
    __host__ __device__ bool next(int i, Unit& u) const {
        const long L = (long)i * G + c; if (L >= nwg) return false;
        int wgid = (int)L; { const int q = nwg / NXCD, r = nwg % NXCD, xcd = wgid % NXCD, off = wgid / NXCD; wgid = (xcd < r ? xcd * (q + 1) : r * (q + 1) + (xcd - r) * q) + off; }
        const int nig = WGM * nN, gid = wgid / nig, fm = gid * WGM, gsz = (nM - fm) < WGM ? (nM - fm) : WGM;
        u.pm = fm + ((wgid % nig) % gsz); u.pn = (wgid % nig) / gsz; return true;
    }
    __device__ __forceinline__ void a_ready(const Unit&) const {}
    __device__ __forceinline__ void done(const Unit&) const {}
};

__device__ __forceinline__ unsigned cvt_pk_bf16(float lo, float hi) { unsigned r; asm("v_cvt_pk_bf16_f32 %0, %1, %2" : "=v"(r) : "v"(lo), "v"(hi)); return r; }
typedef float f32x2 __attribute__((ext_vector_type(2)));
template <class Epi, class Sched, bool ALIGN_EPI = false, bool SP2 = false>
__device__ __forceinline__ void gemm_phase(PG8_LAS unsigned char* lds, const Gemm g, const Sched& S, const Epi& E) {
    static_assert(SP2, "only the SP2 loop carries the lda / segment changes");
    const int tid = fresh_tid(), wid = __builtin_amdgcn_readfirstlane(tid >> 6), lane = tid & 63, wr = wid >> 2, wc = wid & 3, fr = lane & 15, fq = lane >> 4;
    const int K = g.K, nt = K / BK;
    unsigned voffA[2], voffB[2];
#pragma unroll
    for (int i = 0; i < 2; ++i) { int R, C; stage_rc(tid * 16 + i * 8192, R, C); const int Rb = Epi::PERM ? ((R & ~31) + perm32(R & 31)) : R;
        voffA[i] = (unsigned)(R * g.lda + C) * 2u; voffB[i] = (unsigned)(Rb * K + C) * 2u; }
    const size_t kstep = (size_t)(BK * 2);
    const size_t hstep = (size_t)HALF * K * 2, hstepA = (size_t)HALF * g.lda * 2;
    const size_t tstep = 2 * hstep, tstepA = 2 * hstepA;
#define PG8_KA(t) ((size_t)(t) * 128 + ((t) >= g.s1 ? (size_t)g.d1 : 0) + ((t) >= g.s2 ? (size_t)g.d2 : 0))
    const unsigned ldsw = (unsigned)wid * 1024u;
    const int aoff = lds_byte(wr * 64 + fr, fq * 8), boff = lds_byte(wc * 32 + fr, fq * 8);
#define PG8_SA(b, h) (((b) * 2 + (h)) * HTB)
#define PG8_SB(b, h) ((4 + (b) * 2 + (h)) * HTB)
#define PG8_STAGE(bufoff, gbase, voff) do { _Pragma("unroll") for (int _i = 0; _i < 2; ++_i) \
        __builtin_amdgcn_global_load_lds((const unsigned*)((const char*)(gbase) + (voff)[_i]), (PG8_LAS unsigned*)(lds + (bufoff) + ldsw + _i * 8192), 16, 0, 0); } while (0)
#define PG8_LDA(dst, b, h) do { _Pragma("unroll") for (int m = 0; m < 4; ++m) _Pragma("unroll") for (int k = 0; k < 2; ++k) dst[m][k] = *(const PG8_LAS bf16x8*)(lds + PG8_SA(b, h) + aoff + m * 2048 + k * 1024); } while (0)
#define PG8_LDB(dst, b, h) do { _Pragma("unroll") for (int n = 0; n < 2; ++n) _Pragma("unroll") for (int k = 0; k < 2; ++k) dst[n][k] = *(const PG8_LAS bf16x8*)(lds + PG8_SB(b, h) + boff + n * 2048 + k * 1024); } while (0)
#define PG8_MMA(ai, bj, At, Bt) do { __builtin_amdgcn_s_setprio(1); _Pragma("unroll") for (int m = 0; m < 4; ++m) _Pragma("unroll") for (int n = 0; n < 2; ++n) _Pragma("unroll") for (int k = 0; k < 2; ++k) \
        acc[ai][bj][m][n] = __builtin_amdgcn_mfma_f32_16x16x32_bf16(Bt[n][k], At[m][k], acc[ai][bj][m][n], 0, 0, 0); __builtin_amdgcn_s_setprio(0); } while (0)
#define PG8_WAIT_V(n) asm volatile("s_waitcnt vmcnt(" #n ")" ::: "memory")
#define PG8_WAIT_L(n) asm volatile("s_waitcnt lgkmcnt(" #n ")" ::: "memory")
#define PG8_BAR __builtin_amdgcn_s_barrier()
#define PG8_SCHED __builtin_amdgcn_sched_barrier(0)
    Unit cur, nxt; int ui = 0;
    if (!S.next(0, cur)) return;
    f32x4 acc[2][2][4][2];
#pragma unroll
    for (int a = 0; a < 2; ++a)
#pragma unroll
        for (int b = 0; b < 2; ++b)
#pragma unroll
            for (int m = 0; m < 4; ++m)
#pragma unroll
                for (int n = 0; n < 2; ++n) acc[a][b][m][n] = (f32x4){0.f, 0.f, 0.f, 0.f};
    bf16x8 At[4][2], B0[2][2], B1[2][2];
    const char* cA = (const char*)g.A + (size_t)cur.pm * tstepA; const char* cB = (const char*)g.Bt + (size_t)cur.pn * tstep;
    S.a_ready(cur);
    if constexpr (SP2) {
        PG8_STAGE(PG8_SB(0, 0), cB, voffB); PG8_STAGE(PG8_SB(0, 1), cB + hstep, voffB); PG8_STAGE(PG8_SA(0, 0), cA, voffA); PG8_STAGE(PG8_SA(0, 1), cA + hstepA, voffA);
        if (wr == 1) PG8_BAR;
        PG8_WAIT_V(2); PG8_BAR;
        PG8_STAGE(PG8_SB(1, 0), cB + kstep, voffB); PG8_STAGE(PG8_SA(1, 0), cA + PG8_KA(1), voffA); PG8_STAGE(PG8_SB(1, 1), cB + hstep + kstep, voffB);
        PG8_WAIT_V(6); PG8_BAR;
    } else {
        PG8_STAGE(PG8_SB(0, 0), cB, voffB); PG8_STAGE(PG8_SA(0, 0), cA, voffA); PG8_STAGE(PG8_SB(0, 1), cB + hstep, voffB); PG8_STAGE(PG8_SA(0, 1), cA + hstep, voffA);
        if (wr == 1) PG8_BAR;
        PG8_WAIT_V(4); PG8_BAR;
        PG8_STAGE(PG8_SB(1, 0), cB + kstep, voffB); PG8_STAGE(PG8_SA(1, 0), cA + kstep, voffA); PG8_STAGE(PG8_SB(1, 1), cB + hstep + kstep, voffB);
        PG8_WAIT_V(6); PG8_BAR;
    }
    for (;;) {
        const bool has_next = S.next(ui + 1, nxt);
        const char* nA = has_next ? (const char*)g.A + (size_t)nxt.pm * tstepA : cA; const char* nB = has_next ? (const char*)g.Bt + (size_t)nxt.pn * tstep : cB;
        for (int t = 0; t < nt; t += 2) {
            const bool last = (t == nt - 2);
            const char* a1 = cA + PG8_KA(t + 1);
            const char* a2 = last ? nA : cA + PG8_KA(t + 2); const char* b2 = last ? nB : cB + (size_t)(t + 2) * kstep;
            const char* a3 = last ? nA + PG8_KA(1) : cA + PG8_KA(t + 3); const char* b3 = b2 + kstep;
            if (last && has_next) S.a_ready(nxt);
            if constexpr (SP2) {
            PG8_LDB(B0, 0, 0); PG8_LDB(B1, 0, 1); PG8_SCHED; PG8_LDA(At, 0, 0); PG8_STAGE(PG8_SA(1, 1), a1 + hstepA, voffA);
            PG8_WAIT_V(8); PG8_WAIT_L(0); PG8_BAR; PG8_MMA(0, 0, At, B0); PG8_MMA(0, 1, At, B1); PG8_BAR; PG8_SCHED;
            PG8_LDA(At, 0, 1); PG8_STAGE(PG8_SB(0, 0), b2, voffB); PG8_STAGE(PG8_SB(0, 1), b2 + hstep, voffB); PG8_STAGE(PG8_SA(0, 0), a2, voffA);
            PG8_WAIT_V(8); PG8_WAIT_L(0); PG8_BAR; PG8_MMA(1, 0, At, B0); PG8_MMA(1, 1, At, B1); PG8_BAR; PG8_SCHED;
            PG8_LDB(B0, 1, 0); PG8_LDB(B1, 1, 1); PG8_SCHED; PG8_LDA(At, 1, 0); PG8_STAGE(PG8_SA(0, 1), a2 + hstepA, voffA);
            PG8_WAIT_V(8); PG8_WAIT_L(0); PG8_BAR; PG8_MMA(0, 0, At, B0); PG8_MMA(0, 1, At, B1); PG8_BAR; PG8_SCHED;
            PG8_LDA(At, 1, 1); PG8_STAGE(PG8_SB(1, 0), b3, voffB); PG8_STAGE(PG8_SB(1, 1), b3 + hstep, voffB); PG8_STAGE(PG8_SA(1, 0), a3, voffA);
            PG8_WAIT_V(8); PG8_WAIT_L(0); PG8_BAR; PG8_MMA(1, 0, At, B0); PG8_MMA(1, 1, At, B1); PG8_BAR; PG8_SCHED;
            } else {
            PG8_LDB(B0, 0, 0); PG8_SCHED; PG8_LDA(At, 0, 0); PG8_STAGE(PG8_SA(1, 1), a1 + hstep, voffA);
            PG8_WAIT_L(8); PG8_BAR; PG8_WAIT_L(0); PG8_MMA(0, 0, At, B0); PG8_BAR; PG8_SCHED;
            PG8_LDB(B1, 0, 1); PG8_STAGE(PG8_SB(0, 0), b2, voffB);
            PG8_BAR; PG8_WAIT_L(0); PG8_MMA(0, 1, At, B1); PG8_BAR;
            PG8_LDA(At, 0, 1); PG8_STAGE(PG8_SA(0, 0), a2, voffA);
            PG8_BAR; PG8_WAIT_L(0); PG8_MMA(1, 0, At, B0); PG8_BAR; PG8_SCHED;
            PG8_STAGE(PG8_SB(0, 1), b2 + hstep, voffB);
            PG8_WAIT_V(6); PG8_BAR; PG8_MMA(1, 1, At, B1); PG8_BAR;
            PG8_LDB(B0, 1, 0); PG8_SCHED; PG8_LDA(At, 1, 0); PG8_STAGE(PG8_SA(0, 1), a2 + hstep, voffA);
            PG8_WAIT_L(8); PG8_BAR; PG8_WAIT_L(0); PG8_MMA(0, 0, At, B0); PG8_BAR; PG8_SCHED;
            PG8_LDB(B1, 1, 1); PG8_STAGE(PG8_SB(1, 0), b3, voffB);
            PG8_BAR; PG8_WAIT_L(0); PG8_MMA(0, 1, At, B1); PG8_BAR;
            PG8_LDA(At, 1, 1); PG8_STAGE(PG8_SA(1, 0), a3, voffA);
            PG8_BAR; PG8_WAIT_L(0); PG8_MMA(1, 0, At, B0); PG8_BAR; PG8_SCHED;
            PG8_STAGE(PG8_SB(1, 1), b3 + hstep, voffB);
            PG8_WAIT_V(6); PG8_BAR; PG8_MMA(1, 1, At, B1); PG8_BAR;
            }
        }
        if constexpr (ALIGN_EPI) { if (wr == 0) PG8_BAR; }
        if constexpr (!Epi::AFTER_DRAIN) { E(acc, cur, wr, wc, fr, fq); S.done(cur); }
        if (!has_next) break;
#pragma unroll
        for (int a = 0; a < 2; ++a)
#pragma unroll
            for (int b = 0; b < 2; ++b)
#pragma unroll
                for (int m = 0; m < 4; ++m)
#pragma unroll
                    for (int n = 0; n < 2; ++n) acc[a][b][m][n] = (f32x4){0.f, 0.f, 0.f, 0.f};
        cur = nxt; cA = nA; cB = nB; ++ui;
        if constexpr (ALIGN_EPI) { if (wr == 1) PG8_BAR; }
    }
    PG8_WAIT_V(0);
    if constexpr (!ALIGN_EPI) { if (wr == 0) PG8_BAR; }
    PG8_BAR;
    if constexpr (Epi::AFTER_DRAIN) { E.fused(acc, cur, wr, wc, fr, fq, lds, wid, lane); S.done(cur); }
#undef PG8_SA
#undef PG8_KA
#undef PG8_SB
#undef PG8_STAGE
#undef PG8_LDA
#undef PG8_LDB
#undef PG8_MMA
#undef PG8_WAIT_V
#undef PG8_WAIT_L
#undef PG8_BAR
#undef PG8_SCHED
}
}

namespace pg8 {
struct EpiBf16 {
    static constexpr bool PERM = true, AFTER_DRAIN = false;
    bf16_t* O; int ldc; float* fl; int flcol;
    __device__ __forceinline__ void operator()(const f32x4 (&acc)[2][2][4][2], const Unit& u, int wr, int wc, int fr, int fq) const {
        const int row0 = u.pm * BM + wr * 64 + fr; const int colt = u.pn * BM; const int col0 = colt + wc * 32 + 8 * fq;
#pragma unroll
        for (int ai = 0; ai < 2; ++ai)
#pragma unroll
            for (int m = 0; m < 4; ++m) { bf16_t* rowp = O + (size_t)(row0 + ai * HALF + m * 16) * ldc + col0;
#pragma unroll
                for (int bj = 0; bj < 2; ++bj) { const f32x4 v0 = acc[ai][bj][m][0], v1 = acc[ai][bj][m][1];
                    u32x4 w; w.x = cvt_pk_bf16(v0[0], v0[1]); w.y = cvt_pk_bf16(v0[2], v0[3]); w.z = cvt_pk_bf16(v1[0], v1[1]); w.w = cvt_pk_bf16(v1[2], v1[3]);
                    *(u32x4*)(rowp + bj * HALF) = w; } }
        if (fl != nullptr && colt == flcol && wc == 0 && fq == 0) {
#pragma unroll
            for (int ai = 0; ai < 2; ++ai)
#pragma unroll
                for (int m = 0; m < 4; ++m) { float* p = fl + (size_t)(row0 + ai * HALF + m * 16) * 8; *(f32x4*)p = acc[ai][0][m][0]; *(f32x4*)(p + 4) = acc[ai][0][m][1]; }
        }
    }
};

struct EpiVT {
    static constexpr bool PERM = true, AFTER_DRAIN = false;
    bf16_t* VT;
    __device__ __forceinline__ void operator()(const f32x4 (&acc)[2][2][4][2], const Unit& u, int wr, int wc, int fr, int fq) const {
        {
            bf16_t* lanebase = VT + (size_t)(u.pm * 4 + u.pn) * 65536 + (size_t)(wc * 32 + 8 * fq) * 256 + wr * 64 + fr;
#pragma unroll
            for (int ai = 0; ai < 2; ++ai)
#pragma unroll
                for (int m = 0; m < 4; ++m) { bf16_t* pk = lanebase + ai * HALF + m * 16; asm volatile("" : "+v"(pk));
#pragma unroll
                    for (int bj = 0; bj < 2; ++bj)
#pragma unroll
                        for (int n = 0; n < 2; ++n) { const int d0 = bj * HALF + 4 * n; const f32x4 v = acc[ai][bj][m][n];
                            const unsigned w0 = cvt_pk_bf16(v[0], v[1]), w1 = cvt_pk_bf16(v[2], v[3]);
                            pk[(d0 + 0) * 256] = (bf16_t)(w0 & 0xffffu); pk[(d0 + 1) * 256] = (bf16_t)(w0 >> 16);
                            pk[(d0 + 2) * 256] = (bf16_t)(w1 & 0xffffu); pk[(d0 + 3) * 256] = (bf16_t)(w1 >> 16); }
                    asm volatile("" ::: "memory"); }
        }
    }
};
struct EpiSwiGLU {
    static constexpr bool PERM = true, AFTER_DRAIN = false;
    bf16_t* O; int ldc;
    __device__ __forceinline__ void operator()(const f32x4 (&acc)[2][2][4][2], const Unit& u, int wr, int wc, int fr, int fq) const {
        const int row0 = u.pm * BM + wr * 64 + fr; const int col0 = u.pn * HALF + wc * 32 + 8 * fq;
#pragma unroll
        for (int ai = 0; ai < 2; ++ai)
#pragma unroll
            for (int m = 0; m < 4; ++m) { bf16_t* rowp = O + (size_t)(row0 + ai * HALF + m * 16) * ldc + col0;
                float h[8];
#pragma unroll
                for (int n = 0; n < 2; ++n)
#pragma unroll
                    for (int i = 0; i < 4; ++i) { const float g = acc[ai][0][m][n][i], up = acc[ai][1][m][n][i]; h[n * 4 + i] = g * __builtin_amdgcn_rcpf(1.0f + __expf(-g)) * up; }
                u32x4 w; w.x = cvt_pk_bf16(h[0], h[1]); w.y = cvt_pk_bf16(h[2], h[3]); w.z = cvt_pk_bf16(h[4], h[5]); w.w = cvt_pk_bf16(h[6], h[7]);
                *(u32x4*)rowp = w; }
    }
};
}

typedef unsigned short bf16_t;
typedef short bf16x8 __attribute__((ext_vector_type(8)));
typedef float f32x4 __attribute__((ext_vector_type(4)));
typedef unsigned u32x4 __attribute__((ext_vector_type(4)));
typedef unsigned u32x2 __attribute__((ext_vector_type(2)));

constexpr int NB = 16, T = 2048, D = 1024, M = NB * T;
constexpr int ZP = 3584;
constexpr int A_COLS = 1408, IN_COLS = 3334, DFF = 2816;
constexpr int MEMR = NB * 256;
constexpr float RMS_EPS = 1e-6f, GN_EPS = 64e-5f;
constexpr float LOG2E = 1.4426950408889634f;
constexpr size_t MiB = 1u << 20;
constexpr size_t WS_CTL = 0, WS_WIN = 1 * MiB, WS_WLORA = 8 * MiB, WS_WOUT = 10 * MiB, WS_WQ = 12 * MiB, WS_WKV = 14 * MiB, WS_WO = 18 * MiB, WS_WGU = 20 * MiB, WS_WDN = 31 * MiB,
                 WS_CBUF = 37 * MiB, WS_FL = 38 * MiB, WS_MKV = 40 * MiB, WS_VFIRST = 56 * MiB, WS_R3 = 80 * MiB, WS_R2 = 144 * MiB, WS_R1 = 240 * MiB, WS_MEMN = 464 * MiB, WS_VFIN = 472 * MiB, WS_GEND = 496 * MiB, WS_SCAL = 502 * MiB, WS_END = 505 * MiB;
constexpr int NTHREADS = 512, NWAVES = 8;
constexpr int LDS_BYTES = 147456;

struct Params { const float* in[31]; float* out; unsigned char* ws; int pad[2]; };

__device__ __forceinline__ float bf2f(bf16_t v) { return __uint_as_float((unsigned)v << 16); }
__device__ __forceinline__ unsigned f2bf(float f) { return pg8::cvt_pk_bf16(f, 0.f) & 0xffffu; }
__device__ __forceinline__ unsigned pk2(float lo, float hi) { return pg8::cvt_pk_bf16(lo, hi); }
__device__ __forceinline__ float lo16(unsigned w) { return __uint_as_float(w << 16); }
__device__ __forceinline__ float hi16(unsigned w) { return __uint_as_float(w & 0xffff0000u); }
#define WS_DPP(x, ctrl) ((x) + __int_as_float(__builtin_amdgcn_update_dpp(0, __float_as_int(x), (ctrl), 0xF, 0xF, true)))
__device__ __forceinline__ float wave_sum(float v) {
    v = WS_DPP(v, 0xB1); v = WS_DPP(v, 0x4E); v = WS_DPP(v, 0x141); v = WS_DPP(v, 0x140);
    const int iv = __float_as_int(v);
    return (__int_as_float(__builtin_amdgcn_readlane(iv, 0)) + __int_as_float(__builtin_amdgcn_readlane(iv, 16))) + (__int_as_float(__builtin_amdgcn_readlane(iv, 32)) + __int_as_float(__builtin_amdgcn_readlane(iv, 48)));
}
#define BAR_LGKM() asm volatile("s_waitcnt lgkmcnt(0)\n\ts_barrier" ::: "memory")
__device__ __forceinline__ float sigmoidf_(float x) { return __builtin_amdgcn_rcpf(1.0f + __expf(-x)); }
__device__ __forceinline__ float logsigmoidf_(float x) { return fminf(x, 0.f) - __logf(1.0f + __expf(-fabsf(x))); }

__device__ __forceinline__ int colmap(int mode, int n) {
    if (mode == 1) { if (n < 2560) return n; if (n < 3328) return n + 6; if (n < 3334) return n - 768; return -1; }
    if (mode == 2) { const int tile = n >> 8, w = n & 255; return w < 128 ? tile * 128 + w : DFF + tile * 128 + (w - 128); }
    return n;
}
__device__ __forceinline__ void transpose_item(const float* __restrict__ W, int Nsrc, int K, bf16_t* WT, int nblk, int mode, float* scr, int item, int lane) {
    const int kb = item / nblk, nb = item % nblk, k0 = 64 * kb, n0 = 32 * nb;
    const int src = colmap(mode, n0 + (lane & 31));
#pragma unroll 8
    for (int i = 0; i < 32; ++i) { const int kk = 2 * i + (lane >> 5); scr[kk * 33 + (lane & 31)] = src >= 0 ? W[(size_t)(k0 + kk) * Nsrc + src] : 0.f; }
    asm volatile("s_waitcnt lgkmcnt(0)" ::: "memory");
    const int c = lane & 7;
#pragma unroll
    for (int j = 0; j < 4; ++j) { const int n = (lane >> 3) + 8 * j; const float* s = scr + (8 * c) * 33 + n;
        u32x4 o; o.x = pk2(s[0 * 33], s[1 * 33]); o.y = pk2(s[2 * 33], s[3 * 33]); o.z = pk2(s[4 * 33], s[5 * 33]); o.w = pk2(s[6 * 33], s[7 * 33]);
        *(u32x4*)(WT + (size_t)(n0 + n) * K + k0 + 8 * c) = o; }
    asm volatile("s_waitcnt lgkmcnt(0)" ::: "memory");
}
__device__ __forceinline__ void convert_weights(const Params& p, int l, unsigned char* lds, int gw, int ngw, int lane, int wave) {
    unsigned char* ws = p.ws;
    float* scr = (float*)(lds + wave * 16384);
    constexpr int I_IN = 16 * (ZP / 32), I_SQ = 16 * 32, I_KV = 16 * 64, I_GU = 16 * (2 * DFF / 32), I_DN = (DFF / 64) * 32;
    constexpr int NITEMS = I_IN + 3 * I_SQ + I_KV + I_GU + I_DN;
    for (int it = gw; it < NITEMS; it += ngw) {
        int r = it;
        if (r < I_IN) { transpose_item(p.in[4] + (size_t)l * D * IN_COLS, IN_COLS, D, (bf16_t*)(ws + WS_WIN), ZP / 32, 1, scr, r, lane); continue; } r -= I_IN;
        if (r < I_SQ) { transpose_item(p.in[20] + (size_t)l * D * D, D, D, (bf16_t*)(ws + WS_WOUT), 32, 0, scr, r, lane); continue; } r -= I_SQ;
        if (r < I_SQ) { transpose_item(p.in[24] + (size_t)l * D * D, D, D, (bf16_t*)(ws + WS_WQ), 32, 0, scr, r, lane); continue; } r -= I_SQ;
        if (r < I_SQ) { transpose_item(p.in[26] + (size_t)l * D * D, D, D, (bf16_t*)(ws + WS_WO), 32, 0, scr, r, lane); continue; } r -= I_SQ;
        if (r < I_KV) { transpose_item(p.in[25] + (size_t)l * D * 2 * D, 2 * D, D, (bf16_t*)(ws + WS_WKV), 64, 0, scr, r, lane); continue; } r -= I_KV;
        if (r < I_GU) { transpose_item(p.in[29] + (size_t)l * D * 2 * DFF, 2 * DFF, D, (bf16_t*)(ws + WS_WGU), 2 * DFF / 32, 2, scr, r, lane); continue; } r -= I_GU;
        transpose_item(p.in[30] + (size_t)l * DFF * D, D, DFF, (bf16_t*)(ws + WS_WDN), 32, 0, scr, r, lane);
    }
    const int Kl = l ? 640 : 256, Nl = l ? 1536 : 1280, kch = Kl / 8;
    const float* w_up = p.in[7] + (size_t)l * 64 * 384; const float* a_up = p.in[9] + (size_t)l * 64 * 384; const float* g_up = p.in[10] + (size_t)l * 128 * 384;
    const float* vdn = p.in[17]; const float* vup = p.in[18];
    bf16_t* WL = (bf16_t*)(ws + WS_WLORA);
    for (int ci = gw * 64 + lane; ci < Nl * kch; ci += ngw * 64) {
        const int n = ci / kch, k0 = (ci % kch) * 8; float v[8];
#pragma unroll
        for (int e = 0; e < 8; ++e) { const int k = k0 + e; float x = 0.f;
            if (n < 384) { if (k < 64) x = w_up[k * 384 + n]; }
            else if (n < 768) { if (k >= 64 && k < 128) x = a_up[(k - 64) * 384 + n - 384]; }
            else if (n < 1152) { if (k >= 128 && k < 256) x = g_up[(k - 128) * 384 + n - 768]; }
            else if (n < 1536 && l == 1) { if (k >= 256) { float s = 0.f; for (int r = 0; r < 32; ++r) s += vdn[(k - 256) * 32 + r] * vup[r * 384 + n - 1152]; x = s; } }
            v[e] = x; }
        u32x4 o; o.x = pk2(v[0], v[1]); o.y = pk2(v[2], v[3]); o.z = pk2(v[4], v[5]); o.w = pk2(v[6], v[7]);
        *(u32x4*)(WL + (size_t)n * Kl + k0) = o;
    }
}

template <bool XIB, bool XOB>
__device__ __forceinline__ void norm_rows(int gw, int ngw, int lane, int rows, const void* xin_, const bf16_t* y, const float* gpost, void* xout_, const float* gpre, bf16_t* hout) {
    constexpr int NR = 4;
    const float* xin = (const float*)xin_; const bf16_t* xinb = (const bf16_t*)xin_; float* xout = (float*)xout_; bf16_t* xoutb = (bf16_t*)xout_;
    for (int row0 = gw; row0 < rows; row0 += NR * ngw) {
        int rw[NR]; bool ok[NR];
#pragma unroll
        for (int k = 0; k < NR; ++k) { const int r = row0 + k * ngw; ok[k] = r < rows; rw[k] = ok[k] ? r : row0; }
        f32x4 x[NR][4]; u32x2 yy[NR][4];
#pragma unroll
        for (int k = 0; k < NR; ++k)
#pragma unroll
            for (int j = 0; j < 4; ++j) {
                if (XIB) { const u32x2 w = *(const u32x2*)(xinb + (size_t)rw[k] * D + 256 * j + 4 * lane); x[k][j] = (f32x4){lo16(w.x), hi16(w.x), lo16(w.y), hi16(w.y)}; }
                else x[k][j] = *(const f32x4*)(xin + (size_t)rw[k] * D + 256 * j + 4 * lane); }
        if (y != nullptr) {
#pragma unroll
            for (int k = 0; k < NR; ++k)
#pragma unroll
                for (int j = 0; j < 4; ++j) yy[k][j] = *(const u32x2*)(y + (size_t)rw[k] * D + 256 * j + 4 * lane);
#pragma unroll
            for (int k = 0; k < NR; ++k) {
                f32x4 v[4]; float ss = 0.f;
#pragma unroll
                for (int j = 0; j < 4; ++j) { v[j] = (f32x4){lo16(yy[k][j].x), hi16(yy[k][j].x), lo16(yy[k][j].y), hi16(yy[k][j].y)}; ss += (v[j].x * v[j].x + v[j].y * v[j].y) + (v[j].z * v[j].z + v[j].w * v[j].w); }
                const float r = rsqrtf(wave_sum(ss) * (1.0f / D) + RMS_EPS);
#pragma unroll
                for (int j = 0; j < 4; ++j) { const f32x4 g = *(const f32x4*)(gpost + 256 * j + 4 * lane); x[k][j] = x[k][j] + v[j] * r * g; }
            }
        }
        if (xout_ != nullptr) {
#pragma unroll
            for (int k = 0; k < NR; ++k) if (ok[k]) {
#pragma unroll
                for (int j = 0; j < 4; ++j) {
                    if (XOB) { u32x2 w; w.x = pk2(x[k][j].x, x[k][j].y); w.y = pk2(x[k][j].z, x[k][j].w); *(u32x2*)(xoutb + (size_t)rw[k] * D + 256 * j + 4 * lane) = w; }
                    else *(f32x4*)(xout + (size_t)rw[k] * D + 256 * j + 4 * lane) = x[k][j]; } }
        }
        if (gpre != nullptr) {
#pragma unroll
            for (int k = 0; k < NR; ++k) {
                float ss = 0.f;
#pragma unroll
                for (int j = 0; j < 4; ++j) ss += (x[k][j].x * x[k][j].x + x[k][j].y * x[k][j].y) + (x[k][j].z * x[k][j].z + x[k][j].w * x[k][j].w);
                const float r = rsqrtf(wave_sum(ss) * (1.0f / D) + RMS_EPS);
                if (ok[k]) {
#pragma unroll
                    for (int j = 0; j < 4; ++j) { const f32x4 g = *(const f32x4*)(gpre + 256 * j + 4 * lane); const f32x4 h = x[k][j] * r * g;
                        u32x2 w; w.x = pk2(h.x, h.y); w.y = pk2(h.z, h.w); *(u32x2*)(hout + (size_t)rw[k] * D + 256 * j + 4 * lane) = w; } }
            }
        }
    }
}

__device__ __forceinline__ void rwkv_pre(const Params& p, int l, int gw, int ngw, int lane) {
    const bf16_t* z = (const bf16_t*)(p.ws + WS_R1); bf16_t* lin = (bf16_t*)p.out; bf16_t* vfirst = (bf16_t*)(p.ws + WS_VFIRST);
    const float* mu = p.in[5] + (size_t)l * A_COLS; const int Kl = l ? 640 : 256;
    constexpr int NU = 4; const int nlanes = ngw * 64;
    for (int base = gw * 64 + lane; base < M * 80; base += NU * nlanes) {
        u32x4 zc[NU], zp[NU]; int tokv[NU], chv[NU]; bool okv[NU];
#pragma unroll
        for (int k = 0; k < NU; ++k) { const int idx = base + k * nlanes; okv[k] = idx < M * 80; const int id2 = okv[k] ? idx : base; tokv[k] = id2 / 80; chv[k] = id2 % 80;
            const int col = chv[k] < 48 ? 768 + 8 * chv[k] : 1152 + 8 * (chv[k] - 48);
            zc[k] = *(const u32x4*)(z + (size_t)tokv[k] * ZP + col);
            zp[k] = (u32x4){0u, 0u, 0u, 0u}; if ((tokv[k] % T) > 0) zp[k] = *(const u32x4*)(z + (size_t)(tokv[k] - 1) * ZP + col); }
#pragma unroll
        for (int k = 0; k < NU; ++k) { const int tok = tokv[k], ch = chv[k];
            const int col = ch < 48 ? 768 + 8 * ch : 1152 + 8 * (ch - 48);
            const f32x4 m0 = *(const f32x4*)(mu + col), m1 = *(const f32x4*)(mu + col + 4);
            float s[8];
            { const float c0 = lo16(zc[k].x), c1 = hi16(zc[k].x), c2 = lo16(zc[k].y), c3 = hi16(zc[k].y), c4 = lo16(zc[k].z), c5 = hi16(zc[k].z), c6 = lo16(zc[k].w), c7 = hi16(zc[k].w);
              s[0] = c0 + (lo16(zp[k].x) - c0) * m0.x; s[1] = c1 + (hi16(zp[k].x) - c1) * m0.y; s[2] = c2 + (lo16(zp[k].y) - c2) * m0.z; s[3] = c3 + (hi16(zp[k].y) - c3) * m0.w;
              s[4] = c4 + (lo16(zp[k].z) - c4) * m1.x; s[5] = c5 + (hi16(zp[k].z) - c5) * m1.y; s[6] = c6 + (lo16(zp[k].w) - c6) * m1.z; s[7] = c7 + (hi16(zp[k].w) - c7) * m1.w; }
            bf16_t* dst;
            if (ch < 48) { dst = (l == 0) ? vfirst + (size_t)tok * 384 + 8 * ch : lin + (size_t)tok * Kl + 256 + 8 * ch; }
            else { const int c2 = 8 * (ch - 48); dst = lin + (size_t)tok * Kl + c2;
                if (c2 < 64) {
#pragma unroll
                    for (int e = 0; e < 8; ++e) s[e] = 1.0f - 2.0f * __builtin_amdgcn_rcpf(__expf(2.0f * s[e]) + 1.0f);
                } else if (c2 >= 128) {
#pragma unroll
                    for (int e = 0; e < 8; ++e) s[e] = sigmoidf_(s[e]);
                } }
            u32x4 o; o.x = pk2(s[0], s[1]); o.y = pk2(s[2], s[3]); o.z = pk2(s[4], s[5]); o.w = pk2(s[6], s[7]);
            if (okv[k]) *(u32x4*)dst = o;
        }
    }
    {
        float* ktmax = (float*)(p.ws + 512 * 1024);
        for (int item = gw; item < 96 * 32; item += ngw) { const int bh = item >> 5, tile = item & 31, b = bh / 6, h = bh % 6;
            const bf16_t* kp = z + ((size_t)b * T + tile * 64 + lane) * ZP + 1792 + h * 64; float ss = 0.f;
#pragma unroll
            for (int c8 = 0; c8 < 8; ++c8) { const u32x4 w = *(const u32x4*)(kp + 8 * c8); const float a0 = lo16(w.x), a1 = hi16(w.x), a2 = lo16(w.y), a3 = hi16(w.y), a4 = lo16(w.z), a5 = hi16(w.z), a6 = lo16(w.w), a7 = hi16(w.w);
                ss += (a0 * a0 + a1 * a1) + (a2 * a2 + a3 * a3) + (a4 * a4 + a5 * a5) + (a6 * a6 + a7 * a7); }
#pragma unroll
            for (int o = 1; o < 64; o <<= 1) ss = fmaxf(ss, __shfl_xor(ss, o));
            if (lane == 0) ktmax[item] = sqrtf(ss); }
    }
    if (gw < 96) {
        const int b = gw / 6, h = gw % 6; const float* fl = (const float*)(p.ws + WS_FL); float* cb = (float*)(p.ws + WS_CBUF) + (size_t)gw * T;
        const float fb = p.in[19][l * 6 + h]; float carry = 0.f;
        for (int i0 = 0; i0 < 32; i0 += 8) {
            float fv[8];
#pragma unroll
            for (int i = 0; i < 8; ++i) fv[i] = fl[(size_t)(b * T + 64 * (i0 + i) + lane) * 8 + h];
#pragma unroll
            for (int i = 0; i < 8; ++i) {
                float v = logsigmoidf_(fv[i] + fb);
#pragma unroll
                for (int o = 1; o < 64; o <<= 1) { const float u = __shfl_up(v, o); if (lane >= o) v += u; }
                v += carry; cb[64 * (i0 + i) + lane] = v * LOG2E; carry = __shfl(v, 63);
            }
        }
    }
}

typedef float f32x2 __attribute__((ext_vector_type(2)));
__device__ __forceinline__ void rwkv_prep2(const Params& p, int l, int gw, int ngw, int lane) {
    const bf16_t* z = (const bf16_t*)(p.ws + WS_R1); bf16_t* lo = (bf16_t*)(p.ws + WS_R2); const bf16_t* vfirst = (const bf16_t*)(p.ws + WS_VFIRST);
    bf16_t* rk = (bf16_t*)p.out; bf16_t* vfin = (bf16_t*)(p.ws + WS_VFIN); float* gend = (float*)(p.ws + WS_GEND); float* scal = (float*)(p.ws + WS_SCAL);
    const int Nl = l ? 1536 : 1280;
    for (int item = gw; item < NB * 256 * 6; item += ngw) {
        const int h = item % 6, bw = item / 6, b = bw >> 8, win = bw & 255; const int hj = h * 64 + lane;
        const float mu_r = p.in[5][l * A_COLS + hj], mu_k = p.in[5][l * A_COLS + 384 + hj], mu_v = p.in[5][l * A_COLS + 768 + hj];
        const float w0 = p.in[6][l * 384 + hj], a0 = p.in[8][l * 384 + hj], k_k = p.in[11][l * 384 + hj], k_a = p.in[12][l * 384 + hj], r_k = p.in[13][l * 384 + hj];
        const float vbias = l ? p.in[16][hj] : 0.f;
        const size_t tok0 = (size_t)b * T + 8 * win;
        float pr = 0.f, pk = 0.f, pv = 0.f;
        if (win > 0) { const bf16_t* zq = z + (tok0 - 1) * ZP; pr = bf2f(zq[hj]); pk = bf2f(zq[384 + hj]); pv = bf2f(zq[768 + hj]); }
        float zr[8], zk[8], zv[8], wl[8], al[8], vl[8], vf[8];
#pragma unroll
        for (int i = 0; i < 8; ++i) { const size_t tok = tok0 + i; const bf16_t* zp_ = z + tok * ZP; const bf16_t* lor = lo + tok * Nl;
            zr[i] = bf2f(zp_[hj]); zk[i] = bf2f(zp_[384 + hj]); zv[i] = bf2f(zp_[768 + hj]); wl[i] = bf2f(lor[hj]); al[i] = bf2f(lor[384 + hj]);
            vl[i] = 0.f; vf[i] = 0.f; if (l) { vl[i] = bf2f(lor[1152 + hj]); vf[i] = bf2f(vfirst[tok * 384 + hj]); } }
        float G = 1.0f;
#pragma unroll
        for (int i = 0; i < 8; ++i) { const size_t tok = tok0 + i;
            const float r = zr[i] + (pr - zr[i]) * mu_r, k = zk[i] + (pk - zk[i]) * mu_k; float v = zv[i] + (pv - zv[i]) * mu_v;
            pr = zr[i]; pk = zk[i]; pv = zv[i];
            if (l) v = v + (vf[i] - v) * sigmoidf_(vbias + vl[i]);
            const float xw = w0 + wl[i];
            const float wlog = -(fmaxf(-xw, 0.f) + __logf(1.0f + __expf(-fabsf(xw)))) - 0.5f;
            const float dec = __expf(-__expf(wlog));
            const float a = sigmoidf_(a0 + al[i]);
            float kk = k * k_k; const float n2 = wave_sum(kk * kk); kk *= rsqrtf(fmaxf(n2, 1e-24f));
            const float k2 = k * (1.0f + (a - 1.0f) * k_a);
            const float bvv = kk * a;
            const float br = wave_sum(bvv * r), kr = wave_sum(k2 * r), bon = wave_sum(r * k2 * r_k);
            const float Gp = G; G = Gp * dec; const float iG = __builtin_amdgcn_rcpf(G);
            lo[tok * Nl + hj] = (bf16_t)f2bf(-kk * Gp); lo[tok * Nl + 384 + hj] = (bf16_t)f2bf(bvv * iG);
            rk[tok * 768 + hj] = (bf16_t)f2bf(r * G); rk[tok * 768 + 384 + hj] = (bf16_t)f2bf(k2 * iG);
            vfin[tok * 384 + hj] = (bf16_t)f2bf(v);
            if (lane == 0) *(f32x4*)(scal + (tok * 6 + h) * 4) = (f32x4){br, kr, bon, 0.f};
        }
        gend[(tok0 >> 3) * 384 + hj] = G;
    }
}

#define DPP_ADD(x, ctrl) ((x) + __int_as_float(__builtin_amdgcn_update_dpp(0, __float_as_int(x), (ctrl), 0xF, 0xF, true)))
__device__ __forceinline__ float red8(float x) { x = DPP_ADD(x, 0xB1); x = DPP_ADD(x, 0x4E); x = DPP_ADD(x, 0x141); return x; }
__device__ __forceinline__ f32x2 fma2(f32x2 a, f32x2 b, f32x2 c) { return __builtin_elementwise_fma(a, b, c); }
#define SCAN_BAR() asm volatile("s_waitcnt vmcnt(0) lgkmcnt(0)\n\ts_barrier" ::: "memory")
#define SCAN_BAR_L() asm volatile("s_waitcnt lgkmcnt(0)\n\ts_barrier" ::: "memory")

__device__ __forceinline__ void scan_unit(const Params& p, int l, int bh, unsigned char* ldsb, int tid, int lane, int wave, bool store) {
    const int b = bh / 6, h = bh % 6;
    constexpr int BUFSZ = 6 * 2048 + 128 + 256;
    float* base = (float*)ldsb; float* Ybase = base + 2 * BUFSZ;
    if (wave < 4) {
        const int rp = tid >> 3, cgp = tid & 7;
        f32x2 Sa0 = {0.f, 0.f}, Sa1 = Sa0, Sa2 = Sa0, Sa3 = Sa0, Sb0 = Sa0, Sb1 = Sa0, Sb2 = Sa0, Sb3 = Sa0;
        SCAN_BAR();
        for (int c = 0; c < T / 32; ++c) {
            const float* buf = base + (c & 1) * BUFSZ; float* Y = Ybase + (c & 1) * 2048;
            const float* AT = buf; const float* RT = buf + 2048; const float* BH = buf + 4096; const float* KH = buf + 6144; const float* Vv = buf + 8192; const float* SC = buf + 12288; const float* GE = buf + 12416;
#define SCAN_LD(X, tt_) do { const int t_ = (tt_) < 32 ? (tt_) : 31; const int o_ = t_ * 64 + 8 * cgp; \
                X##a0 = *(const f32x4*)(AT + o_); X##a1 = *(const f32x4*)(AT + o_ + 4); X##q0 = *(const f32x4*)(RT + o_); X##q1 = *(const f32x4*)(RT + o_ + 4); \
                X##b0 = *(const f32x4*)(BH + o_); X##b1 = *(const f32x4*)(BH + o_ + 4); X##k0 = *(const f32x4*)(KH + o_); X##k1 = *(const f32x4*)(KH + o_ + 4); \
                X##va = Vv[t_ * 64 + rp]; X##vb = Vv[t_ * 64 + rp + 32]; X##br = SC[t_ * 4]; X##kr = SC[t_ * 4 + 1]; } while (0)
#define SCAN_STEP(X, tt_) do { \
                f32x2 t0 = Sa0 * X##a0.xy; t0 = fma2(Sa1, X##a0.zw, t0); t0 = fma2(Sa2, X##a1.xy, t0); t0 = fma2(Sa3, X##a1.zw, t0); \
                f32x2 t1 = Sb0 * X##a0.xy; t1 = fma2(Sb1, X##a0.zw, t1); t1 = fma2(Sb2, X##a1.xy, t1); t1 = fma2(Sb3, X##a1.zw, t1); \
                f32x2 u0 = Sa0 * X##q0.xy; u0 = fma2(Sa1, X##q0.zw, u0); u0 = fma2(Sa2, X##q1.xy, u0); u0 = fma2(Sa3, X##q1.zw, u0); \
                f32x2 u1 = Sb0 * X##q0.xy; u1 = fma2(Sb1, X##q0.zw, u1); u1 = fma2(Sb2, X##q1.xy, u1); u1 = fma2(Sb3, X##q1.zw, u1); \
                const float sa = red8(t0.x + t0.y), sb = red8(t1.x + t1.y), ya = red8(u0.x + u0.y), yb = red8(u1.x + u1.y); \
                const f32x2 sav = {sa, sa}, sbv = {sb, sb}, vav = {X##va, X##va}, vbv = {X##vb, X##vb}; \
                Sa0 = fma2(sav, X##b0.xy, fma2(vav, X##k0.xy, Sa0)); Sa1 = fma2(sav, X##b0.zw, fma2(vav, X##k0.zw, Sa1)); Sa2 = fma2(sav, X##b1.xy, fma2(vav, X##k1.xy, Sa2)); Sa3 = fma2(sav, X##b1.zw, fma2(vav, X##k1.zw, Sa3)); \
                Sb0 = fma2(sbv, X##b0.xy, fma2(vbv, X##k0.xy, Sb0)); Sb1 = fma2(sbv, X##b0.zw, fma2(vbv, X##k0.zw, Sb1)); Sb2 = fma2(sbv, X##b1.xy, fma2(vbv, X##k1.xy, Sb2)); Sb3 = fma2(sbv, X##b1.zw, fma2(vbv, X##k1.zw, Sb3)); \
                const float y0_ = ya + sa * X##br + X##va * X##kr, y1_ = yb + sb * X##br + X##vb * X##kr; \
                if (cgp == 0) { Y[(tt_) * 64 + rp] = y0_; Y[(tt_) * 64 + rp + 32] = y1_; } } while (0)
            f32x4 Pa0, Pa1, Pq0, Pq1, Pb0, Pb1, Pk0, Pk1, Qa0, Qa1, Qq0, Qq1, Qb0, Qb1, Qk0, Qk1; float Pva, Pvb, Pbr, Pkr, Qva, Qvb, Qbr, Qkr;
            SCAN_LD(P, 0);
#pragma unroll 1
            for (int w8 = 0; w8 < 4; ++w8) {
#pragma unroll
                for (int s = 0; s < 8; s += 2) {
                    const int tt = w8 * 8 + s;
                    SCAN_LD(Q, tt + 1); __builtin_amdgcn_sched_barrier(0);
                    SCAN_STEP(P, tt); __builtin_amdgcn_sched_barrier(0);
                    SCAN_LD(P, tt + 2); __builtin_amdgcn_sched_barrier(0);
                    SCAN_STEP(Q, tt + 1); __builtin_amdgcn_sched_barrier(0);
                }
                const f32x4 g0 = *(const f32x4*)(GE + w8 * 64 + 8 * cgp), g1 = *(const f32x4*)(GE + w8 * 64 + 8 * cgp + 4);
                Sa0 *= g0.xy; Sa1 *= g0.zw; Sa2 *= g1.xy; Sa3 *= g1.zw; Sb0 *= g0.xy; Sb1 *= g0.zw; Sb2 *= g1.xy; Sb3 *= g1.zw;
            }
#undef SCAN_LD
#undef SCAN_STEP
            SCAN_BAR();
        }
    } else {
        bf16_t* z = (bf16_t*)(p.ws + WS_R1); const bf16_t* lo = (const bf16_t*)(p.ws + WS_R2); const bf16_t* rk = (const bf16_t*)p.out;
        const bf16_t* vfin = (const bf16_t*)(p.ws + WS_VFIN); const float* gend = (const float*)(p.ws + WS_GEND); const float* scal = (const float*)(p.ws + WS_SCAL);
        const int Nl = l ? 1536 : 1280; const int pw = wave - 4; const int hj = h * 64 + lane;
        const float gn_g = p.in[14][l * 384 + hj], gn_b = p.in[15][l * 384 + hj];
        const int li = lane >> 3, lc = 8 * (lane & 7);
        u32x4 rAT, rBH, rGL, rRT, rKH, rV; float rGE = 0.f; f32x4 rSC = (f32x4){0.f, 0.f, 0.f, 0.f};
#define SCAN_LOAD(c_) do { const int cc = (c_); const size_t tok = (size_t)b * T + 32 * cc + 8 * pw + li; \
            rAT = *(const u32x4*)(lo + tok * Nl + h * 64 + lc); rBH = *(const u32x4*)(lo + tok * Nl + 384 + h * 64 + lc); rGL = *(const u32x4*)(lo + tok * Nl + 768 + h * 64 + lc); \
            rRT = *(const u32x4*)(rk + tok * 768 + h * 64 + lc); rKH = *(const u32x4*)(rk + tok * 768 + 384 + h * 64 + lc); rV = *(const u32x4*)(vfin + tok * 384 + h * 64 + lc); \
            rGE = gend[(((size_t)b * T + 32 * cc + 8 * pw) >> 3) * 384 + hj]; \
            if (lane < 8) rSC = *(const f32x4*)(scal + (((size_t)b * T + 32 * cc + 8 * pw + lane) * 6 + h) * 4); } while (0)
#define SCAN_ST1(arr_, reg_) do { float* d_ = buf + (arr_) + (8 * pw + li) * 64 + lc; \
            *(f32x4*)d_ = (f32x4){lo16(reg_.x), hi16(reg_.x), lo16(reg_.y), hi16(reg_.y)}; *(f32x4*)(d_ + 4) = (f32x4){lo16(reg_.z), hi16(reg_.z), lo16(reg_.w), hi16(reg_.w)}; } while (0)
#define SCAN_STORE(c_) do { const int cc = (c_); float* buf = base + (cc & 1) * BUFSZ; \
            SCAN_ST1(0, rAT); SCAN_ST1(2048, rRT); SCAN_ST1(4096, rBH); SCAN_ST1(6144, rKH); SCAN_ST1(8192, rV); SCAN_ST1(10240, rGL); \
            buf[12416 + pw * 64 + lane] = rGE; if (lane < 8) *(f32x4*)(buf + 12288 + (8 * pw + lane) * 4) = rSC; } while (0)
#define SCAN_POST(c_) do { const int cc = (c_); const float* buf = base + (cc & 1) * BUFSZ; const float* Y = Ybase + (cc & 1) * 2048; \
            _Pragma("unroll") for (int i = 0; i < 8; ++i) { const int tt = 8 * pw + i; const int o = tt * 64 + lane; const float y = Y[o]; \
                const float mean = wave_sum(y) * (1.0f / 64.0f); const float d = y - mean; const float var = wave_sum(d * d) * (1.0f / 64.0f); \
                const float yn = d * rsqrtf(var + GN_EPS) * gn_g + gn_b; \
                const float outv = (yn + buf[12288 + tt * 4 + 2] * buf[8192 + o]) * buf[10240 + o]; \
                if (store) z[((size_t)b * T + 32 * cc + tt) * ZP + hj] = (bf16_t)f2bf(outv); } } while (0)
        SCAN_LOAD(0);
        SCAN_STORE(0);
        SCAN_LOAD(1);
        SCAN_BAR_L();
        for (int c = 0; c < T / 32; ++c) {
            if (c > 0) SCAN_POST(c - 1);
            if (c + 1 < T / 32) SCAN_STORE(c + 1);
            if (c + 2 < T / 32) SCAN_LOAD(c + 2);
            SCAN_BAR_L();
        }
        SCAN_POST(T / 32 - 1);
#undef SCAN_LOAD
#undef SCAN_ST1
#undef SCAN_STORE
#undef SCAN_POST
    }
    __syncthreads();
}

template <int HD, int MODE>
__device__ __forceinline__ void attn_unit(unsigned char* ldsb, const bf16_t* Qg, int qpitch, const bf16_t* Kg, const bf16_t* Vg, int kvpitch, bf16_t* Og, int q0, int nkeys, const float* cseq, float scale,
                                          int tid, int lane, int wave, bool store) {
    constexpr int KP = (HD + 8) * 2;
    constexpr int VP = 72 * 2;
    constexpr int NCH = HD / 64;
    constexpr int NKB = HD / 32, NDT = HD / 16;
    unsigned char* Ks = ldsb; unsigned char* Vts = ldsb + 64 * KP; float* cs = (float*)(Vts + HD * VP);
    const int r16 = lane & 15, fq = lane >> 4;
    const int qrow = q0 + 16 * wave + r16;
    bf16x8 qf[NKB];
#pragma unroll
    for (int kb = 0; kb < NKB; ++kb) qf[kb] = *(const bf16x8*)(Qg + (size_t)qrow * qpitch + 32 * kb + 8 * fq);
    f32x4 o[NDT];
#pragma unroll
    for (int dt = 0; dt < NDT; ++dt) o[dt] = (f32x4){0.f, 0.f, 0.f, 0.f};
    float m_run = -INFINITY, l_part = 0.f, Rtot = 0.f;
    float cq = 0.f; if (MODE == 0) cq = cseq[qrow];
    const int ntiles = (MODE == 2) ? nkeys / 64 : (q0 + 128) / 64;
    u32x4 kreg[NCH], vreg[NCH]; float creg = 0.f;
#define ATT_ISSUE(tt_) do { const int k0_ = (tt_) * 64; \
        _Pragma("unroll") for (int it = 0; it < NCH; ++it) { const int ci = tid + 512 * it; const int row = ci / (HD / 8), ch = ci % (HD / 8); \
            kreg[it] = *(const u32x4*)(Kg + (size_t)(k0_ + row) * kvpitch + 8 * ch); \
            vreg[it] = *(const u32x4*)(Vg + (size_t)((tid >> 3) + 64 * it) * 256 + k0_ + 8 * (tid & 7)); } \
        if (MODE == 0 && tid < 64) creg = cseq[k0_ + tid]; } while (0)
    int t = (MODE == 1) ? ntiles - 1 : 0;
    ATT_ISSUE(t);
    for (int it_ = 0; it_ < ntiles; ++it_) {
        BAR_LGKM();
#pragma unroll
        for (int it = 0; it < NCH; ++it) { const int ci = tid + 512 * it; const int row = ci / (HD / 8), ch = ci % (HD / 8);
            *(u32x4*)(Ks + row * KP + ch * 16) = kreg[it];
            unsigned char* vp_ = Vts + ((tid >> 3) + 64 * it) * VP + (32 * ((tid & 7) >> 2) + 16 * (tid & 1) + 4 * ((tid >> 1) & 1)) * 2; const u32x4 v = vreg[it];
            *(u32x2*)vp_ = (u32x2){v.x, v.y}; *(u32x2*)(vp_ + 16) = (u32x2){v.z, v.w}; }
        if (MODE == 0 && tid < 64) cs[tid] = creg;
        BAR_LGKM();
        const int k0 = t * 64;
        const int tn = (MODE == 1) ? t - 1 : t + 1;
        if (it_ + 1 < ntiles) ATT_ISSUE(tn);
        f32x4 s[4];
#pragma unroll
        for (int j = 0; j < 4; ++j) { s[j] = (f32x4){0.f, 0.f, 0.f, 0.f};
#pragma unroll
            for (int kb = 0; kb < NKB; ++kb) { const bf16x8 a = *(const bf16x8*)(Ks + (16 * j + r16) * KP + (32 * kb + 8 * fq) * 2); s[j] = __builtin_amdgcn_mfma_f32_16x16x32_bf16(a, qf[kb], s[j], 0, 0, 0); } }
        if (MODE == 0 || MODE == 2) {
            float tmax = -INFINITY;
#pragma unroll
            for (int j = 0; j < 4; ++j) {
                f32x4 ck = (f32x4){0.f, 0.f, 0.f, 0.f}; if (MODE == 0) ck = *(const f32x4*)(cs + 16 * j + 4 * fq);
#pragma unroll
                for (int i = 0; i < 4; ++i) { float v = s[j][i] * scale; if (MODE == 0) { v += (cq - ck[i]) * LOG2E; if (k0 + 16 * j + 4 * fq + i > qrow) v = -INFINITY; } s[j][i] = v; tmax = fmaxf(tmax, v); } }
            tmax = fmaxf(tmax, __shfl_xor(tmax, 16)); tmax = fmaxf(tmax, __shfl_xor(tmax, 32));
            const float mnew = fmaxf(m_run, tmax); const float alpha = __builtin_amdgcn_exp2f(m_run - mnew); m_run = mnew;
            float ps = 0.f;
#pragma unroll
            for (int j = 0; j < 4; ++j)
#pragma unroll
                for (int i = 0; i < 4; ++i) { const float pv = __builtin_amdgcn_exp2f(s[j][i] - mnew); s[j][i] = pv; ps += pv; }
            l_part = l_part * alpha + ps;
#pragma unroll
            for (int dt = 0; dt < NDT; ++dt) o[dt] = o[dt] * alpha;
        } else {
            float lr[4][4], ls[4][4], g[4];
#pragma unroll
            for (int j = 0; j < 4; ++j) { g[j] = 0.f;
#pragma unroll
                for (int i = 0; i < 4; ++i) { const float lg = s[j][i] * scale; const float lsg = logsigmoidf_(lg); const bool valid = (k0 + 16 * j + 4 * fq + i) < qrow;
                    ls[j][i] = lsg; lr[j][i] = valid ? lsg - lg : 0.f; g[j] += lr[j][i]; } }
            float suffix = Rtot;
#pragma unroll
            for (int j = 3; j >= 0; --j) {
                const float ga = g[j], gb = __shfl_xor(ga, 16), gc = __shfl_xor(ga, 32), gd = __shfl_xor(ga, 48);
                const float within = (fq == 0) ? (gb + gc + gd) : (fq == 1) ? (gc + gd) : (fq == 2) ? gb : 0.f;
                float run = suffix + within;
#pragma unroll
                for (int i = 3; i >= 0; --i) { const bool valid = (k0 + 16 * j + 4 * fq + i) < qrow; s[j][i] = valid ? __expf(ls[j][i] + run) : 0.f; run += lr[j][i]; }
                suffix += (ga + gb) + (gc + gd);
            }
            Rtot = suffix;
        }
        bf16x8 pf[2];
#pragma unroll
        for (int kvb = 0; kvb < 2; ++kvb) { u32x4 w; w.x = pk2(s[2 * kvb][0], s[2 * kvb][1]); w.y = pk2(s[2 * kvb][2], s[2 * kvb][3]); w.z = pk2(s[2 * kvb + 1][0], s[2 * kvb + 1][1]); w.w = pk2(s[2 * kvb + 1][2], s[2 * kvb + 1][3]);
            pf[kvb] = __builtin_bit_cast(bf16x8, w); }
#pragma unroll
        for (int dt = 0; dt < NDT; ++dt)
#pragma unroll
            for (int kvb = 0; kvb < 2; ++kvb) { const bf16x8 a = *(const bf16x8*)(Vts + (16 * dt + r16) * VP + (32 * kvb + 8 * fq) * 2); o[dt] = __builtin_amdgcn_mfma_f32_16x16x32_bf16(a, pf[kvb], o[dt], 0, 0, 0); }
        if (MODE == 1) { if (__syncthreads_and(Rtot < -105.0f)) break; }
        t = tn;
    }
    float inv = 1.0f;
    if (MODE != 1) { float lt = l_part; lt += __shfl_xor(lt, 16); lt += __shfl_xor(lt, 32); inv = 1.0f / lt; }
#pragma unroll
    for (int dt = 0; dt < NDT; ++dt) { const f32x4 v = o[dt] * inv; u32x2 w; w.x = pk2(v.x, v.y); w.y = pk2(v.z, v.w);
        if (store) *(u32x2*)(Og + (size_t)qrow * qpitch + 16 * dt + 4 * fq) = w; }
    __syncthreads();
#undef ATT_ISSUE
}

typedef float f32x16 __attribute__((ext_vector_type(16)));
__device__ __forceinline__ int crow_(int r, int hi) { return (r & 3) + 8 * (r >> 2) + 4 * hi; }
template <int MODE>
__device__ __forceinline__ void attn64_unit(unsigned char* ldsb, const bf16_t* Qg, const bf16_t* Kg, const bf16_t* Vg, int pitch, bf16_t* Og, int q0, const float* cseq, float scale,
                                            int tid, int lane, int wave, bool store, const float* ktmax = nullptr) {
    constexpr int KP = 144, VP = 144, BUF = 64 * KP + 64 * VP + 256;
    const int r32 = lane & 31, hi = lane >> 5;
    const int qrow = q0 + 32 * wave + r32;
    bf16x8 qf[4];
#pragma unroll
    for (int ks = 0; ks < 4; ++ks) qf[ks] = *(const bf16x8*)(Qg + (size_t)qrow * pitch + 16 * ks + 8 * hi);
    f32x16 o0, o1;
#pragma unroll
    for (int r = 0; r < 16; ++r) { o0[r] = 0.f; o1[r] = 0.f; }
    float m_run = -INFINITY, l_part = 0.f, Rtot = 0.f;
    float cq = 0.f; if (MODE == 0) cq = cseq[qrow];
    float qs = 0.f;
    float* pmx = (float*)(ldsb + 2 * BUF);
    if (MODE == 0) {
        float ss = 0.f;
#pragma unroll
        for (int ks = 0; ks < 4; ++ks)
#pragma unroll
            for (int e = 0; e < 8; ++e) { const float v = __uint_as_float((unsigned)(unsigned short)qf[ks][e] << 16); ss += v * v; }
        ss += __shfl_xor(ss, 32); qs = sqrtf(ss) * scale * 1.01f;
        if (tid < 64) { float v = tid < 32 ? ktmax[tid] : 0.f;
#pragma unroll
            for (int o = 1; o < 32; o <<= 1) { const float u = __shfl_up(v, o); if ((tid & 31) >= o) v = fmaxf(v, u); }
            if (tid < 32) { pmx[tid] = v * 1.01f; pmx[64 + tid] = tid ? cseq[64 * tid - 1] : 0.f; } }
    }
    const int ntiles = (q0 + 256) / 64;
    const int qlo = q0 + 32 * wave;
    u32x4 kregA = (u32x4){0u, 0u, 0u, 0u}, vregA = kregA, kregB = kregA, vregB = kregA; float cregA = 0.f, cregB = 0.f;
    const int krow = tid >> 3, kch = tid & 7, vrow = tid & 63, vch = tid >> 6;
    const int vperm = (vrow & 0x33) | ((vrow & 4) << 1) | ((vrow & 8) >> 1);
#define A64_ISSUE(S, tt_) do { const int k0_ = (tt_) * 64; \
        kreg##S = *(const u32x4*)(Kg + (size_t)(k0_ + krow) * pitch + 8 * kch); vreg##S = *(const u32x4*)(Vg + (size_t)(k0_ + vrow) * pitch + 8 * vch); \
        if (MODE == 0 && tid < 64) creg##S = cseq[k0_ + tid]; } while (0)
#define A64_STORE(S, b_) do { unsigned char* B_ = ldsb + (b_) * BUF; *(u32x4*)(B_ + krow * KP + kch * 16) = kreg##S; \
        bf16_t* vd = (bf16_t*)(B_ + 64 * KP + (8 * vch) * VP + vperm * 2); const u32x4 v = vreg##S; \
        vd[0 * 72] = (bf16_t)(v.x & 0xffffu); vd[1 * 72] = (bf16_t)(v.x >> 16); vd[2 * 72] = (bf16_t)(v.y & 0xffffu); vd[3 * 72] = (bf16_t)(v.y >> 16); \
        vd[4 * 72] = (bf16_t)(v.z & 0xffffu); vd[5 * 72] = (bf16_t)(v.z >> 16); vd[6 * 72] = (bf16_t)(v.w & 0xffffu); vd[7 * 72] = (bf16_t)(v.w >> 16); \
        if (MODE == 0 && tid < 64) ((float*)(B_ + 64 * KP + 64 * VP))[tid] = creg##S; } while (0)
    int t = ntiles - 1;
    const int dt_ = -1;
    A64_ISSUE(A, t);
    A64_ISSUE(B, t + dt_);
    A64_STORE(A, 0);
    A64_ISSUE(A, t + 2 * dt_);
    int* vt = (int*)(ldsb + 2 * BUF + 512);
    BAR_LGKM();
    bool leave = false;
    for (int it0 = 0; it0 < ntiles && !leave; it0 += 2) {
#pragma unroll
    for (int half = 0; half < 2; ++half) { const int it_ = it0 + half;
        const unsigned char* Bc = ldsb + half * BUF; const unsigned char* Ks = Bc; const unsigned char* Vts = Bc + 64 * KP; const float* cs = (const float*)(Bc + 64 * KP + 64 * VP);
        { const int tn3 = (t - 3 > 0) ? t - 3 : 0;
          if (half) { A64_STORE(A, 0); A64_ISSUE(A, tn3); } else { A64_STORE(B, 1); A64_ISSUE(B, tn3); } }
        const int k0 = t * 64;
        if (k0 <= qlo + 31) {
            f32x16 p0, p1;
#pragma unroll
            for (int r = 0; r < 16; ++r) { p0[r] = 0.f; p1[r] = 0.f; }
#pragma unroll
            for (int ks = 0; ks < 4; ++ks) {
                const bf16x8 a0 = *(const bf16x8*)(Ks + r32 * KP + (16 * ks + 8 * hi) * 2), a1 = *(const bf16x8*)(Ks + (32 + r32) * KP + (16 * ks + 8 * hi) * 2);
                p0 = __builtin_amdgcn_mfma_f32_32x32x16_bf16(a0, qf[ks], p0, 0, 0, 0); p1 = __builtin_amdgcn_mfma_f32_32x32x16_bf16(a1, qf[ks], p1, 0, 0, 0); }
            const bool diag = (k0 + 63 >= qlo);
            bool skip_pv = false;
            if (MODE == 0) {
#pragma unroll
                for (int g = 0; g < 4; ++g) { const f32x4 c0 = *(const f32x4*)(cs + 8 * g + 4 * hi), c1 = *(const f32x4*)(cs + 32 + 8 * g + 4 * hi);
#pragma unroll
                    for (int i = 0; i < 4; ++i) { p0[4 * g + i] = __builtin_fmaf(p0[4 * g + i], scale, cq - c0[i]); p1[4 * g + i] = __builtin_fmaf(p1[4 * g + i], scale, cq - c1[i]); } }
                if (diag) {
#pragma unroll
                    for (int r = 0; r < 16; ++r) { const int kv = k0 + crow_(r, hi); if (kv > qrow) p0[r] = -INFINITY; if (kv + 32 > qrow) p1[r] = -INFINITY; }
                }
                float tmax = fmaxf(p0[0], p1[0]);
#pragma unroll
                for (int r = 1; r < 16; ++r) tmax = fmaxf(tmax, fmaxf(p0[r], p1[r]));
                tmax = fmaxf(tmax, __shfl_xor(tmax, 32));
                skip_pv = __all(tmax < m_run - 40.0f);
                if (!skip_pv) {
                    const float mnew = fmaxf(m_run, tmax); const float mref = (mnew == -INFINITY) ? 0.f : mnew; const float alpha = __builtin_amdgcn_exp2f(m_run - mref); m_run = mnew;
                    float ps = 0.f;
#pragma unroll
                    for (int r = 0; r < 16; ++r) { p0[r] = __builtin_amdgcn_exp2f(p0[r] - mref); p1[r] = __builtin_amdgcn_exp2f(p1[r] - mref); ps += p0[r] + p1[r]; }
                    l_part = l_part * alpha + ps;
                    o0 = o0 * alpha; o1 = o1 * alpha;
                }
            } else {
                float G[8]; f32x16 l0, l1;
#pragma unroll
                for (int r = 0; r < 16; ++r) { l0[r] = p0[r] * scale; l1[r] = p1[r] * scale; p0[r] = logsigmoidf_(l0[r]); p1[r] = logsigmoidf_(l1[r]);
                    const int kv = k0 + crow_(r, hi); l0[r] = (kv < qrow) ? p0[r] - l0[r] : 0.f; l1[r] = (kv + 32 < qrow) ? p1[r] - l1[r] : 0.f; }
#pragma unroll
                for (int g = 0; g < 4; ++g) { G[g] = (l0[4 * g] + l0[4 * g + 1]) + (l0[4 * g + 2] + l0[4 * g + 3]); G[4 + g] = (l1[4 * g] + l1[4 * g + 1]) + (l1[4 * g + 2] + l1[4 * g + 3]); }
                float suffix = Rtot;
#pragma unroll
                for (int th = 1; th >= 0; --th)
#pragma unroll
                    for (int g = 3; g >= 0; --g) { const float mine = G[th * 4 + g]; const float other = __shfl_xor(mine, 32);
                        float run = suffix + (hi == 0 ? other : 0.f);
#pragma unroll
                        for (int i = 3; i >= 0; --i) { const int r = 4 * g + i; const bool valid = (k0 + 32 * th + crow_(r, hi)) < qrow;
                            const float lsg = th ? p1[r] : p0[r]; const float lrr = th ? l1[r] : l0[r];
                            const float att = valid ? __expf(lsg + run) : 0.f; run += lrr; if (th) p1[r] = att; else p0[r] = att; }
                        suffix += mine + other; }
                Rtot = suffix;
            }
            if (!skip_pv) {
            bf16x8 pf[4];
#pragma unroll
            for (int s = 0; s < 4; ++s) { u32x4 w;
                if (s < 2) { const int b8 = 8 * s; w.x = pg8::cvt_pk_bf16(p0[b8], p0[b8 + 1]); w.y = pg8::cvt_pk_bf16(p0[b8 + 2], p0[b8 + 3]); w.z = pg8::cvt_pk_bf16(p0[b8 + 4], p0[b8 + 5]); w.w = pg8::cvt_pk_bf16(p0[b8 + 6], p0[b8 + 7]); }
                else { const int b8 = 8 * (s - 2); w.x = pg8::cvt_pk_bf16(p1[b8], p1[b8 + 1]); w.y = pg8::cvt_pk_bf16(p1[b8 + 2], p1[b8 + 3]); w.z = pg8::cvt_pk_bf16(p1[b8 + 4], p1[b8 + 5]); w.w = pg8::cvt_pk_bf16(p1[b8 + 6], p1[b8 + 7]); }
                pf[s] = __builtin_bit_cast(bf16x8, w); }
#pragma unroll
            for (int s = 0; s < 4; ++s) {
                const bf16x8 v0 = *(const bf16x8*)(Vts + r32 * VP + (16 * s + 8 * hi) * 2), v1 = *(const bf16x8*)(Vts + (32 + r32) * VP + (16 * s + 8 * hi) * 2);
                o0 = __builtin_amdgcn_mfma_f32_32x32x16_bf16(v0, pf[s], o0, 0, 0, 0); o1 = __builtin_amdgcn_mfma_f32_32x32x16_bf16(v1, pf[s], o1, 0, 0, 0); }
            }
        }
        bool done = false;
        if (MODE == 1) done = Rtot < -105.0f;
        else if (t > 0) {
            const float bnd = qs * pmx[t - 1] + (cq - pmx[64 + t]); done = bnd < m_run - 40.0f; }
        { const int wall = __all(done) ? 1 : 0; if (lane == 0) vt[(it_ & 1) * 8 + wave] = wall;
          BAR_LGKM();
          const int* vv = vt + (it_ & 1) * 8; const int all8 = (vv[0] & vv[1]) & (vv[2] & vv[3]) & (vv[4] & vv[5]) & (vv[6] & vv[7]);
          if (all8) { leave = true; break; } }
        t += dt_;
    }
    }
    float inv = 1.0f;
    if (MODE == 0) { float lt = l_part; lt += __shfl_xor(lt, 32); inv = 1.0f / lt; }
#pragma unroll
    for (int g = 0; g < 4; ++g) {
        u32x2 w0, w1; w0.x = pg8::cvt_pk_bf16(o0[4 * g] * inv, o0[4 * g + 1] * inv); w0.y = pg8::cvt_pk_bf16(o0[4 * g + 2] * inv, o0[4 * g + 3] * inv);
        w1.x = pg8::cvt_pk_bf16(o1[4 * g] * inv, o1[4 * g + 1] * inv); w1.y = pg8::cvt_pk_bf16(o1[4 * g + 2] * inv, o1[4 * g + 3] * inv);
        if (store) { *(u32x2*)(Og + (size_t)qrow * pitch + 8 * g + 4 * hi) = w0; *(u32x2*)(Og + (size_t)qrow * pitch + 32 + 8 * g + 4 * hi) = w1; } }
    __syncthreads();
#undef A64_ISSUE
#undef A64_STORE
}

#define GAS __attribute__((address_space(1)))
#define LAS __attribute__((address_space(3)))
#define RLX_AGENT __ATOMIC_RELAXED, __HIP_MEMORY_SCOPE_AGENT
#define XB_TMO      128
#define XB_XCNT(j)  (256  + 64 * (j))
#define XB_XSUB(j)  (1280 + 64 * (j))
#define XB_XGEN(j)  (2304 + 64 * (j))
#define XB_TOP      3328
#define XB_TOPGEN   3392
#define XCD_BAR_WORDS 3456
#define XB_SPIN_CAP (1u << 18)

__device__ __forceinline__ unsigned xb_ld(unsigned* p)              { return __hip_atomic_load(p, __ATOMIC_RELAXED, __HIP_MEMORY_SCOPE_AGENT); }
__device__ __forceinline__ unsigned xb_add(unsigned* p, unsigned v) { return __hip_atomic_fetch_add(p, v, __ATOMIC_RELAXED, __HIP_MEMORY_SCOPE_AGENT); }
__device__ __forceinline__ unsigned xb_xcc_id() { return (unsigned)__builtin_amdgcn_s_getreg((3 << 11) | 20) & 0xFu; }
#define XB_SPIN(cond, bar) do { unsigned _sp = 0; while (cond) { __builtin_amdgcn_s_sleep(1); \
    if ((++_sp & 255u) == 0u) { if (xb_ld(&(bar)[XB_TMO])) break; if (_sp > XB_SPIN_CAP) { atomicAdd(&(bar)[XB_TMO], 1u); break; } } } } while (0)

struct XcdBarrier {
    unsigned* bar; unsigned x;
    volatile LAS unsigned* st;
};

__device__ __forceinline__ XcdBarrier xcd_barrier_post(unsigned* bar, volatile LAS unsigned* st) {
    XcdBarrier b; b.bar = bar; b.x = xb_xcc_id(); b.st = st;
    if (threadIdx.x == 0) (void)xb_add(&bar[XB_XCNT(b.x)], 1u);
    return b;
}
__device__ __forceinline__ void xcd_barrier_complete(unsigned* bar, unsigned x, unsigned& nloc, unsigned& nx) {
    const unsigned G = gridDim.x * gridDim.y * gridDim.z;
    unsigned sum, cnt, mine, sp = 0u;
    for (;;) {
        sum = 0u; cnt = 0u; mine = 0u;
#pragma unroll
        for (unsigned j = 0; j < 16; ++j) { const unsigned c = xb_ld(&bar[XB_XCNT(j)]); sum += c; cnt += (c > 0u) ? 1u : 0u; mine = (j == x) ? c : mine; }
        if (sum == G) break;
        __builtin_amdgcn_s_sleep(1);
        if ((++sp & 255u) == 0u) { if (xb_ld(&bar[XB_TMO])) break; if (sp > XB_SPIN_CAP) { atomicAdd(&bar[XB_TMO], 1u); break; } }
    }
    nloc = mine > 0u ? mine : 1u; nx = cnt > 0u ? cnt : 1u;
}

__device__ __forceinline__ void xcd_barrier(const XcdBarrier& b) {
    asm volatile("s_waitcnt vmcnt(0)" ::: "memory");
    __syncthreads();
    if (threadIdx.x == 0) {
        unsigned* bar = b.bar;
        __builtin_amdgcn_s_waitcnt(0);
        unsigned nloc = b.st[0], nx = b.st[1];
        if (nloc == 0u) { xcd_barrier_complete(bar, b.x, nloc, nx); b.st[0] = nloc; b.st[1] = nx; }
        const unsigned old = xb_add(&bar[XB_XSUB(b.x)], 1u);
        const unsigned gen = old / nloc;
        if (old + 1u == (gen + 1u) * nloc) {
            __builtin_amdgcn_fence(__ATOMIC_RELEASE, "agent");
            asm volatile("s_waitcnt vmcnt(0)" ::: "memory");
            const unsigned og = xb_add(&bar[XB_TOP], 1u);
            const unsigned tg = og / nx;
            if (og + 1u == (tg + 1u) * nx) xb_add(&bar[XB_TOPGEN], 1u);
            else XB_SPIN(xb_ld(&bar[XB_TOPGEN]) == tg, bar);
            __builtin_amdgcn_fence(__ATOMIC_ACQUIRE, "agent");
            xb_add(&bar[XB_XGEN(b.x)], 1u);
            asm volatile("s_waitcnt vmcnt(0)" ::: "memory");
        } else {
            XB_SPIN(xb_ld(&bar[XB_XGEN(b.x)]) == gen, bar);
            __builtin_amdgcn_fence(__ATOMIC_ACQUIRE, "agent");
            asm volatile("s_waitcnt vmcnt(0)" ::: "memory");
        }
    }
    __syncthreads();
}

__global__ void __launch_bounds__(NTHREADS, 2) fwd_megakernel(Params p) {
    extern __shared__ __attribute__((aligned(16))) unsigned char lds[];
    cg::grid_group grid = cg::this_grid();
    __shared__ int s_unit;
    __shared__ unsigned s_bst[2];
    if (threadIdx.x < 2) s_bst[threadIdx.x] = 0u;
    __syncthreads();
    const XcdBarrier xbar = xcd_barrier_post((unsigned*)(p.ws + WS_CTL) + 4096, (volatile LAS unsigned*)s_bst);
#define FRESH() const int tid = fresh_tid(), lane = tid & 63, wave = __builtin_amdgcn_readfirstlane(tid >> 6); const int bx = fresh_s((int)blockIdx.x), G = fresh_s((int)gridDim.x); \
    const int gw = bx * NWAVES + wave, ngw = G * NWAVES; unsigned char* ws = p.ws; PG8_LAS unsigned char* ldsl = (PG8_LAS unsigned char*)lds; \
    bf16_t* R1 = (bf16_t*)(ws + WS_R1); bf16_t* R2 = (bf16_t*)(ws + WS_R2); bf16_t* R3 = (bf16_t*)p.out; bf16_t* XB = (bf16_t*)(ws + WS_R3); bf16_t* MEMN = (bf16_t*)(ws + WS_MEMN); bf16_t* MKV = (bf16_t*)(ws + WS_MKV); float* xres = p.out; \
    (void)tid; (void)lane; (void)wave; (void)gw; (void)ngw; (void)ldsl; (void)R1; (void)R2; (void)R3; (void)XB; (void)MEMN; (void)MKV; (void)xres; (void)bx; (void)G;
#define NOSEG 1 << 30, 0, 1 << 30, 0
#ifdef PROBE_DUP_SYNC
#define GSYNC() do { xcd_barrier(xbar); xcd_barrier(xbar); } while (0)
#else
#define GSYNC() xcd_barrier(xbar)
#endif
#ifdef PROBE_DUP_GEMM
#define GEMM_REP for (int rep_ = 0; rep_ < 2; ++rep_)
#else
#define GEMM_REP
#endif
#ifdef PROBE_DUP_NORM
#define NORM_DRY(...) norm_rows(__VA_ARGS__)
#else
#define NORM_DRY(...)
#endif

    { FRESH();
#ifdef PROBE_DUP_CONV
      convert_weights(p, 0, lds, gw, ngw, lane, wave);
#endif
      convert_weights(p, 0, lds, gw, ngw, lane, wave);
      norm_rows<false, false>(gw, ngw, lane, MEMR, p.in[1], nullptr, nullptr, nullptr, p.in[23], MEMN);
      norm_rows<false, true>(gw, ngw, lane, M, p.in[0], nullptr, nullptr, XB, p.in[2], R3); }
    if (p.pad[1] == 0x5eed) grid.sync();
    GSYNC();

    for (int l = 0; l < 2; ++l) {
        { FRESH(); pg8::Gemm g{R3, (const bf16_t*)(ws + WS_WIN), M, ZP, D, D, NOSEG}; pg8::StaticOrder S; S.init(M, ZP, G, bx);
          pg8::EpiBf16 E{R1, ZP, (float*)(ws + WS_FL), 3328};
          GEMM_REP pg8::gemm_phase<pg8::EpiBf16, pg8::StaticOrder, true, true>(ldsl, g, S, E); }
        { FRESH(); pg8::Gemm g{MEMN, (const bf16_t*)(ws + WS_WKV), MEMR, D, D, D, NOSEG}; pg8::StaticOrder S; S.init(MEMR, D, G, bx);
          pg8::EpiBf16 E{MKV, 2 * D, nullptr, 0};
          GEMM_REP pg8::gemm_phase<pg8::EpiBf16, pg8::StaticOrder, true, true>(ldsl, g, S, E); }
        { FRESH(); pg8::Gemm g{MEMN, (const bf16_t*)(ws + WS_WKV) + (size_t)D * D, MEMR, D, D, D, NOSEG}; pg8::StaticOrder S; S.init(MEMR, D, G, (bx + G - 64) % G);
          pg8::EpiVT E{(bf16_t*)p.out + (size_t)32 * 1024 * 1024};
          GEMM_REP pg8::gemm_phase<pg8::EpiVT, pg8::StaticOrder, true, true>(ldsl, g, S, E); }
        GSYNC();
#ifdef PROBE_DUP_PRE
        { FRESH(); rwkv_pre(p, l, gw, ngw, lane); }
#endif
        { FRESH(); rwkv_pre(p, l, gw, ngw, lane); }
        GSYNC();
        { FRESH(); const int Kl = l ? 640 : 256, Nl = l ? 1536 : 1280;
          pg8::Gemm g{R3, (const bf16_t*)(ws + WS_WLORA), M, Nl, Kl, Kl, NOSEG}; pg8::StaticOrder S; S.init(M, Nl, G, bx);
          pg8::EpiBf16 E{R2, Nl, nullptr, 0};
          GEMM_REP pg8::gemm_phase<pg8::EpiBf16, pg8::StaticOrder, true, true>(ldsl, g, S, E); }
        GSYNC();
#ifdef PROBE_DUP_PREP2
        { FRESH(); rwkv_prep2(p, l, gw, ngw, lane); }
#endif
        { FRESH(); rwkv_prep2(p, l, gw, ngw, lane); }
        GSYNC();
#ifdef PROBE_DUP_SCAN
        { FRESH(); if (bx < 96) scan_unit(p, l, bx, lds, tid, lane, wave, p.pad[0] != 0); }
#endif
        { FRESH(); if (bx < 96) scan_unit(p, l, bx, lds, tid, lane, wave, true); }
#ifdef PROBE_DUP_ATT
        { FRESH(); unsigned* ctl = (unsigned*)(ws + WS_CTL);
        for (;;) {
            if (tid == 0) s_unit = (int)atomicAdd(&ctl[64 * (3 + l)], 1u);
            __syncthreads();
            const int u = s_unit;
            __syncthreads();
            if (u >= 768 + 512) break;
            if (u < 768) { const int qb = 7 - u / 96, bh = u % 96, b = bh / 6, h = bh % 6;
                bf16_t* base = R1 + (size_t)b * T * ZP + 1408 + h * 64;
                attn64_unit<0>(lds, base, base + 384, base + 768, ZP, base, qb * 256, (const float*)(ws + WS_CBUF) + (size_t)bh * T, 0.125f * LOG2E, tid, lane, wave, p.pad[0] != 0, (const float*)(ws + 512 * 1024) + bh * 32);
            } else { const int u2 = u - 768; const int qb = 7 - u2 / 64, bh = u2 % 64, b = bh / 4, h = bh % 4;
                bf16_t* base = R1 + (size_t)b * T * ZP + 2560 + h * 64;
                attn64_unit<1>(lds, base, base + 256, base + 512, ZP, base, qb * 256, nullptr, 0.125f, tid, lane, wave, p.pad[0] != 0);
            }
        } }
#endif
        { FRESH(); unsigned* ctl = (unsigned*)(ws + WS_CTL);
        for (;;) {
            if (tid == 0) s_unit = (int)atomicAdd(&ctl[64 * (1 + l)], 1u);
            __syncthreads();
            const int u = s_unit;
            __syncthreads();
            if (u >= 768 + 512) break;
            if (u < 768) { const int qb = 7 - u / 96, bh = u % 96, b = bh / 6, h = bh % 6;
                bf16_t* base = R1 + (size_t)b * T * ZP + 1408 + h * 64;
                attn64_unit<0>(lds, base, base + 384, base + 768, ZP, base, qb * 256, (const float*)(ws + WS_CBUF) + (size_t)bh * T, 0.125f * LOG2E, tid, lane, wave, true, (const float*)(ws + 512 * 1024) + bh * 32);
            } else { const int u2 = u - 768; const int qb = 7 - u2 / 64, bh = u2 % 64, b = bh / 4, h = bh % 4;
                bf16_t* base = R1 + (size_t)b * T * ZP + 2560 + h * 64;
                attn64_unit<1>(lds, base, base + 256, base + 512, ZP, base, qb * 256, nullptr, 0.125f, tid, lane, wave, true);
            }
        } }
        GSYNC();
        { FRESH(); pg8::Gemm g{R1, (const bf16_t*)(ws + WS_WOUT), M, D, D, ZP, 6, 2048, 12, 1536}; pg8::StaticOrder S; S.init(M, D, G, bx);
          pg8::EpiBf16 E{R2, D, nullptr, 0};
          GEMM_REP pg8::gemm_phase<pg8::EpiBf16, pg8::StaticOrder, true, true>(ldsl, g, S, E); }
        GSYNC();
        { FRESH(); norm_rows<true, true>(gw, ngw, lane, M, XB, R2, p.in[3] + l * D, XB, p.in[21] + l * D, R3); }
        GSYNC();
        { FRESH(); pg8::Gemm g{R3, (const bf16_t*)(ws + WS_WQ), M, D, D, D, NOSEG}; pg8::StaticOrder S; S.init(M, D, G, bx);
          pg8::EpiBf16 E{R1, D, nullptr, 0};
          GEMM_REP pg8::gemm_phase<pg8::EpiBf16, pg8::StaticOrder, true, true>(ldsl, g, S, E); }
        GSYNC();
#ifdef PROBE_DUP_MEM
        { FRESH();
        for (int u = bx; u < 1024; u += G) { const int qb = u & 15, bh = u >> 4, b = bh >> 2, hh = bh & 3;
            bf16_t* qbase = R1 + (size_t)b * T * D + hh * 256; const bf16_t* kbase = MKV + (size_t)b * 256 * (2 * D) + hh * 256;
            attn_unit<256, 2>(lds, qbase, D, kbase, (const bf16_t*)p.out + (size_t)32 * 1024 * 1024 + (size_t)bh * 65536, 2 * D, qbase, qb * 128, 256, nullptr, 0.0625f * LOG2E, tid, lane, wave, p.pad[0] != 0); } }
#endif
        { FRESH();
        for (int u = bx; u < 1024; u += G) { const int qb = u & 15, bh = u >> 4, b = bh >> 2, hh = bh & 3;
            bf16_t* qbase = R1 + (size_t)b * T * D + hh * 256; const bf16_t* kbase = MKV + (size_t)b * 256 * (2 * D) + hh * 256;
            attn_unit<256, 2>(lds, qbase, D, kbase, (const bf16_t*)p.out + (size_t)32 * 1024 * 1024 + (size_t)bh * 65536, 2 * D, qbase, qb * 128, 256, nullptr, 0.0625f * LOG2E, tid, lane, wave, true); } }
        GSYNC();
        { FRESH(); pg8::Gemm g{R1, (const bf16_t*)(ws + WS_WO), M, D, D, D, NOSEG}; pg8::StaticOrder S; S.init(M, D, G, bx);
          pg8::EpiBf16 E{R2, D, nullptr, 0};
          GEMM_REP pg8::gemm_phase<pg8::EpiBf16, pg8::StaticOrder, true, true>(ldsl, g, S, E); }
        GSYNC();
        { FRESH(); norm_rows<true, true>(gw, ngw, lane, M, XB, R2, p.in[22] + l * D, XB, p.in[27] + l * D, R3); }
        GSYNC();
        { FRESH(); pg8::Gemm g{R3, (const bf16_t*)(ws + WS_WGU), M, 2 * DFF, D, D, NOSEG}; pg8::StaticOrder S; S.init(M, 2 * DFF, G, bx);
          pg8::EpiSwiGLU E{R1, DFF};
          GEMM_REP pg8::gemm_phase<pg8::EpiSwiGLU, pg8::StaticOrder, true, true>(ldsl, g, S, E); }
        GSYNC();
        { FRESH(); pg8::Gemm g{R1, (const bf16_t*)(ws + WS_WDN), M, D, DFF, DFF, NOSEG}; pg8::StaticOrder S; S.init(M, D, G, bx);
          pg8::EpiBf16 E{R2, D, nullptr, 0};
          GEMM_REP pg8::gemm_phase<pg8::EpiBf16, pg8::StaticOrder, true, true>(ldsl, g, S, E); }
        GSYNC();
        if (l == 0) {
            { FRESH(); norm_rows<true, true>(gw, ngw, lane, M, XB, R2, p.in[28], XB, p.in[2] + D, R3);
#ifdef PROBE_DUP_CONV
              convert_weights(p, 1, lds, gw, ngw, lane, wave);
#endif
              convert_weights(p, 1, lds, gw, ngw, lane, wave);
              norm_rows<false, false>(gw, ngw, lane, MEMR, p.in[1], nullptr, nullptr, nullptr, p.in[23] + D, MEMN); }
            GSYNC();
        } else {
            { FRESH(); norm_rows<true, false>(gw, ngw, lane, M, XB, R2, p.in[28] + D, xres, nullptr, nullptr); }
        }
    }
}

extern "C" void kernel_launch(void* const* d_in, const int* in_sizes, int n_in, void* d_out, int out_size, void* d_ws, size_t ws_size, hipStream_t stream) {
    static int grid_blocks = 0;
    if (grid_blocks == 0) {
        if (n_in != 31 || out_size != M * D || ws_size < WS_END) { fprintf(stderr, "kernel_launch: unexpected shapes (n_in %d out %d ws %zu)\n", n_in, out_size, ws_size); grid_blocks = -1; return; }
        int dev = 0, cus = 0, per_cu = 0;
        hipGetDevice(&dev); hipDeviceGetAttribute(&cus, hipDeviceAttributeMultiprocessorCount, dev);
        if (hipFuncSetAttribute((const void*)fwd_megakernel, hipFuncAttributeMaxDynamicSharedMemorySize, LDS_BYTES) != hipSuccess) { fprintf(stderr, "kernel_launch: hipFuncSetAttribute failed\n"); grid_blocks = -1; return; }
        if (hipOccupancyMaxActiveBlocksPerMultiprocessor(&per_cu, (const void*)fwd_megakernel, NTHREADS, LDS_BYTES) != hipSuccess || per_cu < 1) { fprintf(stderr, "kernel_launch: occupancy query gave %d\n", per_cu); per_cu = 1; }
        (void)hipGetLastError();
        grid_blocks = cus * 1;
    }
    if (grid_blocks < 0) return;
    (void)hipMemsetAsync((char*)d_ws + WS_CTL, 0, 65536, stream);
    Params p{};
    for (int i = 0; i < 31; ++i) p.in[i] = (const float*)d_in[i];
    p.out = (float*)d_out; p.ws = (unsigned char*)d_ws;
    void* args[] = {&p};
    hipError_t e = hipLaunchCooperativeKernel((const void*)fwd_megakernel, dim3(grid_blocks), dim3(NTHREADS), args, LDS_BYTES, stream);
    if (e != hipSuccess) fprintf(stderr, "cooperative launch failed: %s (grid %d)\n", hipGetErrorString(e), grid_blocks);
}
```

```cpp
#include <hip/hip_runtime.h>
#include <hip/hip_cooperative_groups.h>
#include <cstdio>
#include <cstdint>
namespace cg = cooperative_groups;
__device__ __forceinline__ int fresh_tid() { int t = threadIdx.x; asm volatile("" : "+v"(t)); return t; }
__device__ __forceinline__ int fresh_s(int v) { asm volatile("" : "+s"(v)); return v; }
namespace pg8 {
#define PG8_LAS __attribute__((address_space(3)))
typedef unsigned short bf16_t;
typedef short bf16x8 __attribute__((ext_vector_type(8)));
typedef float f32x4 __attribute__((ext_vector_type(4)));
typedef unsigned u32x4 __attribute__((ext_vector_type(4)));
constexpr int BM = 256, BK = 64, HALF = 128, HTB = HALF * BK * 2  , STAGE_BYTES = 8 * HTB, NXCD = 8, WGM = 8;

__host__ __device__ __forceinline__ int lds_byte(int r, int c) { const int st = (r >> 4) * 2 + (c >> 5), rr = r & 15, cc = c & 31, ob = rr * 64 + cc * 2; return st * 1024 + (ob ^ (((ob >> 9) & 1) << 5)); }
__host__ __device__ __forceinline__ void stage_rc(int b, int& R, int& C) { const int st = b / 1024, sb = b % 1024, swz = sb ^ (((sb >> 9) & 1) << 5); R = (st >> 1) * 16 + swz / 64; C = (st & 1) * 32 + (swz % 64) / 2; }
__host__ __device__ __forceinline__ int perm32(int rho) { const int n = rho >> 4, i = rho & 15; return 8 * (i >> 2) + 4 * n + (i & 3); }

struct Unit { int pm, pn; };
struct Gemm { const bf16_t* A; const bf16_t* Bt; int M, N, K; int lda; int s1, d1, s2, d2; };

struct StaticOrder {
    int nM, nN, nwg, G, c;
    __host__ __device__ void init(int M, int N, int G_, int c_) { nM = M / BM; nN = N / BM; nwg = nM * nN; G = G_; c = c_; }
    __host__ __device__ bool next(int i, Unit& u) const {
        const long L = (long)i * G + c; if (L >= nwg) return false;
        int wgid = (int)L; { const int q = nwg / NXCD, r = nwg % NXCD, xcd = wgid % NXCD, off = wgid / NXCD; wgid = (xcd < r ? xcd * (q + 1) : r * (q + 1) + (xcd - r) * q) + off; }
        const int nig = WGM * nN, gid = wgid / nig, fm = gid * WGM, gsz = (nM - fm) < WGM ? (nM - fm) : WGM;
        u.pm = fm + ((wgid % nig) % gsz); u.pn = (wgid % nig) / gsz; return true;
    }
    __device__ __forceinline__ void a_ready(const Unit&) const {}
    __device__ __forceinline__ void done(const Unit&) const {}
};

__device__ __forceinline__ unsigned cvt_pk_bf16(float lo, float hi) { unsigned r; asm("v_cvt_pk_bf16_f32 %0, %1, %2" : "=v"(r) : "v"(lo), "v"(hi)); return r; }
typedef float f32x2 __attribute__((ext_vector_type(2)));
template <class Epi, class Sched, bool ALIGN_EPI = false, bool SP2 = false>
__device__ __forceinline__ void gemm_phase(PG8_LAS unsigned char* lds, const Gemm g, const Sched& S, const Epi& E) {
    static_assert(SP2, "only the SP2 loop carries the lda / segment changes");
    const int tid = fresh_tid(), wid = __builtin_amdgcn_readfirstlane(tid >> 6), lane = tid & 63, wr = wid >> 2, wc = wid & 3, fr = lane & 15, fq = lane >> 4;
    const int K = g.K, nt = K / BK;
    unsigned voffA[2], voffB[2];
#pragma unroll
    for (int i = 0; i < 2; ++i) { int R, C; stage_rc(tid * 16 + i * 8192, R, C); const int Rb = Epi::PERM ? ((R & ~31) + perm32(R & 31)) : R;
        voffA[i] = (unsigned)(R * g.lda + C) * 2u; voffB[i] = (unsigned)(Rb * K + C) * 2u; }
    const size_t kstep = (size_t)(BK * 2);
    const size_t hstep = (size_t)HALF * K * 2, hstepA = (size_t)HALF * g.lda * 2;
    const size_t tstep = 2 * hstep, tstepA = 2 * hstepA;
#define PG8_KA(t) ((size_t)(t) * 128 + ((t) >= g.s1 ? (size_t)g.d1 : 0) + ((t) >= g.s2 ? (size_t)g.d2 : 0))
    const unsigned ldsw = (unsigned)wid * 1024u;
    const int aoff = lds_byte(wr * 64 + fr, fq * 8), boff = lds_byte(wc * 32 + fr, fq * 8);
#define PG8_SA(b, h) (((b) * 2 + (h)) * HTB)
#define PG8_SB(b, h) ((4 + (b) * 2 + (h)) * HTB)
#define PG8_STAGE(bufoff, gbase, voff) do { _Pragma("unroll") for (int _i = 0; _i < 2; ++_i) \
        __builtin_amdgcn_global_load_lds((const unsigned*)((const char*)(gbase) + (voff)[_i]), (PG8_LAS unsigned*)(lds + (bufoff) + ldsw + _i * 8192), 16, 0, 0); } while (0)
#define PG8_LDA(dst, b, h) do { _Pragma("unroll") for (int m = 0; m < 4; ++m) _Pragma("unroll") for (int k = 0; k < 2; ++k) dst[m][k] = *(const PG8_LAS bf16x8*)(lds + PG8_SA(b, h) + aoff + m * 2048 + k * 1024); } while (0)
#define PG8_LDB(dst, b, h) do { _Pragma("unroll") for (int n = 0; n < 2; ++n) _Pragma("unroll") for (int k = 0; k < 2; ++k) dst[n][k] = *(const PG8_LAS bf16x8*)(lds + PG8_SB(b, h) + boff + n * 2048 + k * 1024); } while (0)
#define PG8_MMA(ai, bj, At, Bt) do { __builtin_amdgcn_s_setprio(1); _Pragma("unroll") for (int m = 0; m < 4; ++m) _Pragma("unroll") for (int n = 0; n < 2; ++n) _Pragma("unroll") for (int k = 0; k < 2; ++k) \
        acc[ai][bj][m][n] = __builtin_amdgcn_mfma_f32_16x16x32_bf16(Bt[n][k], At[m][k], acc[ai][bj][m][n], 0, 0, 0); __builtin_amdgcn_s_setprio(0); } while (0)
#define PG8_WAIT_V(n) asm volatile("s_waitcnt vmcnt(" #n ")" ::: "memory")
#define PG8_WAIT_L(n) asm volatile("s_waitcnt lgkmcnt(" #n ")" ::: "memory")
#define PG8_BAR __builtin_amdgcn_s_barrier()
#define PG8_SCHED __builtin_amdgcn_sched_barrier(0)
    Unit cur, nxt; int ui = 0;
    if (!S.next(0, cur)) return;
    f32x4 acc[2][2][4][2];
#pragma unroll
    for (int a = 0; a < 2; ++a)
#pragma unroll
        for (int b = 0; b < 2; ++b)
#pragma unroll
            for (int m = 0; m < 4; ++m)
#pragma unroll
                for (int n = 0; n < 2; ++n) acc[a][b][m][n] = (f32x4){0.f, 0.f, 0.f, 0.f};
    bf16x8 At[4][2], B0[2][2], B1[2][2];
    const char* cA = (const char*)g.A + (size_t)cur.pm * tstepA; const char* cB = (const char*)g.Bt + (size_t)cur.pn * tstep;
    S.a_ready(cur);
    if constexpr (SP2) {
        PG8_STAGE(PG8_SB(0, 0), cB, voffB); PG8_STAGE(PG8_SB(0, 1), cB + hstep, voffB); PG8_STAGE(PG8_SA(0, 0), cA, voffA); PG8_STAGE(PG8_SA(0, 1), cA + hstepA, voffA);
        if (wr == 1) PG8_BAR;
        PG8_WAIT_V(2); PG8_BAR;
        PG8_STAGE(PG8_SB(1, 0), cB + kstep, voffB); PG8_STAGE(PG8_SA(1, 0), cA + PG8_KA(1), voffA); PG8_STAGE(PG8_SB(1, 1), cB + hstep + kstep, voffB);
        PG8_WAIT_V(6); PG8_BAR;
    } else {
        PG8_STAGE(PG8_SB(0, 0), cB, voffB); PG8_STAGE(PG8_SA(0, 0), cA, voffA); PG8_STAGE(PG8_SB(0, 1), cB + hstep, voffB); PG8_STAGE(PG8_SA(0, 1), cA + hstep, voffA);
        if (wr == 1) PG8_BAR;
        PG8_WAIT_V(4); PG8_BAR;
        PG8_STAGE(PG8_SB(1, 0), cB + kstep, voffB); PG8_STAGE(PG8_SA(1, 0), cA + kstep, voffA); PG8_STAGE(PG8_SB(1, 1), cB + hstep + kstep, voffB);
        PG8_WAIT_V(6); PG8_BAR;
    }
    for (;;) {
        const bool has_next = S.next(ui + 1, nxt);
        const char* nA = has_next ? (const char*)g.A + (size_t)nxt.pm * tstepA : cA; const char* nB = has_next ? (const char*)g.Bt + (size_t)nxt.pn * tstep : cB;
        for (int t = 0; t < nt; t += 2) {
            const bool last = (t == nt - 2);
            const char* a1 = cA + PG8_KA(t + 1);
            const char* a2 = last ? nA : cA + PG8_KA(t + 2); const char* b2 = last ? nB : cB + (size_t)(t + 2) * kstep;
            const char* a3 = last ? nA + PG8_KA(1) : cA + PG8_KA(t + 3); const char* b3 = b2 + kstep;
            if (last && has_next) S.a_ready(nxt);
            if constexpr (SP2) {
            PG8_LDB(B0, 0, 0); PG8_LDB(B1, 0, 1); PG8_SCHED; PG8_LDA(At, 0, 0); PG8_STAGE(PG8_SA(1, 1), a1 + hstepA, voffA);
            PG8_WAIT_V(8); PG8_WAIT_L(0); PG8_BAR; PG8_MMA(0, 0, At, B0); PG8_MMA(0, 1, At, B1); PG8_BAR; PG8_SCHED;
            PG8_LDA(At, 0, 1); PG8_STAGE(PG8_SB(0, 0), b2, voffB); PG8_STAGE(PG8_SB(0, 1), b2 + hstep, voffB); PG8_STAGE(PG8_SA(0, 0), a2, voffA);
            PG8_WAIT_V(8); PG8_WAIT_L(0); PG8_BAR; PG8_MMA(1, 0, At, B0); PG8_MMA(1, 1, At, B1); PG8_BAR; PG8_SCHED;
            PG8_LDB(B0, 1, 0); PG8_LDB(B1, 1, 1); PG8_SCHED; PG8_LDA(At, 1, 0); PG8_STAGE(PG8_SA(0, 1), a2 + hstepA, voffA);
            PG8_WAIT_V(8); PG8_WAIT_L(0); PG8_BAR; PG8_MMA(0, 0, At, B0); PG8_MMA(0, 1, At, B1); PG8_BAR; PG8_SCHED;
            PG8_LDA(At, 1, 1); PG8_STAGE(PG8_SB(1, 0), b3, voffB); PG8_STAGE(PG8_SB(1, 1), b3 + hstep, voffB); PG8_STAGE(PG8_SA(1, 0), a3, voffA);
            PG8_WAIT_V(8); PG8_WAIT_L(0); PG8_BAR; PG8_MMA(1, 0, At, B0); PG8_MMA(1, 1, At, B1); PG8_BAR; PG8_SCHED;
            } else {
            PG8_LDB(B0, 0, 0); PG8_SCHED; PG8_LDA(At, 0, 0); PG8_STAGE(PG8_SA(1, 1), a1 + hstep, voffA);
            PG8_WAIT_L(8); PG8_BAR; PG8_WAIT_L(0); PG8_MMA(0, 0, At, B0); PG8_BAR; PG8_SCHED;
            PG8_LDB(B1, 0, 1); PG8_STAGE(PG8_SB(0, 0), b2, voffB);
            PG8_BAR; PG8_WAIT_L(0); PG8_MMA(0, 1, At, B1); PG8_BAR;
            PG8_LDA(At, 0, 1); PG8_STAGE(PG8_SA(0, 0), a2, voffA);
            PG8_BAR; PG8_WAIT_L(0); PG8_MMA(1, 0, At, B0); PG8_BAR; PG8_SCHED;
            PG8_STAGE(PG8_SB(0, 1), b2 + hstep, voffB);
            PG8_WAIT_V(6); PG8_BAR; PG8_MMA(1, 1, At, B1); PG8_BAR;
            PG8_LDB(B0, 1, 0); PG8_SCHED; PG8_LDA(At, 1, 0); PG8_STAGE(PG8_SA(0, 1), a2 + hstep, voffA);
            PG8_WAIT_L(8); PG8_BAR; PG8_WAIT_L(0); PG8_MMA(0, 0, At, B0); PG8_BAR; PG8_SCHED;
            PG8_LDB(B1, 1, 1); PG8_STAGE(PG8_SB(1, 0), b3, voffB);
            PG8_BAR; PG8_WAIT_L(0); PG8_MMA(0, 1, At, B1); PG8_BAR;
            PG8_LDA(At, 1, 1); PG8_STAGE(PG8_SA(1, 0), a3, voffA);
            PG8_BAR; PG8_WAIT_L(0); PG8_MMA(1, 0, At, B0); PG8_BAR; PG8_SCHED;
            PG8_STAGE(PG8_SB(1, 1), b3 + hstep, voffB);
            PG8_WAIT_V(6); PG8_BAR; PG8_MMA(1, 1, At, B1); PG8_BAR;
            }
        }
        if constexpr (ALIGN_EPI) { if (wr == 0) PG8_BAR; }
        if constexpr (!Epi::AFTER_DRAIN) { E(acc, cur, wr, wc, fr, fq); S.done(cur); }
        if (!has_next) break;
#pragma unroll
        for (int a = 0; a < 2; ++a)
#pragma unroll
            for (int b = 0; b < 2; ++b)
#pragma unroll
                for (int m = 0; m < 4; ++m)
#pragma unroll
                    for (int n = 0; n < 2; ++n) acc[a][b][m][n] = (f32x4){0.f, 0.f, 0.f, 0.f};
        cur = nxt; cA = nA; cB = nB; ++ui;
        if constexpr (ALIGN_EPI) { if (wr == 1) PG8_BAR; }
    }
    PG8_WAIT_V(0);
    if constexpr (!ALIGN_EPI) { if (wr == 0) PG8_BAR; }
    PG8_BAR;
    if constexpr (Epi::AFTER_DRAIN) { E.fused(acc, cur, wr, wc, fr, fq, lds, wid, lane); S.done(cur); }
#undef PG8_SA
#undef PG8_KA
#undef PG8_SB
#undef PG8_STAGE
#undef PG8_LDA
#undef PG8_LDB
#undef PG8_MMA
#undef PG8_WAIT_V
#undef PG8_WAIT_L
#undef PG8_BAR
#undef PG8_SCHED
}
}

namespace pg8 {
struct EpiBf16 {
    static constexpr bool PERM = true, AFTER_DRAIN = false;
    bf16_t* O; int ldc; float* fl; int flcol;
    __device__ __forceinline__ void operator()(const f32x4 (&acc)[2][2][4][2], const Unit& u, int wr, int wc, int fr, int fq) const {
        const int row0 = u.pm * BM + wr * 64 + fr; const int colt = u.pn * BM; const int col0 = colt + wc * 32 + 8 * fq;
#pragma unroll
        for (int ai = 0; ai < 2; ++ai)
#pragma unroll
            for (int m = 0; m < 4; ++m) { bf16_t* rowp = O + (size_t)(row0 + ai * HALF + m * 16) * ldc + col0;
#pragma unroll
                for (int bj = 0; bj < 2; ++bj) { const f32x4 v0 = acc[ai][bj][m][0], v1 = acc[ai][bj][m][1];
                    u32x4 w; w.x = cvt_pk_bf16(v0[0], v0[1]); w.y = cvt_pk_bf16(v0[2], v0[3]); w.z = cvt_pk_bf16(v1[0], v1[1]); w.w = cvt_pk_bf16(v1[2], v1[3]);
                    *(u32x4*)(rowp + bj * HALF) = w; } }
        if (fl != nullptr && colt == flcol && wc == 0 && fq == 0) {
#pragma unroll
            for (int ai = 0; ai < 2; ++ai)
#pragma unroll
                for (int m = 0; m < 4; ++m) { float* p = fl + (size_t)(row0 + ai * HALF + m * 16) * 8; *(f32x4*)p = acc[ai][0][m][0]; *(f32x4*)(p + 4) = acc[ai][0][m][1]; }
        }
    }
};

struct EpiVT {
    static constexpr bool PERM = true, AFTER_DRAIN = false;
    bf16_t* VT;
    __device__ __forceinline__ void operator()(const f32x4 (&acc)[2][2][4][2], const Unit& u, int wr, int wc, int fr, int fq) const {
        {
            bf16_t* lanebase = VT + (size_t)(u.pm * 4 + u.pn) * 65536 + (size_t)(wc * 32 + 8 * fq) * 256 + wr * 64 + fr;
#pragma unroll
            for (int ai = 0; ai < 2; ++ai)
#pragma unroll
                for (int m = 0; m < 4; ++m) { bf16_t* pk = lanebase + ai * HALF + m * 16; asm volatile("" : "+v"(pk));
#pragma unroll
                    for (int bj = 0; bj < 2; ++bj)
#pragma unroll
                        for (int n = 0; n < 2; ++n) { const int d0 = bj * HALF + 4 * n; const f32x4 v = acc[ai][bj][m][n];
                            const unsigned w0 = cvt_pk_bf16(v[0], v[1]), w1 = cvt_pk_bf16(v[2], v[3]);
                            pk[(d0 + 0) * 256] = (bf16_t)(w0 & 0xffffu); pk[(d0 + 1) * 256] = (bf16_t)(w0 >> 16);
                            pk[(d0 + 2) * 256] = (bf16_t)(w1 & 0xffffu); pk[(d0 + 3) * 256] = (bf16_t)(w1 >> 16); }
                    asm volatile("" ::: "memory"); }
        }
    }
};
struct EpiSwiGLU {
    static constexpr bool PERM = true, AFTER_DRAIN = false;
    bf16_t* O; int ldc;
    __device__ __forceinline__ void operator()(const f32x4 (&acc)[2][2][4][2], const Unit& u, int wr, int wc, int fr, int fq) const {
        const int row0 = u.pm * BM + wr * 64 + fr; const int col0 = u.pn * HALF + wc * 32 + 8 * fq;
#pragma unroll
        for (int ai = 0; ai < 2; ++ai)
#pragma unroll
            for (int m = 0; m < 4; ++m) { bf16_t* rowp = O + (size_t)(row0 + ai * HALF + m * 16) * ldc + col0;
                float h[8];
#pragma unroll
                for (int n = 0; n < 2; ++n)
#pragma unroll
                    for (int i = 0; i < 4; ++i) { const float g = acc[ai][0][m][n][i], up = acc[ai][1][m][n][i]; h[n * 4 + i] = g * __builtin_amdgcn_rcpf(1.0f + __expf(-g)) * up; }
                u32x4 w; w.x = cvt_pk_bf16(h[0], h[1]); w.y = cvt_pk_bf16(h[2], h[3]); w.z = cvt_pk_bf16(h[4], h[5]); w.w = cvt_pk_bf16(h[6], h[7]);
                *(u32x4*)rowp = w; }
    }
};
}

typedef unsigned short bf16_t;
typedef short bf16x8 __attribute__((ext_vector_type(8)));
typedef float f32x4 __attribute__((ext_vector_type(4)));
typedef unsigned u32x4 __attribute__((ext_vector_type(4)));
typedef unsigned u32x2 __attribute__((ext_vector_type(2)));

constexpr int NB = 16, T = 2048, D = 1024, M = NB * T;
constexpr int ZP = 3584;
constexpr int A_COLS = 1408, IN_COLS = 3334, DFF = 2816;
constexpr int MEMR = NB * 256;
constexpr float RMS_EPS = 1e-6f, GN_EPS = 64e-5f;
constexpr float LOG2E = 1.4426950408889634f;
constexpr size_t MiB = 1u << 20;
constexpr size_t WS_CTL = 0, WS_WIN = 1 * MiB, WS_WLORA = 8 * MiB, WS_WOUT = 10 * MiB, WS_WQ = 12 * MiB, WS_WKV = 14 * MiB, WS_WO = 18 * MiB, WS_WGU = 20 * MiB, WS_WDN = 31 * MiB,
                 WS_CBUF = 37 * MiB, WS_FL = 38 * MiB, WS_MKV = 40 * MiB, WS_VFIRST = 56 * MiB, WS_R3 = 80 * MiB, WS_R2 = 144 * MiB, WS_R1 = 240 * MiB, WS_MEMN = 464 * MiB, WS_VFIN = 472 * MiB, WS_GEND = 496 * MiB, WS_SCAL = 502 * MiB, WS_END = 505 * MiB;
constexpr int NTHREADS = 512, NWAVES = 8;
constexpr int LDS_BYTES = 147456;

struct Params { const float* in[31]; float* out; unsigned char* ws; int pad[2]; };

__device__ __forceinline__ float bf2f(bf16_t v) { return __uint_as_float((unsigned)v << 16); }
__device__ __forceinline__ unsigned f2bf(float f) { return pg8::cvt_pk_bf16(f, 0.f) & 0xffffu; }
__device__ __forceinline__ unsigned pk2(float lo, float hi) { return pg8::cvt_pk_bf16(lo, hi); }
__device__ __forceinline__ float lo16(unsigned w) { return __uint_as_float(w << 16); }
__device__ __forceinline__ float hi16(unsigned w) { return __uint_as_float(w & 0xffff0000u); }
#define WS_DPP(x, ctrl) ((x) + __int_as_float(__builtin_amdgcn_update_dpp(0, __float_as_int(x), (ctrl), 0xF, 0xF, true)))
__device__ __forceinline__ float wave_sum(float v) {
    v = WS_DPP(v, 0xB1); v = WS_DPP(v, 0x4E); v = WS_DPP(v, 0x141); v = WS_DPP(v, 0x140);
    const int iv = __float_as_int(v);
    return (__int_as_float(__builtin_amdgcn_readlane(iv, 0)) + __int_as_float(__builtin_amdgcn_readlane(iv, 16))) + (__int_as_float(__builtin_amdgcn_readlane(iv, 32)) + __int_as_float(__builtin_amdgcn_readlane(iv, 48)));
}
#define BAR_LGKM() asm volatile("s_waitcnt lgkmcnt(0)\n\ts_barrier" ::: "memory")
__device__ __forceinline__ float sigmoidf_(float x) { return __builtin_amdgcn_rcpf(1.0f + __expf(-x)); }
__device__ __forceinline__ float logsigmoidf_(float x) { return fminf(x, 0.f) - __logf(1.0f + __expf(-fabsf(x))); }

__device__ __forceinline__ int colmap(int mode, int n) {
    if (mode == 1) { if (n < 2560) return n; if (n < 3328) return n + 6; if (n < 3334) return n - 768; return -1; }
    if (mode == 2) { const int tile = n >> 8, w = n & 255; return w < 128 ? tile * 128 + w : DFF + tile * 128 + (w - 128); }
    return n;
}
__device__ __forceinline__ void transpose_item(const float* __restrict__ W, int Nsrc, int K, bf16_t* WT, int nblk, int mode, float* scr, int item, int lane) {
    const int kb = item / nblk, nb = item % nblk, k0 = 64 * kb, n0 = 32 * nb;
    const int src = colmap(mode, n0 + (lane & 31));
#pragma unroll 8
    for (int i = 0; i < 32; ++i) { const int kk = 2 * i + (lane >> 5); scr[kk * 33 + (lane & 31)] = src >= 0 ? W[(size_t)(k0 + kk) * Nsrc + src] : 0.f; }
    asm volatile("s_waitcnt lgkmcnt(0)" ::: "memory");
    const int c = lane & 7;
#pragma unroll
    for (int j = 0; j < 4; ++j) { const int n = (lane >> 3) + 8 * j; const float* s = scr + (8 * c) * 33 + n;
        u32x4 o; o.x = pk2(s[0 * 33], s[1 * 33]); o.y = pk2(s[2 * 33], s[3 * 33]); o.z = pk2(s[4 * 33], s[5 * 33]); o.w = pk2(s[6 * 33], s[7 * 33]);
        *(u32x4*)(WT + (size_t)(n0 + n) * K + k0 + 8 * c) = o; }
    asm volatile("s_waitcnt lgkmcnt(0)" ::: "memory");
}
__device__ __forceinline__ void convert_weights(const Params& p, int l, unsigned char* lds, int gw, int ngw, int lane, int wave) {
    unsigned char* ws = p.ws;
    float* scr = (float*)(lds + wave * 16384);
    constexpr int I_IN = 16 * (ZP / 32), I_SQ = 16 * 32, I_KV = 16 * 64, I_GU = 16 * (2 * DFF / 32), I_DN = (DFF / 64) * 32;
    constexpr int NITEMS = I_IN + 3 * I_SQ + I_KV + I_GU + I_DN;
    for (int it = gw; it < NITEMS; it += ngw) {
        int r = it;
        if (r < I_IN) { transpose_item(p.in[4] + (size_t)l * D * IN_COLS, IN_COLS, D, (bf16_t*)(ws + WS_WIN), ZP / 32, 1, scr, r, lane); continue; } r -= I_IN;
        if (r < I_SQ) { transpose_item(p.in[20] + (size_t)l * D * D, D, D, (bf16_t*)(ws + WS_WOUT), 32, 0, scr, r, lane); continue; } r -= I_SQ;
        if (r < I_SQ) { transpose_item(p.in[24] + (size_t)l * D * D, D, D, (bf16_t*)(ws + WS_WQ), 32, 0, scr, r, lane); continue; } r -= I_SQ;
        if (r < I_SQ) { transpose_item(p.in[26] + (size_t)l * D * D, D, D, (bf16_t*)(ws + WS_WO), 32, 0, scr, r, lane); continue; } r -= I_SQ;
        if (r < I_KV) { transpose_item(p.in[25] + (size_t)l * D * 2 * D, 2 * D, D, (bf16_t*)(ws + WS_WKV), 64, 0, scr, r, lane); continue; } r -= I_KV;
        if (r < I_GU) { transpose_item(p.in[29] + (size_t)l * D * 2 * DFF, 2 * DFF, D, (bf16_t*)(ws + WS_WGU), 2 * DFF / 32, 2, scr, r, lane); continue; } r -= I_GU;
        transpose_item(p.in[30] + (size_t)l * DFF * D, D, DFF, (bf16_t*)(ws + WS_WDN), 32, 0, scr, r, lane);
    }
    const int Kl = l ? 640 : 256, Nl = l ? 1536 : 1280, kch = Kl / 8;
    const float* w_up = p.in[7] + (size_t)l * 64 * 384; const float* a_up = p.in[9] + (size_t)l * 64 * 384; const float* g_up = p.in[10] + (size_t)l * 128 * 384;
    const float* vdn = p.in[17]; const float* vup = p.in[18];
    bf16_t* WL = (bf16_t*)(ws + WS_WLORA);
    for (int ci = gw * 64 + lane; ci < Nl * kch; ci += ngw * 64) {
        const int n = ci / kch, k0 = (ci % kch) * 8; float v[8];
#pragma unroll
        for (int e = 0; e < 8; ++e) { const int k = k0 + e; float x = 0.f;
            if (n < 384) { if (k < 64) x = w_up[k * 384 + n]; }
            else if (n < 768) { if (k >= 64 && k < 128) x = a_up[(k - 64) * 384 + n - 384]; }
            else if (n < 1152) { if (k >= 128 && k < 256) x = g_up[(k - 128) * 384 + n - 768]; }
            else if (n < 1536 && l == 1) { if (k >= 256) { float s = 0.f; for (int r = 0; r < 32; ++r) s += vdn[(k - 256) * 32 + r] * vup[r * 384 + n - 1152]; x = s; } }
            v[e] = x; }
        u32x4 o; o.x = pk2(v[0], v[1]); o.y = pk2(v[2], v[3]); o.z = pk2(v[4], v[5]); o.w = pk2(v[6], v[7]);
        *(u32x4*)(WL + (size_t)n * Kl + k0) = o;
    }
}

template <bool XIB, bool XOB>
__device__ __forceinline__ void norm_rows(int gw, int ngw, int lane, int rows, const void* xin_, const bf16_t* y, const float* gpost, void* xout_, const float* gpre, bf16_t* hout) {
    constexpr int NR = 4;
    const float* xin = (const float*)xin_; const bf16_t* xinb = (const bf16_t*)xin_; float* xout = (float*)xout_; bf16_t* xoutb = (bf16_t*)xout_;
    for (int row0 = gw; row0 < rows; row0 += NR * ngw) {
        int rw[NR]; bool ok[NR];
#pragma unroll
        for (int k = 0; k < NR; ++k) { const int r = row0 + k * ngw; ok[k] = r < rows; rw[k] = ok[k] ? r : row0; }
        f32x4 x[NR][4]; u32x2 yy[NR][4];
#pragma unroll
        for (int k = 0; k < NR; ++k)
#pragma unroll
            for (int j = 0; j < 4; ++j) {
                if (XIB) { const u32x2 w = *(const u32x2*)(xinb + (size_t)rw[k] * D + 256 * j + 4 * lane); x[k][j] = (f32x4){lo16(w.x), hi16(w.x), lo16(w.y), hi16(w.y)}; }
                else x[k][j] = *(const f32x4*)(xin + (size_t)rw[k] * D + 256 * j + 4 * lane); }
        if (y != nullptr) {
#pragma unroll
            for (int k = 0; k < NR; ++k)
#pragma unroll
                for (int j = 0; j < 4; ++j) yy[k][j] = *(const u32x2*)(y + (size_t)rw[k] * D + 256 * j + 4 * lane);
#pragma unroll
            for (int k = 0; k < NR; ++k) {
                f32x4 v[4]; float ss = 0.f;
#pragma unroll
                for (int j = 0; j < 4; ++j) { v[j] = (f32x4){lo16(yy[k][j].x), hi16(yy[k][j].x), lo16(yy[k][j].y), hi16(yy[k][j].y)}; ss += (v[j].x * v[j].x + v[j].y * v[j].y) + (v[j].z * v[j].z + v[j].w * v[j].w); }
                const float r = rsqrtf(wave_sum(ss) * (1.0f / D) + RMS_EPS);
#pragma unroll
                for (int j = 0; j < 4; ++j) { const f32x4 g = *(const f32x4*)(gpost + 256 * j + 4 * lane); x[k][j] = x[k][j] + v[j] * r * g; }
            }
        }
        if (xout_ != nullptr) {
#pragma unroll
            for (int k = 0; k < NR; ++k) if (ok[k]) {
#pragma unroll
                for (int j = 0; j < 4; ++j) {
                    if (XOB) { u32x2 w; w.x = pk2(x[k][j].x, x[k][j].y); w.y = pk2(x[k][j].z, x[k][j].w); *(u32x2*)(xoutb + (size_t)rw[k] * D + 256 * j + 4 * lane) = w; }
                    else *(f32x4*)(xout + (size_t)rw[k] * D + 256 * j + 4 * lane) = x[k][j]; } }
        }
        if (gpre != nullptr) {
#pragma unroll
            for (int k = 0; k < NR; ++k) {
                float ss = 0.f;
#pragma unroll
                for (int j = 0; j < 4; ++j) ss += (x[k][j].x * x[k][j].x + x[k][j].y * x[k][j].y) + (x[k][j].z * x[k][j].z + x[k][j].w * x[k][j].w);
                const float r = rsqrtf(wave_sum(ss) * (1.0f / D) + RMS_EPS);
                if (ok[k]) {
#pragma unroll
                    for (int j = 0; j < 4; ++j) { const f32x4 g = *(const f32x4*)(gpre + 256 * j + 4 * lane); const f32x4 h = x[k][j] * r * g;
                        u32x2 w; w.x = pk2(h.x, h.y); w.y = pk2(h.z, h.w); *(u32x2*)(hout + (size_t)rw[k] * D + 256 * j + 4 * lane) = w; } }
            }
        }
    }
}

__device__ __forceinline__ void rwkv_pre(const Params& p, int l, int gw, int ngw, int lane) {
    const bf16_t* z = (const bf16_t*)(p.ws + WS_R1); bf16_t* lin = (bf16_t*)p.out; bf16_t* vfirst = (bf16_t*)(p.ws + WS_VFIRST);
    const float* mu = p.in[5] + (size_t)l * A_COLS; const int Kl = l ? 640 : 256;
    constexpr int NU = 4; const int nlanes = ngw * 64;
    for (int base = gw * 64 + lane; base < M * 80; base += NU * nlanes) {
        u32x4 zc[NU], zp[NU]; int tokv[NU], chv[NU]; bool okv[NU];
#pragma unroll
        for (int k = 0; k < NU; ++k) { const int idx = base + k * nlanes; okv[k] = idx < M * 80; const int id2 = okv[k] ? idx : base; tokv[k] = id2 / 80; chv[k] = id2 % 80;
            const int col = chv[k] < 48 ? 768 + 8 * chv[k] : 1152 + 8 * (chv[k] - 48);
            zc[k] = *(const u32x4*)(z + (size_t)tokv[k] * ZP + col);
            zp[k] = (u32x4){0u, 0u, 0u, 0u}; if ((tokv[k] % T) > 0) zp[k] = *(const u32x4*)(z + (size_t)(tokv[k] - 1) * ZP + col); }
#pragma unroll
        for (int k = 0; k < NU; ++k) { const int tok = tokv[k], ch = chv[k];
            const int col = ch < 48 ? 768 + 8 * ch : 1152 + 8 * (ch - 48);
            const f32x4 m0 = *(const f32x4*)(mu + col), m1 = *(const f32x4*)(mu + col + 4);
            float s[8];
            { const float c0 = lo16(zc[k].x), c1 = hi16(zc[k].x), c2 = lo16(zc[k].y), c3 = hi16(zc[k].y), c4 = lo16(zc[k].z), c5 = hi16(zc[k].z), c6 = lo16(zc[k].w), c7 = hi16(zc[k].w);
              s[0] = c0 + (lo16(zp[k].x) - c0) * m0.x; s[1] = c1 + (hi16(zp[k].x) - c1) * m0.y; s[2] = c2 + (lo16(zp[k].y) - c2) * m0.z; s[3] = c3 + (hi16(zp[k].y) - c3) * m0.w;
              s[4] = c4 + (lo16(zp[k].z) - c4) * m1.x; s[5] = c5 + (hi16(zp[k].z) - c5) * m1.y; s[6] = c6 + (lo16(zp[k].w) - c6) * m1.z; s[7] = c7 + (hi16(zp[k].w) - c7) * m1.w; }
            bf16_t* dst;
            if (ch < 48) { dst = (l == 0) ? vfirst + (size_t)tok * 384 + 8 * ch : lin + (size_t)tok * Kl + 256 + 8 * ch; }
            else { const int c2 = 8 * (ch - 48); dst = lin + (size_t)tok * Kl + c2;
                if (c2 < 64) {
#pragma unroll
                    for (int e = 0; e < 8; ++e) s[e] = 1.0f - 2.0f * __builtin_amdgcn_rcpf(__expf(2.0f * s[e]) + 1.0f);
                } else if (c2 >= 128) {
#pragma unroll
                    for (int e = 0; e < 8; ++e) s[e] = sigmoidf_(s[e]);
                } }
            u32x4 o; o.x = pk2(s[0], s[1]); o.y = pk2(s[2], s[3]); o.z = pk2(s[4], s[5]); o.w = pk2(s[6], s[7]);
            if (okv[k]) *(u32x4*)dst = o;
        }
    }
    {
        float* ktmax = (float*)(p.ws + 512 * 1024);
        for (int item = gw; item < 96 * 32; item += ngw) { const int bh = item >> 5, tile = item & 31, b = bh / 6, h = bh % 6;
            const bf16_t* kp = z + ((size_t)b * T + tile * 64 + lane) * ZP + 1792 + h * 64; float ss = 0.f;
#pragma unroll
            for (int c8 = 0; c8 < 8; ++c8) { const u32x4 w = *(const u32x4*)(kp + 8 * c8); const float a0 = lo16(w.x), a1 = hi16(w.x), a2 = lo16(w.y), a3 = hi16(w.y), a4 = lo16(w.z), a5 = hi16(w.z), a6 = lo16(w.w), a7 = hi16(w.w);
                ss += (a0 * a0 + a1 * a1) + (a2 * a2 + a3 * a3) + (a4 * a4 + a5 * a5) + (a6 * a6 + a7 * a7); }
#pragma unroll
            for (int o = 1; o < 64; o <<= 1) ss = fmaxf(ss, __shfl_xor(ss, o));
            if (lane == 0) ktmax[item] = sqrtf(ss); }
    }
    if (gw < 96) {
        const int b = gw / 6, h = gw % 6; const float* fl = (const float*)(p.ws + WS_FL); float* cb = (float*)(p.ws + WS_CBUF) + (size_t)gw * T;
        const float fb = p.in[19][l * 6 + h]; float carry = 0.f;
        for (int i0 = 0; i0 < 32; i0 += 8) {
            float fv[8];
#pragma unroll
            for (int i = 0; i < 8; ++i) fv[i] = fl[(size_t)(b * T + 64 * (i0 + i) + lane) * 8 + h];
#pragma unroll
            for (int i = 0; i < 8; ++i) {
                float v = logsigmoidf_(fv[i] + fb);
#pragma unroll
                for (int o = 1; o < 64; o <<= 1) { const float u = __shfl_up(v, o); if (lane >= o) v += u; }
                v += carry; cb[64 * (i0 + i) + lane] = v * LOG2E; carry = __shfl(v, 63);
            }
        }
    }
}

typedef float f32x2 __attribute__((ext_vector_type(2)));
__device__ __forceinline__ void rwkv_prep2(const Params& p, int l, int gw, int ngw, int lane) {
    const bf16_t* z = (const bf16_t*)(p.ws + WS_R1); bf16_t* lo = (bf16_t*)(p.ws + WS_R2); const bf16_t* vfirst = (const bf16_t*)(p.ws + WS_VFIRST);
    bf16_t* rk = (bf16_t*)p.out; bf16_t* vfin = (bf16_t*)(p.ws + WS_VFIN); float* gend = (float*)(p.ws + WS_GEND); float* scal = (float*)(p.ws + WS_SCAL);
    const int Nl = l ? 1536 : 1280;
    for (int item = gw; item < NB * 256 * 6; item += ngw) {
        const int h = item % 6, bw = item / 6, b = bw >> 8, win = bw & 255; const int hj = h * 64 + lane; const int item2 = bw * 6 + h;
        const float mu_r = p.in[5][l * A_COLS + hj], mu_k = p.in[5][l * A_COLS + 384 + hj], mu_v = p.in[5][l * A_COLS + 768 + hj];
        const float w0 = p.in[6][l * 384 + hj], a0 = p.in[8][l * 384 + hj], k_k = p.in[11][l * 384 + hj], k_a = p.in[12][l * 384 + hj], r_k = p.in[13][l * 384 + hj];
        const float vbias = l ? p.in[16][hj] : 0.f;
        const size_t tok0 = (size_t)b * T + 8 * win;
        float pr = 0.f, pk = 0.f, pv = 0.f;
        if (win > 0) { const bf16_t* zq = z + (tok0 - 1) * ZP; pr = bf2f(zq[hj]); pk = bf2f(zq[384 + hj]); pv = bf2f(zq[768 + hj]); }
        float zr[8], zk[8], zv[8], wl[8], al[8], vl[8], vf[8];
#pragma unroll
        for (int i = 0; i < 8; ++i) { const size_t tok = tok0 + i; const bf16_t* zp_ = z + tok * ZP; const bf16_t* lor = lo + tok * Nl;
            zr[i] = bf2f(zp_[hj]); zk[i] = bf2f(zp_[384 + hj]); zv[i] = bf2f(zp_[768 + hj]); wl[i] = bf2f(lor[hj]); al[i] = bf2f(lor[384 + hj]);
            vl[i] = 0.f; vf[i] = 0.f; if (l) { vl[i] = bf2f(lor[1152 + hj]); vf[i] = bf2f(vfirst[tok * 384 + hj]); } }
        float G = 1.0f; float at[8], rt[8], bhv[8], khv[8];
#pragma unroll
        for (int i = 0; i < 8; ++i) { const size_t tok = tok0 + i;
            const float r = zr[i] + (pr - zr[i]) * mu_r, k = zk[i] + (pk - zk[i]) * mu_k; float v = zv[i] + (pv - zv[i]) * mu_v;
            pr = zr[i]; pk = zk[i]; pv = zv[i];
            if (l) v = v + (vf[i] - v) * sigmoidf_(vbias + vl[i]);
            const float xw = w0 + wl[i];
            const float wlog = -(fmaxf(-xw, 0.f) + __logf(1.0f + __expf(-fabsf(xw)))) - 0.5f;
            const float dec = __expf(-__expf(wlog));
            const float a = sigmoidf_(a0 + al[i]);
            float kk = k * k_k; const float n2 = wave_sum(kk * kk); kk *= rsqrtf(fmaxf(n2, 1e-24f));
            const float k2 = k * (1.0f + (a - 1.0f) * k_a);
            const float bvv = kk * a;
            const float bon = wave_sum(r * k2 * r_k);
            const float Gp = G; G = Gp * dec; const float iG = __builtin_amdgcn_rcpf(G);
            const unsigned bb = f2bf(bvv * iG), kb = f2bf(k2 * iG);
            at[i] = -kk * Gp; rt[i] = r * G; bhv[i] = __uint_as_float(bb << 16); khv[i] = __uint_as_float(kb << 16);
            lo[tok * Nl + 384 + hj] = (bf16_t)bb; rk[tok * 768 + 384 + hj] = (bf16_t)kb;
            vfin[tok * 384 + hj] = (bf16_t)f2bf(v);
            if (lane == 0) *(f32x4*)(scal + (tok * 6 + h) * 4) = (f32x4){0.f, 0.f, bon, 0.f};
        }
        gend[(tok0 >> 3) * 384 + hj] = G;
        float Tm[8][8], N1m[8][8], atp[8];
#pragma unroll
        for (int j = 0; j < 8; ++j)
#pragma unroll
            for (int m = 0; m < 8; ++m) { Tm[j][m] = 0.f; N1m[j][m] = 0.f; }
        float* nimg = (float*)((unsigned char*)p.out + 80 * MiB) + (size_t)item2 * 128;
#pragma unroll
        for (int s = 0; s < 8; ++s) {
            float mab[8], mka[8], mbr[8], mkr[8];
#pragma unroll
            for (int j = 0; j < 8; ++j) { mab[j] = 0.f; mka[j] = 0.f; mbr[j] = 0.f; mkr[j] = 0.f;
                if (j < s) { mab[j] = wave_sum(bhv[j] * at[s]); mka[j] = wave_sum(khv[j] * at[s]); }
                if (j <= s) { mbr[j] = wave_sum(bhv[j] * rt[s]); mkr[j] = wave_sum(khv[j] * rt[s]); } }
#pragma unroll
            for (int j = 0; j < 8; ++j) if (j <= s) { float t = (j == s) ? 1.0f : 0.f;
#pragma unroll
                for (int m = 0; m < 8; ++m) if (m >= j && m < s) t += Tm[j][m] * mab[m];
                Tm[j][s] = t; }
            float ap = 0.f;
#pragma unroll
            for (int m = 0; m < 8; ++m) if (m <= s) ap += at[m] * Tm[m][s];
            atp[s] = ap;
#pragma unroll
            for (int j = 0; j < 8; ++j) if (j < s) { float n = mka[j];
#pragma unroll
                for (int m = 0; m < 8; ++m) if (m > j && m < s) n += N1m[j][m] * mab[m];
                N1m[j][s] = n; }
            float rp = rt[s];
#pragma unroll
            for (int m = 0; m < 8; ++m) if (m <= s) rp += atp[m] * mbr[m];
            float n2c[8];
#pragma unroll
            for (int j = 0; j < 8; ++j) { float n = 0.f; if (j <= s) { n = mkr[j];
#pragma unroll
                    for (int m = 0; m < 8; ++m) if (m > j && m <= s) n += N1m[j][m] * mbr[m]; }
                n2c[j] = n; }
            const size_t tok = tok0 + s;
            lo[tok * Nl + hj] = (bf16_t)f2bf(ap); rk[tok * 768 + hj] = (bf16_t)f2bf(rp);
            if (lane == 0) { *(f32x4*)(nimg + s * 8) = (f32x4){N1m[0][s], N1m[1][s], N1m[2][s], N1m[3][s]}; *(f32x4*)(nimg + s * 8 + 4) = (f32x4){N1m[4][s], N1m[5][s], N1m[6][s], N1m[7][s]};
                             *(f32x4*)(nimg + 64 + s * 8) = (f32x4){n2c[0], n2c[1], n2c[2], n2c[3]}; *(f32x4*)(nimg + 64 + s * 8 + 4) = (f32x4){n2c[4], n2c[5], n2c[6], n2c[7]}; }
        }
    }
}

#define DPP_ADD(x, ctrl) ((x) + __int_as_float(__builtin_amdgcn_update_dpp(0, __float_as_int(x), (ctrl), 0xF, 0xF, true)))
__device__ __forceinline__ float red8(float x) { x = DPP_ADD(x, 0xB1); x = DPP_ADD(x, 0x4E); x = DPP_ADD(x, 0x141); return x; }
__device__ __forceinline__ f32x2 fma2(f32x2 a, f32x2 b, f32x2 c) { return __builtin_elementwise_fma(a, b, c); }
#define SCAN_BAR() asm volatile("s_waitcnt vmcnt(0) lgkmcnt(0)\n\ts_barrier" ::: "memory")
#define SCAN_BAR_L() asm volatile("s_waitcnt lgkmcnt(0)\n\ts_barrier" ::: "memory")

__device__ __forceinline__ void scan_unit(const Params& p, int l, int bh, unsigned char* ldsb, int tid, int lane, int wave, bool store) {
    const int b = bh / 6, h = bh % 6;
    constexpr int BUFSZ = 6 * 2048 + 128 + 256 + 512;
    float* base = (float*)ldsb; float* Ybase = base + 2 * BUFSZ;
    if (wave < 4) {
        const int n16 = lane & 15, q = lane >> 4; const int irow = 16 * wave + n16;
        f32x4 Z0 = (f32x4){0.f, 0.f, 0.f, 0.f}, Z1 = Z0, Z2 = Z0, Z3 = Z0;
        SCAN_BAR();
        for (int c = 0; c < T / 32; ++c) {
            const float* buf = base + (c & 1) * BUFSZ; float* Y = Ybase + (c & 1) * 2048;
            const float* AT = buf; const float* RT = buf + 2048; const float* BH = buf + 4096; const float* KH = buf + 6144; const float* Vv = buf + 8192; const float* GE = buf + 12416; const float* NI = buf + 12672;
#define MF4(a_, b_, c_) __builtin_amdgcn_mfma_f32_16x16x4f32((a_), (b_), (c_), 0, 0, 0)
#pragma unroll 1
            for (int w8 = 0; w8 < 4; ++w8) {
                const int tt0 = 8 * w8;
                const float* xrow = (n16 < 8 ? AT + (tt0 + n16) * 64 : RT + (tt0 + n16 - 8) * 64) + 4 * q;
                const f32x4 x0 = *(const f32x4*)(xrow), x1 = *(const f32x4*)(xrow + 16), x2 = *(const f32x4*)(xrow + 32), x3 = *(const f32x4*)(xrow + 48);
                const float na = NI[w8 * 128 + n16 * 8 + q], nb = NI[w8 * 128 + n16 * 8 + 4 + q];
                const float va = Vv[(tt0 + q) * 64 + irow], vb = Vv[(tt0 + 4 + q) * 64 + irow];
                f32x4 D1 = (f32x4){0.f, 0.f, 0.f, 0.f};
                D1 = MF4(x0.x, Z0.x, D1); D1 = MF4(x0.y, Z0.y, D1); D1 = MF4(x0.z, Z0.z, D1); D1 = MF4(x0.w, Z0.w, D1);
                D1 = MF4(x1.x, Z1.x, D1); D1 = MF4(x1.y, Z1.y, D1); D1 = MF4(x1.z, Z1.z, D1); D1 = MF4(x1.w, Z1.w, D1);
                D1 = MF4(x2.x, Z2.x, D1); D1 = MF4(x2.y, Z2.y, D1); D1 = MF4(x2.z, Z2.z, D1); D1 = MF4(x2.w, Z2.w, D1);
                D1 = MF4(x3.x, Z3.x, D1); D1 = MF4(x3.y, Z3.y, D1); D1 = MF4(x3.z, Z3.z, D1); D1 = MF4(x3.w, Z3.w, D1);
                D1 = MF4(na, va, D1); D1 = MF4(nb, vb, D1);
                const int sq = tt0 + 4 * (q & 1);
                const float* vsel = Vv + sq * 64 + irow;
                const float v0 = vsel[0], v1 = vsel[64], v2 = vsel[128], v3 = vsel[192];
                if (q >= 2) { float* yp = Y + sq * 64 + irow; yp[0] = D1.x; yp[64] = D1.y; yp[128] = D1.z; yp[192] = D1.w; }
                const float b0 = q < 2 ? D1.x : v0, b1 = q < 2 ? D1.y : v1, b2 = q < 2 ? D1.z : v2, b3 = q < 2 ? D1.w : v3;
                const float* arow = (q < 2 ? BH : KH) + sq * 64 + n16;
                Z0 = MF4(arow[0], b0, Z0);  Z0 = MF4(arow[64], b1, Z0);  Z0 = MF4(arow[128], b2, Z0);  Z0 = MF4(arow[192], b3, Z0);
                Z1 = MF4(arow[16], b0, Z1); Z1 = MF4(arow[80], b1, Z1);  Z1 = MF4(arow[144], b2, Z1);  Z1 = MF4(arow[208], b3, Z1);
                Z2 = MF4(arow[32], b0, Z2); Z2 = MF4(arow[96], b1, Z2);  Z2 = MF4(arow[160], b2, Z2);  Z2 = MF4(arow[224], b3, Z2);
                Z3 = MF4(arow[48], b0, Z3); Z3 = MF4(arow[112], b1, Z3); Z3 = MF4(arow[176], b2, Z3);  Z3 = MF4(arow[240], b3, Z3);
                const float* gp = GE + w8 * 64 + 4 * q;
                Z0 *= *(const f32x4*)(gp); Z1 *= *(const f32x4*)(gp + 16); Z2 *= *(const f32x4*)(gp + 32); Z3 *= *(const f32x4*)(gp + 48);
            }
#undef MF4
            SCAN_BAR();
        }
    } else {
        bf16_t* z = (bf16_t*)(p.ws + WS_R1); const bf16_t* lo = (const bf16_t*)(p.ws + WS_R2); const bf16_t* rk = (const bf16_t*)p.out;
        const bf16_t* vfin = (const bf16_t*)(p.ws + WS_VFIN); const float* gend = (const float*)(p.ws + WS_GEND); const float* scal = (const float*)(p.ws + WS_SCAL);
        const int Nl = l ? 1536 : 1280; const int pw = wave - 4; const int hj = h * 64 + lane;
        const float gn_g = p.in[14][l * 384 + hj], gn_b = p.in[15][l * 384 + hj];
        const int li = lane >> 3, lc = 8 * (lane & 7);
        u32x4 rAT, rBH, rGL, rRT, rKH, rV; float rGE = 0.f; f32x4 rSC = (f32x4){0.f, 0.f, 0.f, 0.f}; f32x2 rNI = (f32x2){0.f, 0.f};
        const float* nimg = (const float*)((const unsigned char*)p.out + 80 * MiB);
#define SCAN_LOAD(c_) do { const int cc = (c_); const size_t tok = (size_t)b * T + 32 * cc + 8 * pw + li; \
            rAT = *(const u32x4*)(lo + tok * Nl + h * 64 + lc); rBH = *(const u32x4*)(lo + tok * Nl + 384 + h * 64 + lc); rGL = *(const u32x4*)(lo + tok * Nl + 768 + h * 64 + lc); \
            rRT = *(const u32x4*)(rk + tok * 768 + h * 64 + lc); rKH = *(const u32x4*)(rk + tok * 768 + 384 + h * 64 + lc); rV = *(const u32x4*)(vfin + tok * 384 + h * 64 + lc); \
            rGE = gend[(((size_t)b * T + 32 * cc + 8 * pw) >> 3) * 384 + hj]; rNI = *(const f32x2*)(nimg + ((((size_t)b * T + 32 * cc + 8 * pw) >> 3) * 6 + h) * 128 + 2 * lane); \
            if (lane < 8) rSC = *(const f32x4*)(scal + (((size_t)b * T + 32 * cc + 8 * pw + lane) * 6 + h) * 4); } while (0)
#define SCAN_ST1(arr_, reg_) do { float* d_ = buf + (arr_) + (8 * pw + li) * 64 + lc; \
            *(f32x4*)d_ = (f32x4){lo16(reg_.x), hi16(reg_.x), lo16(reg_.y), hi16(reg_.y)}; *(f32x4*)(d_ + 4) = (f32x4){lo16(reg_.z), hi16(reg_.z), lo16(reg_.w), hi16(reg_.w)}; } while (0)
#define SCAN_STORE(c_) do { const int cc = (c_); float* buf = base + (cc & 1) * BUFSZ; \
            SCAN_ST1(0, rAT); SCAN_ST1(2048, rRT); SCAN_ST1(4096, rBH); SCAN_ST1(6144, rKH); SCAN_ST1(8192, rV); SCAN_ST1(10240, rGL); \
            buf[12416 + pw * 64 + lane] = rGE; *(f32x2*)(buf + 12672 + pw * 128 + 2 * lane) = rNI; if (lane < 8) *(f32x4*)(buf + 12288 + (8 * pw + lane) * 4) = rSC; } while (0)
#define SCAN_POST(c_) do { const int cc = (c_); const float* buf = base + (cc & 1) * BUFSZ; const float* Y = Ybase + (cc & 1) * 2048; \
            _Pragma("unroll") for (int i = 0; i < 8; ++i) { const int tt = 8 * pw + i; const int o = tt * 64 + lane; const float y = Y[o]; \
                const float mean = wave_sum(y) * (1.0f / 64.0f); const float d = y - mean; const float var = wave_sum(d * d) * (1.0f / 64.0f); \
                const float yn = d * rsqrtf(var + GN_EPS) * gn_g + gn_b; \
                const float outv = (yn + buf[12288 + tt * 4 + 2] * buf[8192 + o]) * buf[10240 + o]; \
                if (store) z[((size_t)b * T + 32 * cc + tt) * ZP + hj] = (bf16_t)f2bf(outv); } } while (0)
        SCAN_LOAD(0);
        SCAN_STORE(0);
        SCAN_LOAD(1);
        SCAN_BAR_L();
        for (int c = 0; c < T / 32; ++c) {
            if (c > 0) SCAN_POST(c - 1);
            if (c + 1 < T / 32) SCAN_STORE(c + 1);
            if (c + 2 < T / 32) SCAN_LOAD(c + 2);
            SCAN_BAR_L();
        }
        SCAN_POST(T / 32 - 1);
#undef SCAN_LOAD
#undef SCAN_ST1
#undef SCAN_STORE
#undef SCAN_POST
    }
    __syncthreads();
}

template <int HD, int MODE>
__device__ __forceinline__ void attn_unit(unsigned char* ldsb, const bf16_t* Qg, int qpitch, const bf16_t* Kg, const bf16_t* Vg, int kvpitch, bf16_t* Og, int q0, int nkeys, const float* cseq, float scale,
                                          int tid, int lane, int wave, bool store) {
    constexpr int KP = (HD + 8) * 2;
    constexpr int VP = 72 * 2;
    constexpr int NCH = HD / 64;
    constexpr int NKB = HD / 32, NDT = HD / 16;
    unsigned char* Ks = ldsb; unsigned char* Vts = ldsb + 64 * KP; float* cs = (float*)(Vts + HD * VP);
    const int r16 = lane & 15, fq = lane >> 4;
    const int qrow = q0 + 16 * wave + r16;
    bf16x8 qf[NKB];
#pragma unroll
    for (int kb = 0; kb < NKB; ++kb) qf[kb] = *(const bf16x8*)(Qg + (size_t)qrow * qpitch + 32 * kb + 8 * fq);
    f32x4 o[NDT];
#pragma unroll
    for (int dt = 0; dt < NDT; ++dt) o[dt] = (f32x4){0.f, 0.f, 0.f, 0.f};
    float m_run = -INFINITY, l_part = 0.f, Rtot = 0.f;
    float cq = 0.f; if (MODE == 0) cq = cseq[qrow];
    const int ntiles = (MODE == 2) ? nkeys / 64 : (q0 + 128) / 64;
    u32x4 kreg[NCH], vreg[NCH]; float creg = 0.f;
#define ATT_ISSUE(tt_) do { const int k0_ = (tt_) * 64; \
        _Pragma("unroll") for (int it = 0; it < NCH; ++it) { const int ci = tid + 512 * it; const int row = ci / (HD / 8), ch = ci % (HD / 8); \
            kreg[it] = *(const u32x4*)(Kg + (size_t)(k0_ + row) * kvpitch + 8 * ch); \
            vreg[it] = *(const u32x4*)(Vg + (size_t)((tid >> 3) + 64 * it) * 256 + k0_ + 8 * (tid & 7)); } \
        if (MODE == 0 && tid < 64) creg = cseq[k0_ + tid]; } while (0)
    int t = (MODE == 1) ? ntiles - 1 : 0;
    ATT_ISSUE(t);
    for (int it_ = 0; it_ < ntiles; ++it_) {
        BAR_LGKM();
#pragma unroll
        for (int it = 0; it < NCH; ++it) { const int ci = tid + 512 * it; const int row = ci / (HD / 8), ch = ci % (HD / 8);
            *(u32x4*)(Ks + row * KP + ch * 16) = kreg[it];
            unsigned char* vp_ = Vts + ((tid >> 3) + 64 * it) * VP + (32 * ((tid & 7) >> 2) + 16 * (tid & 1) + 4 * ((tid >> 1) & 1)) * 2; const u32x4 v = vreg[it];
            *(u32x2*)vp_ = (u32x2){v.x, v.y}; *(u32x2*)(vp_ + 16) = (u32x2){v.z, v.w}; }
        if (MODE == 0 && tid < 64) cs[tid] = creg;
        BAR_LGKM();
        const int k0 = t * 64;
        const int tn = (MODE == 1) ? t - 1 : t + 1;
        if (it_ + 1 < ntiles) ATT_ISSUE(tn);
        f32x4 s[4];
#pragma unroll
        for (int j = 0; j < 4; ++j) { s[j] = (f32x4){0.f, 0.f, 0.f, 0.f};
#pragma unroll
            for (int kb = 0; kb < NKB; ++kb) { const bf16x8 a = *(const bf16x8*)(Ks + (16 * j + r16) * KP + (32 * kb + 8 * fq) * 2); s[j] = __builtin_amdgcn_mfma_f32_16x16x32_bf16(a, qf[kb], s[j], 0, 0, 0); } }
        if (MODE == 0 || MODE == 2) {
            float tmax = -INFINITY;
#pragma unroll
            for (int j = 0; j < 4; ++j) {
                f32x4 ck = (f32x4){0.f, 0.f, 0.f, 0.f}; if (MODE == 0) ck = *(const f32x4*)(cs + 16 * j + 4 * fq);
#pragma unroll
                for (int i = 0; i < 4; ++i) { float v = s[j][i] * scale; if (MODE == 0) { v += (cq - ck[i]) * LOG2E; if (k0 + 16 * j + 4 * fq + i > qrow) v = -INFINITY; } s[j][i] = v; tmax = fmaxf(tmax, v); } }
            tmax = fmaxf(tmax, __shfl_xor(tmax, 16)); tmax = fmaxf(tmax, __shfl_xor(tmax, 32));
            const float mnew = fmaxf(m_run, tmax); const float alpha = __builtin_amdgcn_exp2f(m_run - mnew); m_run = mnew;
            float ps = 0.f;
#pragma unroll
            for (int j = 0; j < 4; ++j)
#pragma unroll
                for (int i = 0; i < 4; ++i) { const float pv = __builtin_amdgcn_exp2f(s[j][i] - mnew); s[j][i] = pv; ps += pv; }
            l_part = l_part * alpha + ps;
#pragma unroll
            for (int dt = 0; dt < NDT; ++dt) o[dt] = o[dt] * alpha;
        } else {
            float lr[4][4], ls[4][4], g[4];
#pragma unroll
            for (int j = 0; j < 4; ++j) { g[j] = 0.f;
#pragma unroll
                for (int i = 0; i < 4; ++i) { const float lg = s[j][i] * scale; const float lsg = logsigmoidf_(lg); const bool valid = (k0 + 16 * j + 4 * fq + i) < qrow;
                    ls[j][i] = lsg; lr[j][i] = valid ? lsg - lg : 0.f; g[j] += lr[j][i]; } }
            float suffix = Rtot;
#pragma unroll
            for (int j = 3; j >= 0; --j) {
                const float ga = g[j], gb = __shfl_xor(ga, 16), gc = __shfl_xor(ga, 32), gd = __shfl_xor(ga, 48);
                const float within = (fq == 0) ? (gb + gc + gd) : (fq == 1) ? (gc + gd) : (fq == 2) ? gb : 0.f;
                float run = suffix + within;
#pragma unroll
                for (int i = 3; i >= 0; --i) { const bool valid = (k0 + 16 * j + 4 * fq + i) < qrow; s[j][i] = valid ? __expf(ls[j][i] + run) : 0.f; run += lr[j][i]; }
                suffix += (ga + gb) + (gc + gd);
            }
            Rtot = suffix;
        }
        bf16x8 pf[2];
#pragma unroll
        for (int kvb = 0; kvb < 2; ++kvb) { u32x4 w; w.x = pk2(s[2 * kvb][0], s[2 * kvb][1]); w.y = pk2(s[2 * kvb][2], s[2 * kvb][3]); w.z = pk2(s[2 * kvb + 1][0], s[2 * kvb + 1][1]); w.w = pk2(s[2 * kvb + 1][2], s[2 * kvb + 1][3]);
            pf[kvb] = __builtin_bit_cast(bf16x8, w); }
#pragma unroll
        for (int dt = 0; dt < NDT; ++dt)
#pragma unroll
            for (int kvb = 0; kvb < 2; ++kvb) { const bf16x8 a = *(const bf16x8*)(Vts + (16 * dt + r16) * VP + (32 * kvb + 8 * fq) * 2); o[dt] = __builtin_amdgcn_mfma_f32_16x16x32_bf16(a, pf[kvb], o[dt], 0, 0, 0); }
        if (MODE == 1) { if (__syncthreads_and(Rtot < -105.0f)) break; }
        t = tn;
    }
    float inv = 1.0f;
    if (MODE != 1) { float lt = l_part; lt += __shfl_xor(lt, 16); lt += __shfl_xor(lt, 32); inv = 1.0f / lt; }
#pragma unroll
    for (int dt = 0; dt < NDT; ++dt) { const f32x4 v = o[dt] * inv; u32x2 w; w.x = pk2(v.x, v.y); w.y = pk2(v.z, v.w);
        if (store) *(u32x2*)(Og + (size_t)qrow * qpitch + 16 * dt + 4 * fq) = w; }
    __syncthreads();
#undef ATT_ISSUE
}

typedef float f32x16 __attribute__((ext_vector_type(16)));
__device__ __forceinline__ int crow_(int r, int hi) { return (r & 3) + 8 * (r >> 2) + 4 * hi; }
template <int MODE>
__device__ __forceinline__ void attn64_unit(unsigned char* ldsb, const bf16_t* Qg, const bf16_t* Kg, const bf16_t* Vg, int pitch, bf16_t* Og, int q0, const float* cseq, float scale,
                                            int tid, int lane, int wave, bool store, const float* ktmax = nullptr) {
    constexpr int KP = 144, VP = 144, BUF = 64 * KP + 64 * VP + 256;
    const int r32 = lane & 31, hi = lane >> 5;
    const int qrow = q0 + 32 * wave + r32;
    bf16x8 qf[4];
#pragma unroll
    for (int ks = 0; ks < 4; ++ks) qf[ks] = *(const bf16x8*)(Qg + (size_t)qrow * pitch + 16 * ks + 8 * hi);
    f32x16 o0, o1;
#pragma unroll
    for (int r = 0; r < 16; ++r) { o0[r] = 0.f; o1[r] = 0.f; }
    float m_run = -INFINITY, l_part = 0.f, Rtot = 0.f;
    float cq = 0.f; if (MODE == 0) cq = cseq[qrow];
    float qs = 0.f;
    float* pmx = (float*)(ldsb + 2 * BUF);
    if (MODE == 0) {
        float ss = 0.f;
#pragma unroll
        for (int ks = 0; ks < 4; ++ks)
#pragma unroll
            for (int e = 0; e < 8; ++e) { const float v = __uint_as_float((unsigned)(unsigned short)qf[ks][e] << 16); ss += v * v; }
        ss += __shfl_xor(ss, 32); qs = sqrtf(ss) * scale * 1.01f;
        if (tid < 64) { float v = tid < 32 ? ktmax[tid] : 0.f;
#pragma unroll
            for (int o = 1; o < 32; o <<= 1) { const float u = __shfl_up(v, o); if ((tid & 31) >= o) v = fmaxf(v, u); }
            if (tid < 32) { pmx[tid] = v * 1.01f; pmx[64 + tid] = tid ? cseq[64 * tid - 1] : 0.f; } }
    }
    const int ntiles = (q0 + 256) / 64;
    const int qlo = q0 + 32 * wave;
    u32x4 kregA = (u32x4){0u, 0u, 0u, 0u}, vregA = kregA, kregB = kregA, vregB = kregA; float cregA = 0.f, cregB = 0.f;
    const int krow = tid >> 3, kch = tid & 7, vrow = tid & 63, vch = tid >> 6;
    const int vperm = (vrow & 0x33) | ((vrow & 4) << 1) | ((vrow & 8) >> 1);
#define A64_ISSUE(S, tt_) do { const int k0_ = (tt_) * 64; \
        kreg##S = *(const u32x4*)(Kg + (size_t)(k0_ + krow) * pitch + 8 * kch); vreg##S = *(const u32x4*)(Vg + (size_t)(k0_ + vrow) * pitch + 8 * vch); \
        if (MODE == 0 && tid < 64) creg##S = cseq[k0_ + tid]; } while (0)
#define A64_STORE(S, b_) do { unsigned char* B_ = ldsb + (b_) * BUF; *(u32x4*)(B_ + krow * KP + kch * 16) = kreg##S; \
        bf16_t* vd = (bf16_t*)(B_ + 64 * KP + (8 * vch) * VP + vperm * 2); const u32x4 v = vreg##S; \
        vd[0 * 72] = (bf16_t)(v.x & 0xffffu); vd[1 * 72] = (bf16_t)(v.x >> 16); vd[2 * 72] = (bf16_t)(v.y & 0xffffu); vd[3 * 72] = (bf16_t)(v.y >> 16); \
        vd[4 * 72] = (bf16_t)(v.z & 0xffffu); vd[5 * 72] = (bf16_t)(v.z >> 16); vd[6 * 72] = (bf16_t)(v.w & 0xffffu); vd[7 * 72] = (bf16_t)(v.w >> 16); \
        if (MODE == 0 && tid < 64) ((float*)(B_ + 64 * KP + 64 * VP))[tid] = creg##S; } while (0)
    int t = ntiles - 1;
    const int dt_ = -1;
    A64_ISSUE(A, t);
    A64_ISSUE(B, t + dt_);
    A64_STORE(A, 0);
    A64_ISSUE(A, t + 2 * dt_);
    int* vt = (int*)(ldsb + 2 * BUF + 512);
    BAR_LGKM();
    bool leave = false;
    for (int it0 = 0; it0 < ntiles && !leave; it0 += 2) {
#pragma unroll
    for (int half = 0; half < 2; ++half) { const int it_ = it0 + half;
        const unsigned char* Bc = ldsb + half * BUF; const unsigned char* Ks = Bc; const unsigned char* Vts = Bc + 64 * KP; const float* cs = (const float*)(Bc + 64 * KP + 64 * VP);
        { const int tn3 = (t - 3 > 0) ? t - 3 : 0;
          if (half) { A64_STORE(A, 0); A64_ISSUE(A, tn3); } else { A64_STORE(B, 1); A64_ISSUE(B, tn3); } }
        const int k0 = t * 64;
        if (k0 <= qlo + 31) {
            f32x16 p0, p1;
#pragma unroll
            for (int r = 0; r < 16; ++r) { p0[r] = 0.f; p1[r] = 0.f; }
#pragma unroll
            for (int ks = 0; ks < 4; ++ks) {
                const bf16x8 a0 = *(const bf16x8*)(Ks + r32 * KP + (16 * ks + 8 * hi) * 2), a1 = *(const bf16x8*)(Ks + (32 + r32) * KP + (16 * ks + 8 * hi) * 2);
                p0 = __builtin_amdgcn_mfma_f32_32x32x16_bf16(a0, qf[ks], p0, 0, 0, 0); p1 = __builtin_amdgcn_mfma_f32_32x32x16_bf16(a1, qf[ks], p1, 0, 0, 0); }
            const bool diag = (k0 + 63 >= qlo);
            bool skip_pv = false;
            if (MODE == 0) {
#pragma unroll
                for (int g = 0; g < 4; ++g) { const f32x4 c0 = *(const f32x4*)(cs + 8 * g + 4 * hi), c1 = *(const f32x4*)(cs + 32 + 8 * g + 4 * hi);
#pragma unroll
                    for (int i = 0; i < 4; ++i) { p0[4 * g + i] = __builtin_fmaf(p0[4 * g + i], scale, cq - c0[i]); p1[4 * g + i] = __builtin_fmaf(p1[4 * g + i], scale, cq - c1[i]); } }
                if (diag) {
#pragma unroll
                    for (int r = 0; r < 16; ++r) { const int kv = k0 + crow_(r, hi); if (kv > qrow) p0[r] = -INFINITY; if (kv + 32 > qrow) p1[r] = -INFINITY; }
                }
                float tmax = fmaxf(p0[0], p1[0]);
#pragma unroll
                for (int r = 1; r < 16; ++r) tmax = fmaxf(tmax, fmaxf(p0[r], p1[r]));
                tmax = fmaxf(tmax, __shfl_xor(tmax, 32));
                skip_pv = __all(tmax < m_run - 40.0f);
                if (!skip_pv) {
                    const float mnew = fmaxf(m_run, tmax); const float mref = (mnew == -INFINITY) ? 0.f : mnew; const float alpha = __builtin_amdgcn_exp2f(m_run - mref); m_run = mnew;
                    float ps = 0.f;
#pragma unroll
                    for (int r = 0; r < 16; ++r) { p0[r] = __builtin_amdgcn_exp2f(p0[r] - mref); p1[r] = __builtin_amdgcn_exp2f(p1[r] - mref); ps += p0[r] + p1[r]; }
                    l_part = l_part * alpha + ps;
                    o0 = o0 * alpha; o1 = o1 * alpha;
                }
            } else {
                float G[8]; f32x16 l0, l1;
#pragma unroll
                for (int r = 0; r < 16; ++r) { l0[r] = p0[r] * scale; l1[r] = p1[r] * scale; p0[r] = logsigmoidf_(l0[r]); p1[r] = logsigmoidf_(l1[r]);
                    const int kv = k0 + crow_(r, hi); l0[r] = (kv < qrow) ? p0[r] - l0[r] : 0.f; l1[r] = (kv + 32 < qrow) ? p1[r] - l1[r] : 0.f; }
#pragma unroll
                for (int g = 0; g < 4; ++g) { G[g] = (l0[4 * g] + l0[4 * g + 1]) + (l0[4 * g + 2] + l0[4 * g + 3]); G[4 + g] = (l1[4 * g] + l1[4 * g + 1]) + (l1[4 * g + 2] + l1[4 * g + 3]); }
                float suffix = Rtot;
#pragma unroll
                for (int th = 1; th >= 0; --th)
#pragma unroll
                    for (int g = 3; g >= 0; --g) { const float mine = G[th * 4 + g]; const float other = __shfl_xor(mine, 32);
                        float run = suffix + (hi == 0 ? other : 0.f);
#pragma unroll
                        for (int i = 3; i >= 0; --i) { const int r = 4 * g + i; const bool valid = (k0 + 32 * th + crow_(r, hi)) < qrow;
                            const float lsg = th ? p1[r] : p0[r]; const float lrr = th ? l1[r] : l0[r];
                            const float att = valid ? __expf(lsg + run) : 0.f; run += lrr; if (th) p1[r] = att; else p0[r] = att; }
                        suffix += mine + other; }
                Rtot = suffix;
            }
            if (!skip_pv) {
            bf16x8 pf[4];
#pragma unroll
            for (int s = 0; s < 4; ++s) { u32x4 w;
                if (s < 2) { const int b8 = 8 * s; w.x = pg8::cvt_pk_bf16(p0[b8], p0[b8 + 1]); w.y = pg8::cvt_pk_bf16(p0[b8 + 2], p0[b8 + 3]); w.z = pg8::cvt_pk_bf16(p0[b8 + 4], p0[b8 + 5]); w.w = pg8::cvt_pk_bf16(p0[b8 + 6], p0[b8 + 7]); }
                else { const int b8 = 8 * (s - 2); w.x = pg8::cvt_pk_bf16(p1[b8], p1[b8 + 1]); w.y = pg8::cvt_pk_bf16(p1[b8 + 2], p1[b8 + 3]); w.z = pg8::cvt_pk_bf16(p1[b8 + 4], p1[b8 + 5]); w.w = pg8::cvt_pk_bf16(p1[b8 + 6], p1[b8 + 7]); }
                pf[s] = __builtin_bit_cast(bf16x8, w); }
#pragma unroll
            for (int s = 0; s < 4; ++s) {
                const bf16x8 v0 = *(const bf16x8*)(Vts + r32 * VP + (16 * s + 8 * hi) * 2), v1 = *(const bf16x8*)(Vts + (32 + r32) * VP + (16 * s + 8 * hi) * 2);
                o0 = __builtin_amdgcn_mfma_f32_32x32x16_bf16(v0, pf[s], o0, 0, 0, 0); o1 = __builtin_amdgcn_mfma_f32_32x32x16_bf16(v1, pf[s], o1, 0, 0, 0); }
            }
        }
        bool done = false;
        if (MODE == 1) done = Rtot < -105.0f;
        else if (t > 0) {
            const float bnd = qs * pmx[t - 1] + (cq - pmx[64 + t]); done = bnd < m_run - 40.0f; }
        { const int wall = __all(done) ? 1 : 0; if (lane == 0) vt[(it_ & 1) * 8 + wave] = wall;
          BAR_LGKM();
          const int* vv = vt + (it_ & 1) * 8; const int all8 = (vv[0] & vv[1]) & (vv[2] & vv[3]) & (vv[4] & vv[5]) & (vv[6] & vv[7]);
          if (all8) { leave = true; break; } }
        t += dt_;
    }
    }
    float inv = 1.0f;
    if (MODE == 0) { float lt = l_part; lt += __shfl_xor(lt, 32); inv = 1.0f / lt; }
#pragma unroll
    for (int g = 0; g < 4; ++g) {
        u32x2 w0, w1; w0.x = pg8::cvt_pk_bf16(o0[4 * g] * inv, o0[4 * g + 1] * inv); w0.y = pg8::cvt_pk_bf16(o0[4 * g + 2] * inv, o0[4 * g + 3] * inv);
        w1.x = pg8::cvt_pk_bf16(o1[4 * g] * inv, o1[4 * g + 1] * inv); w1.y = pg8::cvt_pk_bf16(o1[4 * g + 2] * inv, o1[4 * g + 3] * inv);
        if (store) { *(u32x2*)(Og + (size_t)qrow * pitch + 8 * g + 4 * hi) = w0; *(u32x2*)(Og + (size_t)qrow * pitch + 32 + 8 * g + 4 * hi) = w1; } }
    __syncthreads();
#undef A64_ISSUE
#undef A64_STORE
}

#define GAS __attribute__((address_space(1)))
#define LAS __attribute__((address_space(3)))
#define RLX_AGENT __ATOMIC_RELAXED, __HIP_MEMORY_SCOPE_AGENT
#define XB_TMO      128
#define XB_XCNT(j)  (256  + 64 * (j))
#define XB_XSUB(j)  (1280 + 64 * (j))
#define XB_XGEN(j)  (2304 + 64 * (j))
#define XB_TOP      3328
#define XB_TOPGEN   3392
#define XCD_BAR_WORDS 3456
#define XB_SPIN_CAP (1u << 18)

__device__ __forceinline__ unsigned xb_ld(unsigned* p)              { return __hip_atomic_load(p, __ATOMIC_RELAXED, __HIP_MEMORY_SCOPE_AGENT); }
__device__ __forceinline__ unsigned xb_add(unsigned* p, unsigned v) { return __hip_atomic_fetch_add(p, v, __ATOMIC_RELAXED, __HIP_MEMORY_SCOPE_AGENT); }
__device__ __forceinline__ unsigned xb_xcc_id() { return (unsigned)__builtin_amdgcn_s_getreg((3 << 11) | 20) & 0xFu; }
#define XB_SPIN(cond, bar) do { unsigned _sp = 0; while (cond) { __builtin_amdgcn_s_sleep(1); \
    if ((++_sp & 255u) == 0u) { if (xb_ld(&(bar)[XB_TMO])) break; if (_sp > XB_SPIN_CAP) { atomicAdd(&(bar)[XB_TMO], 1u); break; } } } } while (0)

struct XcdBarrier {
    unsigned* bar; unsigned x;
    volatile LAS unsigned* st;
};

__device__ __forceinline__ XcdBarrier xcd_barrier_post(unsigned* bar, volatile LAS unsigned* st) {
    XcdBarrier b; b.bar = bar; b.x = xb_xcc_id(); b.st = st;
    if (threadIdx.x == 0) (void)xb_add(&bar[XB_XCNT(b.x)], 1u);
    return b;
}
__device__ __forceinline__ void xcd_barrier_complete(unsigned* bar, unsigned x, unsigned& nloc, unsigned& nx) {
    const unsigned G = gridDim.x * gridDim.y * gridDim.z;
    unsigned sum, cnt, mine, sp = 0u;
    for (;;) {
        sum = 0u; cnt = 0u; mine = 0u;
#pragma unroll
        for (unsigned j = 0; j < 16; ++j) { const unsigned c = xb_ld(&bar[XB_XCNT(j)]); sum += c; cnt += (c > 0u) ? 1u : 0u; mine = (j == x) ? c : mine; }
        if (sum == G) break;
        __builtin_amdgcn_s_sleep(1);
        if ((++sp & 255u) == 0u) { if (xb_ld(&bar[XB_TMO])) break; if (sp > XB_SPIN_CAP) { atomicAdd(&bar[XB_TMO], 1u); break; } }
    }
    nloc = mine > 0u ? mine : 1u; nx = cnt > 0u ? cnt : 1u;
}

__device__ __forceinline__ void xcd_barrier(const XcdBarrier& b) {
    asm volatile("s_waitcnt vmcnt(0)" ::: "memory");
    __syncthreads();
    if (threadIdx.x == 0) {
        unsigned* bar = b.bar;
        __builtin_amdgcn_s_waitcnt(0);
        unsigned nloc = b.st[0], nx = b.st[1];
        if (nloc == 0u) { xcd_barrier_complete(bar, b.x, nloc, nx); b.st[0] = nloc; b.st[1] = nx; }
        const unsigned old = xb_add(&bar[XB_XSUB(b.x)], 1u);
        const unsigned gen = old / nloc;
        if (old + 1u == (gen + 1u) * nloc) {
            __builtin_amdgcn_fence(__ATOMIC_RELEASE, "agent");
            asm volatile("s_waitcnt vmcnt(0)" ::: "memory");
            const unsigned og = xb_add(&bar[XB_TOP], 1u);
            const unsigned tg = og / nx;
            if (og + 1u == (tg + 1u) * nx) xb_add(&bar[XB_TOPGEN], 1u);
            else XB_SPIN(xb_ld(&bar[XB_TOPGEN]) == tg, bar);
            __builtin_amdgcn_fence(__ATOMIC_ACQUIRE, "agent");
            xb_add(&bar[XB_XGEN(b.x)], 1u);
            asm volatile("s_waitcnt vmcnt(0)" ::: "memory");
        } else {
            XB_SPIN(xb_ld(&bar[XB_XGEN(b.x)]) == gen, bar);
            __builtin_amdgcn_fence(__ATOMIC_ACQUIRE, "agent");
            asm volatile("s_waitcnt vmcnt(0)" ::: "memory");
        }
    }
    __syncthreads();
}

__global__ void __launch_bounds__(NTHREADS, 2) fwd_megakernel(Params p) {
    extern __shared__ __attribute__((aligned(16))) unsigned char lds[];
    cg::grid_group grid = cg::this_grid();
    __shared__ int s_unit;
    __shared__ unsigned s_bst[2];
    if (threadIdx.x < 2) s_bst[threadIdx.x] = 0u;
    __syncthreads();
    (void)xcd_barrier_post((unsigned*)(p.ws + WS_CTL) + 4096, (volatile LAS unsigned*)s_bst);
#define FRESH() const int tid = fresh_tid(), lane = tid & 63, wave = __builtin_amdgcn_readfirstlane(tid >> 6); const int bx = fresh_s((int)blockIdx.x), G = fresh_s((int)gridDim.x); \
    const int gw = bx * NWAVES + wave, ngw = G * NWAVES; unsigned char* ws = p.ws; PG8_LAS unsigned char* ldsl = (PG8_LAS unsigned char*)lds; \
    bf16_t* R1 = (bf16_t*)(ws + WS_R1); bf16_t* R2 = (bf16_t*)(ws + WS_R2); bf16_t* R3 = (bf16_t*)p.out; bf16_t* XB = (bf16_t*)(ws + WS_R3); bf16_t* MEMN = (bf16_t*)(ws + WS_MEMN); bf16_t* MKV = (bf16_t*)(ws + WS_MKV); float* xres = p.out; \
    (void)tid; (void)lane; (void)wave; (void)gw; (void)ngw; (void)ldsl; (void)R1; (void)R2; (void)R3; (void)XB; (void)MEMN; (void)MKV; (void)xres; (void)bx; (void)G;
#define NOSEG 1 << 30, 0, 1 << 30, 0
#ifdef PROBE_DUP_SYNC
#define GSYNC() do { xcd_barrier(xbar); xcd_barrier(xbar); } while (0)
#else
#define GSYNC() do { XcdBarrier xb_; xb_.bar = (unsigned*)(p.ws + WS_CTL) + 4096; xb_.x = xb_xcc_id(); xb_.st = (volatile LAS unsigned*)s_bst; xcd_barrier(xb_); } while (0)
#endif
#ifdef PROBE_DUP_GEMM
#define GEMM_REP for (int rep_ = 0; rep_ < 2; ++rep_)
#else
#define GEMM_REP
#endif
#ifdef PROBE_DUP_NORM
#define NORM_DRY(...) norm_rows(__VA_ARGS__)
#else
#define NORM_DRY(...)
#endif

    { FRESH();
#ifdef PROBE_DUP_CONV
      convert_weights(p, 0, lds, gw, ngw, lane, wave);
#endif
      convert_weights(p, 0, lds, gw, ngw, lane, wave);
      norm_rows<false, false>(gw, ngw, lane, MEMR, p.in[1], nullptr, nullptr, nullptr, p.in[23], MEMN);
      norm_rows<false, true>(gw, ngw, lane, M, p.in[0], nullptr, nullptr, XB, p.in[2], R3); }
    if (p.pad[1] == 0x5eed) grid.sync();
    GSYNC();

    for (int l = 0; l < 2; ++l) {
        { FRESH(); pg8::Gemm g{R3, (const bf16_t*)(ws + WS_WIN), M, ZP, D, D, NOSEG}; pg8::StaticOrder S; S.init(M, ZP, G, bx);
          pg8::EpiBf16 E{R1, ZP, (float*)(ws + WS_FL), 3328};
          GEMM_REP pg8::gemm_phase<pg8::EpiBf16, pg8::StaticOrder, true, true>(ldsl, g, S, E); }
        { FRESH(); pg8::Gemm g{MEMN, (const bf16_t*)(ws + WS_WKV), MEMR, D, D, D, NOSEG}; pg8::StaticOrder S; S.init(MEMR, D, G, bx);
          pg8::EpiBf16 E{MKV, 2 * D, nullptr, 0};
          GEMM_REP pg8::gemm_phase<pg8::EpiBf16, pg8::StaticOrder, true, true>(ldsl, g, S, E); }
        { FRESH(); pg8::Gemm g{MEMN, (const bf16_t*)(ws + WS_WKV) + (size_t)D * D, MEMR, D, D, D, NOSEG}; pg8::StaticOrder S; S.init(MEMR, D, G, (bx + G - 64) % G);
          pg8::EpiVT E{(bf16_t*)p.out + (size_t)32 * 1024 * 1024};
          GEMM_REP pg8::gemm_phase<pg8::EpiVT, pg8::StaticOrder, true, true>(ldsl, g, S, E); }
        GSYNC();
#ifdef PROBE_DUP_PRE
        { FRESH(); rwkv_pre(p, l, gw, ngw, lane); }
#endif
        { FRESH(); rwkv_pre(p, l, gw, ngw, lane); }
        GSYNC();
        { FRESH(); const int Kl = l ? 640 : 256, Nl = l ? 1536 : 1280;
          pg8::Gemm g{R3, (const bf16_t*)(ws + WS_WLORA), M, Nl, Kl, Kl, NOSEG}; pg8::StaticOrder S; S.init(M, Nl, G, bx);
          pg8::EpiBf16 E{R2, Nl, nullptr, 0};
          GEMM_REP pg8::gemm_phase<pg8::EpiBf16, pg8::StaticOrder, true, true>(ldsl, g, S, E); }
        GSYNC();
#ifdef PROBE_DUP_PREP2
        { FRESH(); rwkv_prep2(p, l, gw, ngw, lane); }
#endif
        { FRESH(); rwkv_prep2(p, l, gw, ngw, lane); }
        GSYNC();
#ifdef PROBE_DUP_SCAN
        { FRESH(); if (bx < 96) scan_unit(p, l, bx, lds, tid, lane, wave, p.pad[0] != 0); }
#endif
        { FRESH(); if (bx < 96) scan_unit(p, l, bx, lds, tid, lane, wave, true); }
#ifdef PROBE_DUP_ATT
        { FRESH(); unsigned* ctl = (unsigned*)(ws + WS_CTL);
        for (;;) {
            if (tid == 0) s_unit = (int)atomicAdd(&ctl[64 * (3 + l)], 1u);
            __syncthreads();
            const int u = s_unit;
            __syncthreads();
            if (u >= 768 + 512) break;
            if (u < 768) { const int qb = 7 - u / 96, bh = u % 96, b = bh / 6, h = bh % 6;
                bf16_t* base = R1 + (size_t)b * T * ZP + 1408 + h * 64;
                attn64_unit<0>(lds, base, base + 384, base + 768, ZP, base, qb * 256, (const float*)(ws + WS_CBUF) + (size_t)bh * T, 0.125f * LOG2E, tid, lane, wave, p.pad[0] != 0, (const float*)(ws + 512 * 1024) + bh * 32);
            } else { const int u2 = u - 768; const int qb = 7 - u2 / 64, bh = u2 % 64, b = bh / 4, h = bh % 4;
                bf16_t* base = R1 + (size_t)b * T * ZP + 2560 + h * 64;
                attn64_unit<1>(lds, base, base + 256, base + 512, ZP, base, qb * 256, nullptr, 0.125f, tid, lane, wave, p.pad[0] != 0);
            }
        } }
#endif
        { FRESH(); unsigned* ctl = (unsigned*)(ws + WS_CTL);
        for (;;) {
            if (tid == 0) s_unit = (int)atomicAdd(&ctl[64 * (1 + l)], 1u);
            __syncthreads();
            const int u = s_unit;
            __syncthreads();
            if (u >= 768 + 512) break;
            if (u < 768) { const int qb = 7 - u / 96, bh = u % 96, b = bh / 6, h = bh % 6;
                bf16_t* base = R1 + (size_t)b * T * ZP + 1408 + h * 64;
                attn64_unit<0>(lds, base, base + 384, base + 768, ZP, base, qb * 256, (const float*)(ws + WS_CBUF) + (size_t)bh * T, 0.125f * LOG2E, tid, lane, wave, true, (const float*)(ws + 512 * 1024) + bh * 32);
            } else { const int u2 = u - 768; const int qb = 7 - u2 / 64, bh = u2 % 64, b = bh / 4, h = bh % 4;
                bf16_t* base = R1 + (size_t)b * T * ZP + 2560 + h * 64;
                attn64_unit<1>(lds, base, base + 256, base + 512, ZP, base, qb * 256, nullptr, 0.125f, tid, lane, wave, true);
            }
        } }
        GSYNC();
        { FRESH(); pg8::Gemm g{R1, (const bf16_t*)(ws + WS_WOUT), M, D, D, ZP, 6, 2048, 12, 1536}; pg8::StaticOrder S; S.init(M, D, G, bx);
          pg8::EpiBf16 E{R2, D, nullptr, 0};
          GEMM_REP pg8::gemm_phase<pg8::EpiBf16, pg8::StaticOrder, true, true>(ldsl, g, S, E); }
        GSYNC();
        { FRESH(); norm_rows<true, true>(gw, ngw, lane, M, XB, R2, p.in[3] + l * D, XB, p.in[21] + l * D, R3); }
        GSYNC();
        { FRESH(); pg8::Gemm g{R3, (const bf16_t*)(ws + WS_WQ), M, D, D, D, NOSEG}; pg8::StaticOrder S; S.init(M, D, G, bx);
          pg8::EpiBf16 E{R1, D, nullptr, 0};
          GEMM_REP pg8::gemm_phase<pg8::EpiBf16, pg8::StaticOrder, true, true>(ldsl, g, S, E); }
        GSYNC();
#ifdef PROBE_DUP_MEM
        { FRESH();
        for (int u = bx; u < 1024; u += G) { const int qb = u & 15, bh = u >> 4, b = bh >> 2, hh = bh & 3;
            bf16_t* qbase = R1 + (size_t)b * T * D + hh * 256; const bf16_t* kbase = MKV + (size_t)b * 256 * (2 * D) + hh * 256;
            attn_unit<256, 2>(lds, qbase, D, kbase, (const bf16_t*)p.out + (size_t)32 * 1024 * 1024 + (size_t)bh * 65536, 2 * D, qbase, qb * 128, 256, nullptr, 0.0625f * LOG2E, tid, lane, wave, p.pad[0] != 0); } }
#endif
        { FRESH();
        for (int u = bx; u < 1024; u += G) { const int qb = u & 15, bh = u >> 4, b = bh >> 2, hh = bh & 3;
            bf16_t* qbase = R1 + (size_t)b * T * D + hh * 256; const bf16_t* kbase = MKV + (size_t)b * 256 * (2 * D) + hh * 256;
            attn_unit<256, 2>(lds, qbase, D, kbase, (const bf16_t*)p.out + (size_t)32 * 1024 * 1024 + (size_t)bh * 65536, 2 * D, qbase, qb * 128, 256, nullptr, 0.0625f * LOG2E, tid, lane, wave, true); } }
        GSYNC();
        { FRESH(); pg8::Gemm g{R1, (const bf16_t*)(ws + WS_WO), M, D, D, D, NOSEG}; pg8::StaticOrder S; S.init(M, D, G, bx);
          pg8::EpiBf16 E{R2, D, nullptr, 0};
          GEMM_REP pg8::gemm_phase<pg8::EpiBf16, pg8::StaticOrder, true, true>(ldsl, g, S, E); }
        GSYNC();
        { FRESH(); norm_rows<true, true>(gw, ngw, lane, M, XB, R2, p.in[22] + l * D, XB, p.in[27] + l * D, R3); }
        GSYNC();
        { FRESH(); pg8::Gemm g{R3, (const bf16_t*)(ws + WS_WGU), M, 2 * DFF, D, D, NOSEG}; pg8::StaticOrder S; S.init(M, 2 * DFF, G, bx);
          pg8::EpiSwiGLU E{R1, DFF};
          GEMM_REP pg8::gemm_phase<pg8::EpiSwiGLU, pg8::StaticOrder, true, true>(ldsl, g, S, E); }
        GSYNC();
        { FRESH(); pg8::Gemm g{R1, (const bf16_t*)(ws + WS_WDN), M, D, DFF, DFF, NOSEG}; pg8::StaticOrder S; S.init(M, D, G, bx);
          pg8::EpiBf16 E{R2, D, nullptr, 0};
          GEMM_REP pg8::gemm_phase<pg8::EpiBf16, pg8::StaticOrder, true, true>(ldsl, g, S, E); }
        GSYNC();
        if (l == 0) {
            { FRESH(); norm_rows<true, true>(gw, ngw, lane, M, XB, R2, p.in[28], XB, p.in[2] + D, R3);
#ifdef PROBE_DUP_CONV
              convert_weights(p, 1, lds, gw, ngw, lane, wave);
#endif
              convert_weights(p, 1, lds, gw, ngw, lane, wave);
              norm_rows<false, false>(gw, ngw, lane, MEMR, p.in[1], nullptr, nullptr, nullptr, p.in[23] + D, MEMN); }
            GSYNC();
        } else {
            { FRESH(); norm_rows<true, false>(gw, ngw, lane, M, XB, R2, p.in[28] + D, xres, nullptr, nullptr); }
        }
    }
}

extern "C" void kernel_launch(void* const* d_in, const int* in_sizes, int n_in, void* d_out, int out_size, void* d_ws, size_t ws_size, hipStream_t stream) {
    static int grid_blocks = 0;
    if (grid_blocks == 0) {
        if (n_in != 31 || out_size != M * D || ws_size < WS_END) { fprintf(stderr, "kernel_launch: unexpected shapes (n_in %d out %d ws %zu)\n", n_in, out_size, ws_size); grid_blocks = -1; return; }
        int dev = 0, cus = 0, per_cu = 0;
        hipGetDevice(&dev); hipDeviceGetAttribute(&cus, hipDeviceAttributeMultiprocessorCount, dev);
        if (hipFuncSetAttribute((const void*)fwd_megakernel, hipFuncAttributeMaxDynamicSharedMemorySize, LDS_BYTES) != hipSuccess) { fprintf(stderr, "kernel_launch: hipFuncSetAttribute failed\n"); grid_blocks = -1; return; }
        if (hipOccupancyMaxActiveBlocksPerMultiprocessor(&per_cu, (const void*)fwd_megakernel, NTHREADS, LDS_BYTES) != hipSuccess || per_cu < 1) { fprintf(stderr, "kernel_launch: occupancy query gave %d\n", per_cu); per_cu = 1; }
        (void)hipGetLastError();
        grid_blocks = cus * 1;
    }
    if (grid_blocks < 0) return;
    (void)hipMemsetAsync((char*)d_ws + WS_CTL, 0, 65536, stream);
    Params p{};
    for (int i = 0; i < 31; ++i) p.in[i] = (const float*)d_in[i];
    p.out = (float*)d_out; p.ws = (unsigned char*)d_ws;
    void* args[] = {&p};
    hipError_t e = hipLaunchCooperativeKernel((const void*)fwd_megakernel, dim3(grid_blocks), dim3(NTHREADS), args, LDS_BYTES, stream);
    if (e != hipSuccess) fprintf(stderr, "cooperative launch failed: %s (grid %d)\n", hipGetErrorString(e), grid_blocks);
}
```

```cpp
#include <hip/hip_runtime.h>
#include <hip/hip_cooperative_groups.h>
#include <cstdio>
#include <cstdint>
namespace cg = cooperative_groups;
__device__ __forceinline__ int fresh_tid() { int t = threadIdx.x; asm volatile("" : "+v"(t)); return t; }
__device__ __forceinline__ int fresh_s(int v) { asm volatile("" : "+s"(v)); return v; }
namespace pg8 {
#define PG8_LAS __attribute__((address_space(3)))
typedef unsigned short bf16_t;
typedef short bf16x8 __attribute__((ext_vector_type(8)));
typedef float f32x4 __attribute__((ext_vector_type(4)));
typedef unsigned u32x4 __attribute__((ext_vector_type(4)));
constexpr int BM = 256, BK = 64, HALF = 128, HTB = HALF * BK * 2  , STAGE_BYTES = 8 * HTB, NXCD = 8, WGM = 8;

__host__ __device__ __forceinline__ int lds_byte(int r, int c) { const int st = (r >> 4) * 2 + (c >> 5), rr = r & 15, cc = c & 31, ob = rr * 64 + cc * 2; return st * 1024 + (ob ^ (((ob >> 9) & 1) << 5)); }
__host__ __device__ __forceinline__ void stage_rc(int b, int& R, int& C) { const int st = b / 1024, sb = b % 1024, swz = sb ^ (((sb >> 9) & 1) << 5); R = (st >> 1) * 16 + swz / 64; C = (st & 1) * 32 + (swz % 64) / 2; }
__host__ __device__ __forceinline__ int perm32(int rho) { const int n = rho >> 4, i = rho & 15; return 8 * (i >> 2) + 4 * n + (i & 3); }

struct Unit { int pm, pn; };
struct Gemm { const bf16_t* A; const bf16_t* Bt; int M, N, K; int lda; int s1, d1, s2, d2; };

struct StaticOrder {
    int nM, nN, nwg, G, c;
    __host__ __device__ void init(int M, int N, int G_, int c_) { nM = M / BM; nN = N / BM; nwg = nM * nN; G = G_; c = c_; }
    __host__ __device__ bool next(int i, Unit& u) const {
        const long L = (long)i * G + c; if (L >= nwg) return false;
        int wgid = (int)L; { const int q = nwg / NXCD, r = nwg % NXCD, xcd = wgid % NXCD, off = wgid / NXCD; wgid = (xcd < r ? xcd * (q + 1) : r * (q + 1) + (xcd - r) * q) + off; }
        const int nig = WGM * nN, gid = wgid / nig, fm = gid * WGM, gsz = (nM - fm) < WGM ? (nM - fm) : WGM;
        u.pm = fm + ((wgid % nig) % gsz); u.pn = (wgid % nig) / gsz; return true;
    }
    __device__ __forceinline__ void a_ready(const Unit&) const {}
    __device__ __forceinline__ void done(const Unit&) const {}
};

__device__ __forceinline__ unsigned cvt_pk_bf16(float lo, float hi) { unsigned r; asm("v_cvt_pk_bf16_f32 %0, %1, %2" : "=v"(r) : "v"(lo), "v"(hi)); return r; }
typedef float f32x2 __attribute__((ext_vector_type(2)));
template <class Epi, class Sched, bool ALIGN_EPI = false, bool SP2 = false>
__device__ __forceinline__ void gemm_phase(PG8_LAS unsigned char* lds, const Gemm g, const Sched& S, const Epi& E) {
    static_assert(SP2, "only the SP2 loop carries the lda / segment changes");
    const int tid = fresh_tid(), wid = __builtin_amdgcn_readfirstlane(tid >> 6), lane = tid & 63, wr = wid >> 2, wc = wid & 3, fr = lane & 15, fq = lane >> 4;
    const int K = g.K, nt = K / BK;
    unsigned voffA[2], voffB[2];
#pragma unroll
    for (int i = 0; i < 2; ++i) { int R, C; stage_rc(tid * 16 + i * 8192, R, C); const int Rb = Epi::PERM ? ((R & ~31) + perm32(R & 31)) : R;
        voffA[i] = (unsigned)(R * g.lda + C) * 2u; voffB[i] = (unsigned)(Rb * K + C) * 2u; }
    const size_t kstep = (size_t)(BK * 2);
    const size_t hstep = (size_t)HALF * K * 2, hstepA = (size_t)HALF * g.lda * 2;
    const size_t tstep = 2 * hstep, tstepA = 2 * hstepA;
#define PG8_KA(t) ((size_t)(t) * 128 + ((t) >= g.s1 ? (size_t)g.d1 : 0) + ((t) >= g.s2 ? (size_t)g.d2 : 0))
    const unsigned ldsw = (unsigned)wid * 1024u;
    const int aoff = lds_byte(wr * 64 + fr, fq * 8), boff = lds_byte(wc * 32 + fr, fq * 8);
#define PG8_SA(b, h) (((b) * 2 + (h)) * HTB)
#define PG8_SB(b, h) ((4 + (b) * 2 + (h)) * HTB)
#define PG8_STAGE(bufoff, gbase, voff) do { _Pragma("unroll") for (int _i = 0; _i < 2; ++_i) \
        __builtin_amdgcn_global_load_lds((const unsigned*)((const char*)(gbase) + (voff)[_i]), (PG8_LAS unsigned*)(lds + (bufoff) + ldsw + _i * 8192), 16, 0, 0); } while (0)
#define PG8_LDA(dst, b, h) do { _Pragma("unroll") for (int m = 0; m < 4; ++m) _Pragma("unroll") for (int k = 0; k < 2; ++k) dst[m][k] = *(const PG8_LAS bf16x8*)(lds + PG8_SA(b, h) + aoff + m * 2048 + k * 1024); } while (0)
#define PG8_LDB(dst, b, h) do { _Pragma("unroll") for (int n = 0; n < 2; ++n) _Pragma("unroll") for (int k = 0; k < 2; ++k) dst[n][k] = *(const PG8_LAS bf16x8*)(lds + PG8_SB(b, h) + boff + n * 2048 + k * 1024); } while (0)
#define PG8_MMA(ai, bj, At, Bt) do { __builtin_amdgcn_s_setprio(1); _Pragma("unroll") for (int m = 0; m < 4; ++m) _Pragma("unroll") for (int n = 0; n < 2; ++n) _Pragma("unroll") for (int k = 0; k < 2; ++k) \
        acc[ai][bj][m][n] = __builtin_amdgcn_mfma_f32_16x16x32_bf16(Bt[n][k], At[m][k], acc[ai][bj][m][n], 0, 0, 0); __builtin_amdgcn_s_setprio(0); } while (0)
#define PG8_WAIT_V(n) asm volatile("s_waitcnt vmcnt(" #n ")" ::: "memory")
#define PG8_WAIT_L(n) asm volatile("s_waitcnt lgkmcnt(" #n ")" ::: "memory")
#define PG8_BAR __builtin_amdgcn_s_barrier()
#define PG8_SCHED __builtin_amdgcn_sched_barrier(0)
    Unit cur, nxt; int ui = 0;
    if (!S.next(0, cur)) return;
    f32x4 acc[2][2][4][2];
#pragma unroll
    for (int a = 0; a < 2; ++a)
#pragma unroll
        for (int b = 0; b < 2; ++b)
#pragma unroll
            for (int m = 0; m < 4; ++m)
#pragma unroll
                for (int n = 0; n < 2; ++n) acc[a][b][m][n] = (f32x4){0.f, 0.f, 0.f, 0.f};
    bf16x8 At[4][2], B0[2][2], B1[2][2];
    const char* cA = (const char*)g.A + (size_t)cur.pm * tstepA; const char* cB = (const char*)g.Bt + (size_t)cur.pn * tstep;
    S.a_ready(cur);
    if constexpr (SP2) {
        PG8_STAGE(PG8_SB(0, 0), cB, voffB); PG8_STAGE(PG8_SB(0, 1), cB + hstep, voffB); PG8_STAGE(PG8_SA(0, 0), cA, voffA); PG8_STAGE(PG8_SA(0, 1), cA + hstepA, voffA);
        if (wr == 1) PG8_BAR;
        PG8_WAIT_V(2); PG8_BAR;
        PG8_STAGE(PG8_SB(1, 0), cB + kstep, voffB); PG8_STAGE(PG8_SA(1, 0), cA + PG8_KA(1), voffA); PG8_STAGE(PG8_SB(1, 1), cB + hstep + kstep, voffB);
        PG8_WAIT_V(6); PG8_BAR;
    } else {
        PG8_STAGE(PG8_SB(0, 0), cB, voffB); PG8_STAGE(PG8_SA(0, 0), cA, voffA); PG8_STAGE(PG8_SB(0, 1), cB + hstep, voffB); PG8_STAGE(PG8_SA(0, 1), cA + hstep, voffA);
        if (wr == 1) PG8_BAR;
        PG8_WAIT_V(4); PG8_BAR;
        PG8_STAGE(PG8_SB(1, 0), cB + kstep, voffB); PG8_STAGE(PG8_SA(1, 0), cA + kstep, voffA); PG8_STAGE(PG8_SB(1, 1), cB + hstep + kstep, voffB);
        PG8_WAIT_V(6); PG8_BAR;
    }
    for (;;) {
        const bool has_next = S.next(ui + 1, nxt);
        const char* nA = has_next ? (const char*)g.A + (size_t)nxt.pm * tstepA : cA; const char* nB = has_next ? (const char*)g.Bt + (size_t)nxt.pn * tstep : cB;
        for (int t = 0; t < nt; t += 2) {
            const bool last = (t == nt - 2);
            const char* a1 = cA + PG8_KA(t + 1);
            const char* a2 = last ? nA : cA + PG8_KA(t + 2); const char* b2 = last ? nB : cB + (size_t)(t + 2) * kstep;
            const char* a3 = last ? nA + PG8_KA(1) : cA + PG8_KA(t + 3); const char* b3 = b2 + kstep;
            if (last && has_next) S.a_ready(nxt);
            if constexpr (SP2) {
            PG8_LDB(B0, 0, 0); PG8_LDB(B1, 0, 1); PG8_SCHED; PG8_LDA(At, 0, 0); PG8_STAGE(PG8_SA(1, 1), a1 + hstepA, voffA);
            PG8_WAIT_V(8); PG8_WAIT_L(0); PG8_BAR; PG8_MMA(0, 0, At, B0); PG8_MMA(0, 1, At, B1); PG8_BAR; PG8_SCHED;
            PG8_LDA(At, 0, 1); PG8_STAGE(PG8_SB(0, 0), b2, voffB); PG8_STAGE(PG8_SB(0, 1), b2 + hstep, voffB); PG8_STAGE(PG8_SA(0, 0), a2, voffA);
            PG8_WAIT_V(8); PG8_WAIT_L(0); PG8_BAR; PG8_MMA(1, 0, At, B0); PG8_MMA(1, 1, At, B1); PG8_BAR; PG8_SCHED;
            PG8_LDB(B0, 1, 0); PG8_LDB(B1, 1, 1); PG8_SCHED; PG8_LDA(At, 1, 0); PG8_STAGE(PG8_SA(0, 1), a2 + hstepA, voffA);
            PG8_WAIT_V(8); PG8_WAIT_L(0); PG8_BAR; PG8_MMA(0, 0, At, B0); PG8_MMA(0, 1, At, B1); PG8_BAR; PG8_SCHED;
            PG8_LDA(At, 1, 1); PG8_STAGE(PG8_SB(1, 0), b3, voffB); PG8_STAGE(PG8_SB(1, 1), b3 + hstep, voffB); PG8_STAGE(PG8_SA(1, 0), a3, voffA);
            PG8_WAIT_V(8); PG8_WAIT_L(0); PG8_BAR; PG8_MMA(1, 0, At, B0); PG8_MMA(1, 1, At, B1); PG8_BAR; PG8_SCHED;
            } else {
            PG8_LDB(B0, 0, 0); PG8_SCHED; PG8_LDA(At, 0, 0); PG8_STAGE(PG8_SA(1, 1), a1 + hstep, voffA);
            PG8_WAIT_L(8); PG8_BAR; PG8_WAIT_L(0); PG8_MMA(0, 0, At, B0); PG8_BAR; PG8_SCHED;
            PG8_LDB(B1, 0, 1); PG8_STAGE(PG8_SB(0, 0), b2, voffB);
            PG8_BAR; PG8_WAIT_L(0); PG8_MMA(0, 1, At, B1); PG8_BAR;
            PG8_LDA(At, 0, 1); PG8_STAGE(PG8_SA(0, 0), a2, voffA);
            PG8_BAR; PG8_WAIT_L(0); PG8_MMA(1, 0, At, B0); PG8_BAR; PG8_SCHED;
            PG8_STAGE(PG8_SB(0, 1), b2 + hstep, voffB);
            PG8_WAIT_V(6); PG8_BAR; PG8_MMA(1, 1, At, B1); PG8_BAR;
            PG8_LDB(B0, 1, 0); PG8_SCHED; PG8_LDA(At, 1, 0); PG8_STAGE(PG8_SA(0, 1), a2 + hstep, voffA);
            PG8_WAIT_L(8); PG8_BAR; PG8_WAIT_L(0); PG8_MMA(0, 0, At, B0); PG8_BAR; PG8_SCHED;
            PG8_LDB(B1, 1, 1); PG8_STAGE(PG8_SB(1, 0), b3, voffB);
            PG8_BAR; PG8_WAIT_L(0); PG8_MMA(0, 1, At, B1); PG8_BAR;
            PG8_LDA(At, 1, 1); PG8_STAGE(PG8_SA(1, 0), a3, voffA);
            PG8_BAR; PG8_WAIT_L(0); PG8_MMA(1, 0, At, B0); PG8_BAR; PG8_SCHED;
            PG8_STAGE(PG8_SB(1, 1), b3 + hstep, voffB);
            PG8_WAIT_V(6); PG8_BAR; PG8_MMA(1, 1, At, B1); PG8_BAR;
            }
        }
        if constexpr (ALIGN_EPI) { if (wr == 0) PG8_BAR; }
        if constexpr (!Epi::AFTER_DRAIN) { E(acc, cur, wr, wc, fr, fq); S.done(cur); }
        if (!has_next) break;
#pragma unroll
        for (int a = 0; a < 2; ++a)
#pragma unroll
            for (int b = 0; b < 2; ++b)
#pragma unroll
                for (int m = 0; m < 4; ++m)
#pragma unroll
                    for (int n = 0; n < 2; ++n) acc[a][b][m][n] = (f32x4){0.f, 0.f, 0.f, 0.f};
        cur = nxt; cA = nA; cB = nB; ++ui;
        if constexpr (ALIGN_EPI) { if (wr == 1) PG8_BAR; }
    }
    PG8_WAIT_V(0);
    if constexpr (!ALIGN_EPI) { if (wr == 0) PG8_BAR; }
    PG8_BAR;
    if constexpr (Epi::AFTER_DRAIN) { E.fused(acc, cur, wr, wc, fr, fq, lds, wid, lane); S.done(cur); }
#undef PG8_SA
#undef PG8_KA
#undef PG8_SB
#undef PG8_STAGE
#undef PG8_LDA
#undef PG8_LDB
#undef PG8_MMA
#undef PG8_WAIT_V
#undef PG8_WAIT_L
#undef PG8_BAR
#undef PG8_SCHED
}
}

namespace pg8 {
struct EpiBf16 {
    static constexpr bool PERM = true, AFTER_DRAIN = false;
    bf16_t* O; int ldc; float* fl; int flcol;
    __device__ __forceinline__ void operator()(const f32x4 (&acc)[2][2][4][2], const Unit& u, int wr, int wc, int fr, int fq) const {
        const int row0 = u.pm * BM + wr * 64 + fr; const int colt = u.pn * BM; const int col0 = colt + wc * 32 + 8 * fq;
#pragma unroll
        for (int ai = 0; ai < 2; ++ai)
#pragma unroll
            for (int m = 0; m < 4; ++m) { bf16_t* rowp = O + (size_t)(row0 + ai * HALF + m * 16) * ldc + col0;
#pragma unroll
                for (int bj = 0; bj < 2; ++bj) { const f32x4 v0 = acc[ai][bj][m][0], v1 = acc[ai][bj][m][1];
                    u32x4 w; w.x = cvt_pk_bf16(v0[0], v0[1]); w.y = cvt_pk_bf16(v0[2], v0[3]); w.z = cvt_pk_bf16(v1[0], v1[1]); w.w = cvt_pk_bf16(v1[2], v1[3]);
                    *(u32x4*)(rowp + bj * HALF) = w; } }
        if (fl != nullptr && colt == flcol && wc == 0 && fq == 0) {
#pragma unroll
            for (int ai = 0; ai < 2; ++ai)
#pragma unroll
                for (int m = 0; m < 4; ++m) { float* p = fl + (size_t)(row0 + ai * HALF + m * 16) * 8; *(f32x4*)p = acc[ai][0][m][0]; *(f32x4*)(p + 4) = acc[ai][0][m][1]; }
        }
    }
};

struct EpiVT {
    static constexpr bool PERM = true, AFTER_DRAIN = false;
    bf16_t* VT;
    __device__ __forceinline__ void operator()(const f32x4 (&acc)[2][2][4][2], const Unit& u, int wr, int wc, int fr, int fq) const {
        {
            bf16_t* lanebase = VT + (size_t)(u.pm * 4 + u.pn) * 65536 + (size_t)(wc * 32 + 8 * fq) * 256 + wr * 64 + fr;
#pragma unroll
            for (int ai = 0; ai < 2; ++ai)
#pragma unroll
                for (int m = 0; m < 4; ++m) { bf16_t* pk = lanebase + ai * HALF + m * 16; asm volatile("" : "+v"(pk));
#pragma unroll
                    for (int bj = 0; bj < 2; ++bj)
#pragma unroll
                        for (int n = 0; n < 2; ++n) { const int d0 = bj * HALF + 4 * n; const f32x4 v = acc[ai][bj][m][n];
                            const unsigned w0 = cvt_pk_bf16(v[0], v[1]), w1 = cvt_pk_bf16(v[2], v[3]);
                            pk[(d0 + 0) * 256] = (bf16_t)(w0 & 0xffffu); pk[(d0 + 1) * 256] = (bf16_t)(w0 >> 16);
                            pk[(d0 + 2) * 256] = (bf16_t)(w1 & 0xffffu); pk[(d0 + 3) * 256] = (bf16_t)(w1 >> 16); }
                    asm volatile("" ::: "memory"); }
        }
    }
};
struct EpiSwiGLU {
    static constexpr bool PERM = true, AFTER_DRAIN = false;
    bf16_t* O; int ldc;
    __device__ __forceinline__ void operator()(const f32x4 (&acc)[2][2][4][2], const Unit& u, int wr, int wc, int fr, int fq) const {
        const int row0 = u.pm * BM + wr * 64 + fr; const int col0 = u.pn * HALF + wc * 32 + 8 * fq;
#pragma unroll
        for (int ai = 0; ai < 2; ++ai)
#pragma unroll
            for (int m = 0; m < 4; ++m) { bf16_t* rowp = O + (size_t)(row0 + ai * HALF + m * 16) * ldc + col0;
                float h[8];
#pragma unroll
                for (int n = 0; n < 2; ++n)
#pragma unroll
                    for (int i = 0; i < 4; ++i) { const float g = acc[ai][0][m][n][i], up = acc[ai][1][m][n][i]; h[n * 4 + i] = g * __builtin_amdgcn_rcpf(1.0f + __expf(-g)) * up; }
                u32x4 w; w.x = cvt_pk_bf16(h[0], h[1]); w.y = cvt_pk_bf16(h[2], h[3]); w.z = cvt_pk_bf16(h[4], h[5]); w.w = cvt_pk_bf16(h[6], h[7]);
                *(u32x4*)rowp = w; }
    }
};
}

typedef unsigned short bf16_t;
typedef short bf16x8 __attribute__((ext_vector_type(8)));
typedef float f32x4 __attribute__((ext_vector_type(4)));
typedef unsigned u32x4 __attribute__((ext_vector_type(4)));
typedef unsigned u32x2 __attribute__((ext_vector_type(2)));

constexpr int NB = 16, T = 2048, D = 1024, M = NB * T;
constexpr int ZP = 3584;
constexpr int A_COLS = 1408, IN_COLS = 3334, DFF = 2816;
constexpr int MEMR = NB * 256;
constexpr float RMS_EPS = 1e-6f, GN_EPS = 64e-5f;
constexpr float LOG2E = 1.4426950408889634f;
constexpr size_t MiB = 1u << 20;
constexpr size_t WS_CTL = 0, WS_WIN = 1 * MiB, WS_WLORA = 8 * MiB, WS_WOUT = 10 * MiB, WS_WQ = 12 * MiB, WS_WKV = 14 * MiB, WS_WO = 18 * MiB, WS_WGU = 20 * MiB, WS_WDN = 31 * MiB,
                 WS_CBUF = 37 * MiB, WS_FL = 38 * MiB, WS_MKV = 40 * MiB, WS_VFIRST = 56 * MiB, WS_R3 = 80 * MiB, WS_R2 = 144 * MiB, WS_R1 = 240 * MiB, WS_MEMN = 464 * MiB, WS_VFIN = 472 * MiB, WS_GEND = 496 * MiB, WS_SCAL = 502 * MiB, WS_END = 505 * MiB;
constexpr int NTHREADS = 512, NWAVES = 8;
constexpr int LDS_BYTES = 147456;

struct Params { const float* in[31]; float* out; unsigned char* ws; int pad[2]; };

__device__ __forceinline__ float bf2f(bf16_t v) { return __uint_as_float((unsigned)v << 16); }
__device__ __forceinline__ unsigned f2bf(float f) { return pg8::cvt_pk_bf16(f, 0.f) & 0xffffu; }
__device__ __forceinline__ unsigned pk2(float lo, float hi) { return pg8::cvt_pk_bf16(lo, hi); }
__device__ __forceinline__ float lo16(unsigned w) { return __uint_as_float(w << 16); }
__device__ __forceinline__ float hi16(unsigned w) { return __uint_as_float(w & 0xffff0000u); }
#define WS_DPP(x, ctrl) ((x) + __int_as_float(__builtin_amdgcn_update_dpp(0, __float_as_int(x), (ctrl), 0xF, 0xF, true)))
__device__ __forceinline__ float wave_sum(float v) {
    v = WS_DPP(v, 0xB1); v = WS_DPP(v, 0x4E); v = WS_DPP(v, 0x141); v = WS_DPP(v, 0x140);
    const int iv = __float_as_int(v);
    return (__int_as_float(__builtin_amdgcn_readlane(iv, 0)) + __int_as_float(__builtin_amdgcn_readlane(iv, 16))) + (__int_as_float(__builtin_amdgcn_readlane(iv, 32)) + __int_as_float(__builtin_amdgcn_readlane(iv, 48)));
}
#define BAR_LGKM() asm volatile("s_waitcnt lgkmcnt(0)\n\ts_barrier" ::: "memory")
__device__ __forceinline__ float sigmoidf_(float x) { return __builtin_amdgcn_rcpf(1.0f + __expf(-x)); }
__device__ __forceinline__ float logsigmoidf_(float x) { return fminf(x, 0.f) - __logf(1.0f + __expf(-fabsf(x))); }

__device__ __forceinline__ int colmap(int mode, int n) {
    if (mode == 1) { if (n < 2560) return n; if (n < 3328) return n + 6; if (n < 3334) return n - 768; return -1; }
    if (mode == 2) { const int tile = n >> 8, w = n & 255; return w < 128 ? tile * 128 + w : DFF + tile * 128 + (w - 128); }
    return n;
}
__device__ __forceinline__ void transpose_item(const float* __restrict__ W, int Nsrc, int K, bf16_t* WT, int nblk, int mode, float* scr, int item, int lane) {
    const int kb = item / nblk, nb = item % nblk, k0 = 64 * kb, n0 = 32 * nb;
    const int src = colmap(mode, n0 + (lane & 31));
#pragma unroll 8
    for (int i = 0; i < 32; ++i) { const int kk = 2 * i + (lane >> 5); scr[kk * 33 + (lane & 31)] = src >= 0 ? W[(size_t)(k0 + kk) * Nsrc + src] : 0.f; }
    asm volatile("s_waitcnt lgkmcnt(0)" ::: "memory");
    const int c = lane & 7;
#pragma unroll
    for (int j = 0; j < 4; ++j) { const int n = (lane >> 3) + 8 * j; const float* s = scr + (8 * c) * 33 + n;
        u32x4 o; o.x = pk2(s[0 * 33], s[1 * 33]); o.y = pk2(s[2 * 33], s[3 * 33]); o.z = pk2(s[4 * 33], s[5 * 33]); o.w = pk2(s[6 * 33], s[7 * 33]);
        *(u32x4*)(WT + (size_t)(n0 + n) * K + k0 + 8 * c) = o; }
    asm volatile("s_waitcnt lgkmcnt(0)" ::: "memory");
}
__device__ __forceinline__ void convert_weights(const Params& p, int l, unsigned char* lds, int gw, int ngw, int lane, int wave) {
    unsigned char* ws = p.ws;
    float* scr = (float*)(lds + wave * 16384);
    constexpr int I_IN = 16 * (ZP / 32), I_SQ = 16 * 32, I_KV = 16 * 64, I_GU = 16 * (2 * DFF / 32), I_DN = (DFF / 64) * 32;
    constexpr int NITEMS = I_IN + 3 * I_SQ + I_KV + I_GU + I_DN;
    for (int it = gw; it < NITEMS; it += ngw) {
        int r = it;
        if (r < I_IN) { transpose_item(p.in[4] + (size_t)l * D * IN_COLS, IN_COLS, D, (bf16_t*)(ws + WS_WIN), ZP / 32, 1, scr, r, lane); continue; } r -= I_IN;
        if (r < I_SQ) { transpose_item(p.in[20] + (size_t)l * D * D, D, D, (bf16_t*)(ws + WS_WOUT), 32, 0, scr, r, lane); continue; } r -= I_SQ;
        if (r < I_SQ) { transpose_item(p.in[24] + (size_t)l * D * D, D, D, (bf16_t*)(ws + WS_WQ), 32, 0, scr, r, lane); continue; } r -= I_SQ;
        if (r < I_SQ) { transpose_item(p.in[26] + (size_t)l * D * D, D, D, (bf16_t*)(ws + WS_WO), 32, 0, scr, r, lane); continue; } r -= I_SQ;
        if (r < I_KV) { transpose_item(p.in[25] + (size_t)l * D * 2 * D, 2 * D, D, (bf16_t*)(ws + WS_WKV), 64, 0, scr, r, lane); continue; } r -= I_KV;
        if (r < I_GU) { transpose_item(p.in[29] + (size_t)l * D * 2 * DFF, 2 * DFF, D, (bf16_t*)(ws + WS_WGU), 2 * DFF / 32, 2, scr, r, lane); continue; } r -= I_GU;
        transpose_item(p.in[30] + (size_t)l * DFF * D, D, DFF, (bf16_t*)(ws + WS_WDN), 32, 0, scr, r, lane);
    }
    const int Kl = l ? 640 : 256, Nl = l ? 1536 : 1280, kch = Kl / 8;
    const float* w_up = p.in[7] + (size_t)l * 64 * 384; const float* a_up = p.in[9] + (size_t)l * 64 * 384; const float* g_up = p.in[10] + (size_t)l * 128 * 384;
    const float* vdn = p.in[17]; const float* vup = p.in[18];
    bf16_t* WL = (bf16_t*)(ws + WS_WLORA);
    for (int ci = gw * 64 + lane; ci < Nl * kch; ci += ngw * 64) {
        const int n = ci / kch, k0 = (ci % kch) * 8; float v[8];
#pragma unroll
        for (int e = 0; e < 8; ++e) { const int k = k0 + e; float x = 0.f;
            if (n < 384) { if (k < 64) x = w_up[k * 384 + n]; }
            else if (n < 768) { if (k >= 64 && k < 128) x = a_up[(k - 64) * 384 + n - 384]; }
            else if (n < 1152) { if (k >= 128 && k < 256) x = g_up[(k - 128) * 384 + n - 768]; }
            else if (n < 1536 && l == 1) { if (k >= 256) { float s = 0.f; for (int r = 0; r < 32; ++r) s += vdn[(k - 256) * 32 + r] * vup[r * 384 + n - 1152]; x = s; } }
            v[e] = x; }
        u32x4 o; o.x = pk2(v[0], v[1]); o.y = pk2(v[2], v[3]); o.z = pk2(v[4], v[5]); o.w = pk2(v[6], v[7]);
        *(u32x4*)(WL + (size_t)n * Kl + k0) = o;
    }
}

template <bool XIB, bool XOB>
__device__ __forceinline__ void norm_rows(int gw, int ngw, int lane, int rows, const void* xin_, const bf16_t* y, const float* gpost, void* xout_, const float* gpre, bf16_t* hout) {
    constexpr int NR = 4;
    const float* xin = (const float*)xin_; const bf16_t* xinb = (const bf16_t*)xin_; float* xout = (float*)xout_; bf16_t* xoutb = (bf16_t*)xout_;
    for (int row0 = gw; row0 < rows; row0 += NR * ngw) {
        int rw[NR]; bool ok[NR];
#pragma unroll
        for (int k = 0; k < NR; ++k) { const int r = row0 + k * ngw; ok[k] = r < rows; rw[k] = ok[k] ? r : row0; }
        f32x4 x[NR][4]; u32x2 yy[NR][4];
#pragma unroll
        for (int k = 0; k < NR; ++k)
#pragma unroll
            for (int j = 0; j < 4; ++j) {
                if (XIB) { const u32x2 w = *(const u32x2*)(xinb + (size_t)rw[k] * D + 256 * j + 4 * lane); x[k][j] = (f32x4){lo16(w.x), hi16(w.x), lo16(w.y), hi16(w.y)}; }
                else x[k][j] = *(const f32x4*)(xin + (size_t)rw[k] * D + 256 * j + 4 * lane); }
        if (y != nullptr) {
#pragma unroll
            for (int k = 0; k < NR; ++k)
#pragma unroll
                for (int j = 0; j < 4; ++j) yy[k][j] = *(const u32x2*)(y + (size_t)rw[k] * D + 256 * j + 4 * lane);
#pragma unroll
            for (int k = 0; k < NR; ++k) {
                f32x4 v[4]; float ss = 0.f;
#pragma unroll
                for (int j = 0; j < 4; ++j) { v[j] = (f32x4){lo16(yy[k][j].x), hi16(yy[k][j].x), lo16(yy[k][j].y), hi16(yy[k][j].y)}; ss += (v[j].x * v[j].x + v[j].y * v[j].y) + (v[j].z * v[j].z + v[j].w * v[j].w); }
                const float r = rsqrtf(wave_sum(ss) * (1.0f / D) + RMS_EPS);
#pragma unroll
                for (int j = 0; j < 4; ++j) { const f32x4 g = *(const f32x4*)(gpost + 256 * j + 4 * lane); x[k][j] = x[k][j] + v[j] * r * g; }
            }
        }
        if (xout_ != nullptr) {
#pragma unroll
            for (int k = 0; k < NR; ++k) if (ok[k]) {
#pragma unroll
                for (int j = 0; j < 4; ++j) {
                    if (XOB) { u32x2 w; w.x = pk2(x[k][j].x, x[k][j].y); w.y = pk2(x[k][j].z, x[k][j].w); *(u32x2*)(xoutb + (size_t)rw[k] * D + 256 * j + 4 * lane) = w; }
                    else *(f32x4*)(xout + (size_t)rw[k] * D + 256 * j + 4 * lane) = x[k][j]; } }
        }
        if (gpre != nullptr) {
#pragma unroll
            for (int k = 0; k < NR; ++k) {
                float ss = 0.f;
#pragma unroll
                for (int j = 0; j < 4; ++j) ss += (x[k][j].x * x[k][j].x + x[k][j].y * x[k][j].y) + (x[k][j].z * x[k][j].z + x[k][j].w * x[k][j].w);
                const float r = rsqrtf(wave_sum(ss) * (1.0f / D) + RMS_EPS);
                if (ok[k]) {
#pragma unroll
                    for (int j = 0; j < 4; ++j) { const f32x4 g = *(const f32x4*)(gpre + 256 * j + 4 * lane); const f32x4 h = x[k][j] * r * g;
                        u32x2 w; w.x = pk2(h.x, h.y); w.y = pk2(h.z, h.w); *(u32x2*)(hout + (size_t)rw[k] * D + 256 * j + 4 * lane) = w; } }
            }
        }
    }
}

__device__ __forceinline__ void rwkv_pre(const Params& p, int l, int gw, int ngw, int lane) {
    const bf16_t* z = (const bf16_t*)(p.ws + WS_R1); bf16_t* lin = (bf16_t*)p.out; bf16_t* vfirst = (bf16_t*)(p.ws + WS_VFIRST);
    const float* mu = p.in[5] + (size_t)l * A_COLS; const int Kl = l ? 640 : 256;
    constexpr int NU = 4; const int nlanes = ngw * 64;
    for (int base = gw * 64 + lane; base < M * 80; base += NU * nlanes) {
        u32x4 zc[NU], zp[NU]; int tokv[NU], chv[NU]; bool okv[NU];
#pragma unroll
        for (int k = 0; k < NU; ++k) { const int idx = base + k * nlanes; okv[k] = idx < M * 80; const int id2 = okv[k] ? idx : base; tokv[k] = id2 / 80; chv[k] = id2 % 80;
            const int col = chv[k] < 48 ? 768 + 8 * chv[k] : 1152 + 8 * (chv[k] - 48);
            zc[k] = *(const u32x4*)(z + (size_t)tokv[k] * ZP + col);
            zp[k] = (u32x4){0u, 0u, 0u, 0u}; if ((tokv[k] % T) > 0) zp[k] = *(const u32x4*)(z + (size_t)(tokv[k] - 1) * ZP + col); }
#pragma unroll
        for (int k = 0; k < NU; ++k) { const int tok = tokv[k], ch = chv[k];
            const int col = ch < 48 ? 768 + 8 * ch : 1152 + 8 * (ch - 48);
            const f32x4 m0 = *(const f32x4*)(mu + col), m1 = *(const f32x4*)(mu + col + 4);
            float s[8];
            { const float c0 = lo16(zc[k].x), c1 = hi16(zc[k].x), c2 = lo16(zc[k].y), c3 = hi16(zc[k].y), c4 = lo16(zc[k].z), c5 = hi16(zc[k].z), c6 = lo16(zc[k].w), c7 = hi16(zc[k].w);
              s[0] = c0 + (lo16(zp[k].x) - c0) * m0.x; s[1] = c1 + (hi16(zp[k].x) - c1) * m0.y; s[2] = c2 + (lo16(zp[k].y) - c2) * m0.z; s[3] = c3 + (hi16(zp[k].y) - c3) * m0.w;
              s[4] = c4 + (lo16(zp[k].z) - c4) * m1.x; s[5] = c5 + (hi16(zp[k].z) - c5) * m1.y; s[6] = c6 + (lo16(zp[k].w) - c6) * m1.z; s[7] = c7 + (hi16(zp[k].w) - c7) * m1.w; }
            bf16_t* dst;
            if (ch < 48) { dst = (l == 0) ? vfirst + (size_t)tok * 384 + 8 * ch : lin + (size_t)tok * Kl + 256 + 8 * ch; }
            else { const int c2 = 8 * (ch - 48); dst = lin + (size_t)tok * Kl + c2;
                if (c2 < 64) {
#pragma unroll
                    for (int e = 0; e < 8; ++e) s[e] = 1.0f - 2.0f * __builtin_amdgcn_rcpf(__expf(2.0f * s[e]) + 1.0f);
                } else if (c2 >= 128) {
#pragma unroll
                    for (int e = 0; e < 8; ++e) s[e] = sigmoidf_(s[e]);
                } }
            u32x4 o; o.x = pk2(s[0], s[1]); o.y = pk2(s[2], s[3]); o.z = pk2(s[4], s[5]); o.w = pk2(s[6], s[7]);
            if (okv[k]) *(u32x4*)dst = o;
        }
    }
    {
        float* ktmax = (float*)(p.ws + 512 * 1024);
        for (int item = gw; item < 96 * 32; item += ngw) { const int bh = item >> 5, tile = item & 31, b = bh / 6, h = bh % 6;
            const bf16_t* kp = z + ((size_t)b * T + tile * 64 + lane) * ZP + 1792 + h * 64; float ss = 0.f;
#pragma unroll
            for (int c8 = 0; c8 < 8; ++c8) { const u32x4 w = *(const u32x4*)(kp + 8 * c8); const float a0 = lo16(w.x), a1 = hi16(w.x), a2 = lo16(w.y), a3 = hi16(w.y), a4 = lo16(w.z), a5 = hi16(w.z), a6 = lo16(w.w), a7 = hi16(w.w);
                ss += (a0 * a0 + a1 * a1) + (a2 * a2 + a3 * a3) + (a4 * a4 + a5 * a5) + (a6 * a6 + a7 * a7); }
#pragma unroll
            for (int o = 1; o < 64; o <<= 1) ss = fmaxf(ss, __shfl_xor(ss, o));
            if (lane == 0) ktmax[item] = sqrtf(ss); }
    }
    if (gw < 96) {
        const int b = gw / 6, h = gw % 6; const float* fl = (const float*)(p.ws + WS_FL); float* cb = (float*)(p.ws + WS_CBUF) + (size_t)gw * T;
        const float fb = p.in[19][l * 6 + h]; float carry = 0.f;
        for (int i0 = 0; i0 < 32; i0 += 8) {
            float fv[8];
#pragma unroll
            for (int i = 0; i < 8; ++i) fv[i] = fl[(size_t)(b * T + 64 * (i0 + i) + lane) * 8 + h];
#pragma unroll
            for (int i = 0; i < 8; ++i) {
                float v = logsigmoidf_(fv[i] + fb);
#pragma unroll
                for (int o = 1; o < 64; o <<= 1) { const float u = __shfl_up(v, o); if (lane >= o) v += u; }
                v += carry; cb[64 * (i0 + i) + lane] = v * LOG2E; carry = __shfl(v, 63);
            }
        }
    }
}

typedef float f32x2 __attribute__((ext_vector_type(2)));
__device__ __forceinline__ void rwkv_prep2(const Params& p, int l, int gw, int ngw, int lane, unsigned char* ldsb, int wave) {
    const bf16_t* z = (const bf16_t*)(p.ws + WS_R1); bf16_t* lo = (bf16_t*)(p.ws + WS_R2); const bf16_t* vfirst = (const bf16_t*)(p.ws + WS_VFIRST);
    bf16_t* rk = (bf16_t*)p.out; bf16_t* vfin = (bf16_t*)(p.ws + WS_VFIN); float* gend = (float*)(p.ws + WS_GEND); float* scal = (float*)(p.ws + WS_SCAL);
    const int Nl = l ? 1536 : 1280;
    for (int item = gw; item < NB * 256 * 6; item += ngw) {
        const int h = item % 6, bw = item / 6, b = bw >> 8, win = bw & 255; const int hj = h * 64 + lane; const int item2 = bw * 6 + h;
        const float mu_r = p.in[5][l * A_COLS + hj], mu_k = p.in[5][l * A_COLS + 384 + hj], mu_v = p.in[5][l * A_COLS + 768 + hj];
        const float w0 = p.in[6][l * 384 + hj], a0 = p.in[8][l * 384 + hj], k_k = p.in[11][l * 384 + hj], k_a = p.in[12][l * 384 + hj], r_k = p.in[13][l * 384 + hj];
        const float vbias = l ? p.in[16][hj] : 0.f;
        const size_t tok0 = (size_t)b * T + 8 * win;
        float pr = 0.f, pk = 0.f, pv = 0.f;
        if (win > 0) { const bf16_t* zq = z + (tok0 - 1) * ZP; pr = bf2f(zq[hj]); pk = bf2f(zq[384 + hj]); pv = bf2f(zq[768 + hj]); }
        float zr[8], zk[8], zv[8], wl[8], al[8], vl[8], vf[8];
#pragma unroll
        for (int i = 0; i < 8; ++i) { const size_t tok = tok0 + i; const bf16_t* zp_ = z + tok * ZP; const bf16_t* lor = lo + tok * Nl;
            zr[i] = bf2f(zp_[hj]); zk[i] = bf2f(zp_[384 + hj]); zv[i] = bf2f(zp_[768 + hj]); wl[i] = bf2f(lor[hj]); al[i] = bf2f(lor[384 + hj]);
            vl[i] = 0.f; vf[i] = 0.f; if (l) { vl[i] = bf2f(lor[1152 + hj]); vf[i] = bf2f(vfirst[tok * 384 + hj]); } }
        float G = 1.0f; float at[8], rt[8], bhv[8], khv[8];
#pragma unroll
        for (int i = 0; i < 8; ++i) { const size_t tok = tok0 + i;
            const float r = zr[i] + (pr - zr[i]) * mu_r, k = zk[i] + (pk - zk[i]) * mu_k; float v = zv[i] + (pv - zv[i]) * mu_v;
            pr = zr[i]; pk = zk[i]; pv = zv[i];
            if (l) v = v + (vf[i] - v) * sigmoidf_(vbias + vl[i]);
            const float xw = w0 + wl[i];
            const float wlog = -(fmaxf(-xw, 0.f) + __logf(1.0f + __expf(-fabsf(xw)))) - 0.5f;
            const float dec = __expf(-__expf(wlog));
            const float a = sigmoidf_(a0 + al[i]);
            float kk = k * k_k; const float n2 = wave_sum(kk * kk); kk *= rsqrtf(fmaxf(n2, 1e-24f));
            const float k2 = k * (1.0f + (a - 1.0f) * k_a);
            const float bvv = kk * a;
            const float bon = wave_sum(r * k2 * r_k);
            const float Gp = G; G = Gp * dec; const float iG = __builtin_amdgcn_rcpf(G);
            const unsigned bb = f2bf(bvv * iG), kb = f2bf(k2 * iG);
            at[i] = -kk * Gp; rt[i] = r * G; bhv[i] = __uint_as_float(bb << 16); khv[i] = __uint_as_float(kb << 16);
            lo[tok * Nl + 384 + hj] = (bf16_t)bb; rk[tok * 768 + 384 + hj] = (bf16_t)kb;
            vfin[tok * 384 + hj] = (bf16_t)f2bf(v);
            if (lane == 0) *(f32x4*)(scal + (tok * 6 + h) * 4) = (f32x4){0.f, 0.f, bon, 0.f};
        }
        gend[(tok0 >> 3) * 384 + hj] = G;
        float Tm[8][8], N1m[8][8], atp[8];
#pragma unroll
        for (int j = 0; j < 8; ++j)
#pragma unroll
            for (int m = 0; m < 8; ++m) { Tm[j][m] = 0.f; N1m[j][m] = 0.f; }
        float* nimg = (float*)((unsigned char*)p.out + 80 * MiB) + (size_t)item2 * 128;
        float* Pm = (float*)(ldsb + wave * 16384); float* Qm = Pm + 1024; float* GT = Qm + 1024;
#pragma unroll
        for (int m = 0; m < 8; ++m) { Pm[m * 64 + lane] = bhv[m]; Pm[(8 + m) * 64 + lane] = khv[m]; Qm[m * 64 + lane] = at[m]; Qm[(8 + m) * 64 + lane] = rt[m]; }
        { const int n16 = lane & 15, q = lane >> 4; f32x4 Dg = (f32x4){0.f, 0.f, 0.f, 0.f};
#pragma unroll
          for (int jt = 0; jt < 4; ++jt) { const f32x4 pa = *(const f32x4*)(Pm + n16 * 64 + 16 * jt + 4 * q), qb = *(const f32x4*)(Qm + n16 * 64 + 16 * jt + 4 * q);
              Dg = __builtin_amdgcn_mfma_f32_16x16x4f32(pa.x, qb.x, Dg, 0, 0, 0); Dg = __builtin_amdgcn_mfma_f32_16x16x4f32(pa.y, qb.y, Dg, 0, 0, 0);
              Dg = __builtin_amdgcn_mfma_f32_16x16x4f32(pa.z, qb.z, Dg, 0, 0, 0); Dg = __builtin_amdgcn_mfma_f32_16x16x4f32(pa.w, qb.w, Dg, 0, 0, 0); }
          *(f32x4*)(GT + n16 * 16 + 4 * q) = Dg; }
#pragma unroll
        for (int s = 0; s < 8; ++s) {
            float mab[8], mka[8], mbr[8], mkr[8];
#pragma unroll
            for (int j = 0; j < 8; ++j) { mab[j] = GT[s * 16 + j]; mka[j] = GT[s * 16 + 8 + j]; mbr[j] = GT[(8 + s) * 16 + j]; mkr[j] = GT[(8 + s) * 16 + 8 + j]; }
#pragma unroll
            for (int j = 0; j < 8; ++j) if (j <= s) { float t = (j == s) ? 1.0f : 0.f;
#pragma unroll
                for (int m = 0; m < 8; ++m) if (m >= j && m < s) t += Tm[j][m] * mab[m];
                Tm[j][s] = t; }
            float ap = 0.f;
#pragma unroll
            for (int m = 0; m < 8; ++m) if (m <= s) ap += at[m] * Tm[m][s];
            atp[s] = ap;
#pragma unroll
            for (int j = 0; j < 8; ++j) if (j < s) { float n = mka[j];
#pragma unroll
                for (int m = 0; m < 8; ++m) if (m > j && m < s) n += N1m[j][m] * mab[m];
                N1m[j][s] = n; }
            float rp = rt[s];
#pragma unroll
            for (int m = 0; m < 8; ++m) if (m <= s) rp += atp[m] * mbr[m];
            float n2c[8];
#pragma unroll
            for (int j = 0; j < 8; ++j) { float n = 0.f; if (j <= s) { n = mkr[j];
#pragma unroll
                    for (int m = 0; m < 8; ++m) if (m > j && m <= s) n += N1m[j][m] * mbr[m]; }
                n2c[j] = n; }
            const size_t tok = tok0 + s;
            lo[tok * Nl + hj] = (bf16_t)f2bf(ap); rk[tok * 768 + hj] = (bf16_t)f2bf(rp);
            if (lane == 0) { *(f32x4*)(nimg + s * 8) = (f32x4){N1m[0][s], N1m[1][s], N1m[2][s], N1m[3][s]}; *(f32x4*)(nimg + s * 8 + 4) = (f32x4){N1m[4][s], N1m[5][s], N1m[6][s], N1m[7][s]};
                             *(f32x4*)(nimg + 64 + s * 8) = (f32x4){n2c[0], n2c[1], n2c[2], n2c[3]}; *(f32x4*)(nimg + 64 + s * 8 + 4) = (f32x4){n2c[4], n2c[5], n2c[6], n2c[7]}; }
        }
    }
}

#define DPP_ADD(x, ctrl) ((x) + __int_as_float(__builtin_amdgcn_update_dpp(0, __float_as_int(x), (ctrl), 0xF, 0xF, true)))
__device__ __forceinline__ float red8(float x) { x = DPP_ADD(x, 0xB1); x = DPP_ADD(x, 0x4E); x = DPP_ADD(x, 0x141); return x; }
__device__ __forceinline__ f32x2 fma2(f32x2 a, f32x2 b, f32x2 c) { return __builtin_elementwise_fma(a, b, c); }
#define SCAN_BAR() asm volatile("s_waitcnt vmcnt(0) lgkmcnt(0)\n\ts_barrier" ::: "memory")
#define SCAN_BAR_L() asm volatile("s_waitcnt lgkmcnt(0)\n\ts_barrier" ::: "memory")

__device__ __forceinline__ void scan_unit(const Params& p, int l, int bh, unsigned char* ldsb, int tid, int lane, int wave, bool store) {
    const int b = bh / 6, h = bh % 6;
    constexpr int BUFSZ = 6 * 2048 + 128 + 256 + 512;
    float* base = (float*)ldsb; float* Ybase = base + 2 * BUFSZ;
    if (wave < 4) {
        const int n16 = lane & 15, q = lane >> 4; const int irow = 16 * wave + n16;
        f32x4 Z0 = (f32x4){0.f, 0.f, 0.f, 0.f}, Z1 = Z0, Z2 = Z0, Z3 = Z0;
        SCAN_BAR();
        for (int c = 0; c < T / 32; ++c) {
            const float* buf = base + (c & 1) * BUFSZ; float* Y = Ybase + (c & 1) * 2048;
            const float* AT = buf; const float* RT = buf + 2048; const float* BH = buf + 4096; const float* KH = buf + 6144; const float* Vv = buf + 8192; const float* GE = buf + 12416; const float* NI = buf + 12672;
#define MF4(a_, b_, c_) __builtin_amdgcn_mfma_f32_16x16x4f32((a_), (b_), (c_), 0, 0, 0)
#pragma unroll 1
            for (int w8 = 0; w8 < 4; ++w8) {
                const int tt0 = 8 * w8;
                const float* xrow = (n16 < 8 ? AT + (tt0 + n16) * 64 : RT + (tt0 + n16 - 8) * 64) + 4 * q;
                const f32x4 x0 = *(const f32x4*)(xrow), x1 = *(const f32x4*)(xrow + 16), x2 = *(const f32x4*)(xrow + 32), x3 = *(const f32x4*)(xrow + 48);
                const float na = NI[w8 * 128 + n16 * 8 + q], nb = NI[w8 * 128 + n16 * 8 + 4 + q];
                const float va = Vv[(tt0 + q) * 64 + irow], vb = Vv[(tt0 + 4 + q) * 64 + irow];
                f32x4 D1 = (f32x4){0.f, 0.f, 0.f, 0.f};
                D1 = MF4(x0.x, Z0.x, D1); D1 = MF4(x0.y, Z0.y, D1); D1 = MF4(x0.z, Z0.z, D1); D1 = MF4(x0.w, Z0.w, D1);
                D1 = MF4(x1.x, Z1.x, D1); D1 = MF4(x1.y, Z1.y, D1); D1 = MF4(x1.z, Z1.z, D1); D1 = MF4(x1.w, Z1.w, D1);
                D1 = MF4(x2.x, Z2.x, D1); D1 = MF4(x2.y, Z2.y, D1); D1 = MF4(x2.z, Z2.z, D1); D1 = MF4(x2.w, Z2.w, D1);
                D1 = MF4(x3.x, Z3.x, D1); D1 = MF4(x3.y, Z3.y, D1); D1 = MF4(x3.z, Z3.z, D1); D1 = MF4(x3.w, Z3.w, D1);
                D1 = MF4(na, va, D1); D1 = MF4(nb, vb, D1);
                const int sq = tt0 + 4 * (q & 1);
                const float* vsel = Vv + sq * 64 + irow;
                const float v0 = vsel[0], v1 = vsel[64], v2 = vsel[128], v3 = vsel[192];
                if (q >= 2) { float* yp = Y + sq * 64 + irow; yp[0] = D1.x; yp[64] = D1.y; yp[128] = D1.z; yp[192] = D1.w; }
                const float b0 = q < 2 ? D1.x : v0, b1 = q < 2 ? D1.y : v1, b2 = q < 2 ? D1.z : v2, b3 = q < 2 ? D1.w : v3;
                const float* arow = (q < 2 ? BH : KH) + sq * 64 + n16;
                Z0 = MF4(arow[0], b0, Z0);  Z0 = MF4(arow[64], b1, Z0);  Z0 = MF4(arow[128], b2, Z0);  Z0 = MF4(arow[192], b3, Z0);
                Z1 = MF4(arow[16], b0, Z1); Z1 = MF4(arow[80], b1, Z1);  Z1 = MF4(arow[144], b2, Z1);  Z1 = MF4(arow[208], b3, Z1);
                Z2 = MF4(arow[32], b0, Z2); Z2 = MF4(arow[96], b1, Z2);  Z2 = MF4(arow[160], b2, Z2);  Z2 = MF4(arow[224], b3, Z2);
                Z3 = MF4(arow[48], b0, Z3); Z3 = MF4(arow[112], b1, Z3); Z3 = MF4(arow[176], b2, Z3);  Z3 = MF4(arow[240], b3, Z3);
                const float* gp = GE + w8 * 64 + 4 * q;
                Z0 *= *(const f32x4*)(gp); Z1 *= *(const f32x4*)(gp + 16); Z2 *= *(const f32x4*)(gp + 32); Z3 *= *(const f32x4*)(gp + 48);
            }
#undef MF4
            SCAN_BAR();
        }
    } else {
        bf16_t* z = (bf16_t*)(p.ws + WS_R1); const bf16_t* lo = (const bf16_t*)(p.ws + WS_R2); const bf16_t* rk = (const bf16_t*)p.out;
        const bf16_t* vfin = (const bf16_t*)(p.ws + WS_VFIN); const float* gend = (const float*)(p.ws + WS_GEND); const float* scal = (const float*)(p.ws + WS_SCAL);
        const int Nl = l ? 1536 : 1280; const int pw = wave - 4; const int hj = h * 64 + lane;
        const float gn_g = p.in[14][l * 384 + hj], gn_b = p.in[15][l * 384 + hj];
        const int li = lane >> 3, lc = 8 * (lane & 7);
        u32x4 rAT, rBH, rGL, rRT, rKH, rV; float rGE = 0.f; f32x4 rSC = (f32x4){0.f, 0.f, 0.f, 0.f}; f32x2 rNI = (f32x2){0.f, 0.f};
        const float* nimg = (const float*)((const unsigned char*)p.out + 80 * MiB);
#define SCAN_LOAD(c_) do { const int cc = (c_); const size_t tok = (size_t)b * T + 32 * cc + 8 * pw + li; \
            rAT = *(const u32x4*)(lo + tok * Nl + h * 64 + lc); rBH = *(const u32x4*)(lo + tok * Nl + 384 + h * 64 + lc); rGL = *(const u32x4*)(lo + tok * Nl + 768 + h * 64 + lc); \
            rRT = *(const u32x4*)(rk + tok * 768 + h * 64 + lc); rKH = *(const u32x4*)(rk + tok * 768 + 384 + h * 64 + lc); rV = *(const u32x4*)(vfin + tok * 384 + h * 64 + lc); \
            rGE = gend[(((size_t)b * T + 32 * cc + 8 * pw) >> 3) * 384 + hj]; rNI = *(const f32x2*)(nimg + ((((size_t)b * T + 32 * cc + 8 * pw) >> 3) * 6 + h) * 128 + 2 * lane); \
            if (lane < 8) rSC = *(const f32x4*)(scal + (((size_t)b * T + 32 * cc + 8 * pw + lane) * 6 + h) * 4); } while (0)
#define SCAN_ST1(arr_, reg_) do { float* d_ = buf + (arr_) + (8 * pw + li) * 64 + lc; \
            *(f32x4*)d_ = (f32x4){lo16(reg_.x), hi16(reg_.x), lo16(reg_.y), hi16(reg_.y)}; *(f32x4*)(d_ + 4) = (f32x4){lo16(reg_.z), hi16(reg_.z), lo16(reg_.w), hi16(reg_.w)}; } while (0)
#define SCAN_STORE(c_) do { const int cc = (c_); float* buf = base + (cc & 1) * BUFSZ; \
            SCAN_ST1(0, rAT); SCAN_ST1(2048, rRT); SCAN_ST1(4096, rBH); SCAN_ST1(6144, rKH); SCAN_ST1(8192, rV); SCAN_ST1(10240, rGL); \
            buf[12416 + pw * 64 + lane] = rGE; *(f32x2*)(buf + 12672 + pw * 128 + 2 * lane) = rNI; if (lane < 8) *(f32x4*)(buf + 12288 + (8 * pw + lane) * 4) = rSC; } while (0)
#define SCAN_POST(c_) do { const int cc = (c_); const float* buf = base + (cc & 1) * BUFSZ; const float* Y = Ybase + (cc & 1) * 2048; \
            _Pragma("unroll") for (int i = 0; i < 8; ++i) { const int tt = 8 * pw + i; const int o = tt * 64 + lane; const float y = Y[o]; \
                const float mean = wave_sum(y) * (1.0f / 64.0f); const float d = y - mean; const float var = wave_sum(d * d) * (1.0f / 64.0f); \
                const float yn = d * rsqrtf(var + GN_EPS) * gn_g + gn_b; \
                const float outv = (yn + buf[12288 + tt * 4 + 2] * buf[8192 + o]) * buf[10240 + o]; \
                if (store) z[((size_t)b * T + 32 * cc + tt) * ZP + hj] = (bf16_t)f2bf(outv); } } while (0)
        SCAN_LOAD(0);
        SCAN_STORE(0);
        SCAN_LOAD(1);
        SCAN_BAR_L();
        for (int c = 0; c < T / 32; ++c) {
            if (c > 0) SCAN_POST(c - 1);
            if (c + 1 < T / 32) SCAN_STORE(c + 1);
            if (c + 2 < T / 32) SCAN_LOAD(c + 2);
            SCAN_BAR_L();
        }
        SCAN_POST(T / 32 - 1);
#undef SCAN_LOAD
#undef SCAN_ST1
#undef SCAN_STORE
#undef SCAN_POST
    }
    __syncthreads();
}

template <int HD, int MODE>
__device__ __forceinline__ void attn_unit(unsigned char* ldsb, const bf16_t* Qg, int qpitch, const bf16_t* Kg, const bf16_t* Vg, int kvpitch, bf16_t* Og, int q0, int nkeys, const float* cseq, float scale,
                                          int tid, int lane, int wave, bool store) {
    constexpr int KP = (HD + 8) * 2;
    constexpr int VP = 72 * 2;
    constexpr int NCH = HD / 64;
    constexpr int NKB = HD / 32, NDT = HD / 16;
    unsigned char* Ks = ldsb; unsigned char* Vts = ldsb + 64 * KP; float* cs = (float*)(Vts + HD * VP);
    const int r16 = lane & 15, fq = lane >> 4;
    const int qrow = q0 + 16 * wave + r16;
    bf16x8 qf[NKB];
#pragma unroll
    for (int kb = 0; kb < NKB; ++kb) qf[kb] = *(const bf16x8*)(Qg + (size_t)qrow * qpitch + 32 * kb + 8 * fq);
    f32x4 o[NDT];
#pragma unroll
    for (int dt = 0; dt < NDT; ++dt) o[dt] = (f32x4){0.f, 0.f, 0.f, 0.f};
    float m_run = -INFINITY, l_part = 0.f, Rtot = 0.f;
    float cq = 0.f; if (MODE == 0) cq = cseq[qrow];
    const int ntiles = (MODE == 2) ? nkeys / 64 : (q0 + 128) / 64;
    u32x4 kreg[NCH], vreg[NCH]; float creg = 0.f;
#define ATT_ISSUE(tt_) do { const int k0_ = (tt_) * 64; \
        _Pragma("unroll") for (int it = 0; it < NCH; ++it) { const int ci = tid + 512 * it; const int row = ci / (HD / 8), ch = ci % (HD / 8); \
            kreg[it] = *(const u32x4*)(Kg + (size_t)(k0_ + row) * kvpitch + 8 * ch); \
            vreg[it] = *(const u32x4*)(Vg + (size_t)((tid >> 3) + 64 * it) * 256 + k0_ + 8 * (tid & 7)); } \
        if (MODE == 0 && tid < 64) creg = cseq[k0_ + tid]; } while (0)
    int t = (MODE == 1) ? ntiles - 1 : 0;
    ATT_ISSUE(t);
    for (int it_ = 0; it_ < ntiles; ++it_) {
        BAR_LGKM();
#pragma unroll
        for (int it = 0; it < NCH; ++it) { const int ci = tid + 512 * it; const int row = ci / (HD / 8), ch = ci % (HD / 8);
            *(u32x4*)(Ks + row * KP + ch * 16) = kreg[it];
            unsigned char* vp_ = Vts + ((tid >> 3) + 64 * it) * VP + (32 * ((tid & 7) >> 2) + 16 * (tid & 1) + 4 * ((tid >> 1) & 1)) * 2; const u32x4 v = vreg[it];
            *(u32x2*)vp_ = (u32x2){v.x, v.y}; *(u32x2*)(vp_ + 16) = (u32x2){v.z, v.w}; }
        if (MODE == 0 && tid < 64) cs[tid] = creg;
        BAR_LGKM();
        const int k0 = t * 64;
        const int tn = (MODE == 1) ? t - 1 : t + 1;
        if (it_ + 1 < ntiles) ATT_ISSUE(tn);
        f32x4 s[4];
#pragma unroll
        for (int j = 0; j < 4; ++j) { s[j] = (f32x4){0.f, 0.f, 0.f, 0.f};
#pragma unroll
            for (int kb = 0; kb < NKB; ++kb) { const bf16x8 a = *(const bf16x8*)(Ks + (16 * j + r16) * KP + (32 * kb + 8 * fq) * 2); s[j] = __builtin_amdgcn_mfma_f32_16x16x32_bf16(a, qf[kb], s[j], 0, 0, 0); } }
        if (MODE == 0 || MODE == 2) {
            float tmax = -INFINITY;
#pragma unroll
            for (int j = 0; j < 4; ++j) {
                f32x4 ck = (f32x4){0.f, 0.f, 0.f, 0.f}; if (MODE == 0) ck = *(const f32x4*)(cs + 16 * j + 4 * fq);
#pragma unroll
                for (int i = 0; i < 4; ++i) { float v = s[j][i] * scale; if (MODE == 0) { v += (cq - ck[i]) * LOG2E; if (k0 + 16 * j + 4 * fq + i > qrow) v = -INFINITY; } s[j][i] = v; tmax = fmaxf(tmax, v); } }
            tmax = fmaxf(tmax, __shfl_xor(tmax, 16)); tmax = fmaxf(tmax, __shfl_xor(tmax, 32));
            const float mnew = fmaxf(m_run, tmax); const float alpha = __builtin_amdgcn_exp2f(m_run - mnew); m_run = mnew;
            float ps = 0.f;
#pragma unroll
            for (int j = 0; j < 4; ++j)
#pragma unroll
                for (int i = 0; i < 4; ++i) { const float pv = __builtin_amdgcn_exp2f(s[j][i] - mnew); s[j][i] = pv; ps += pv; }
            l_part = l_part * alpha + ps;
#pragma unroll
            for (int dt = 0; dt < NDT; ++dt) o[dt] = o[dt] * alpha;
        } else {
            float lr[4][4], ls[4][4], g[4];
#pragma unroll
            for (int j = 0; j < 4; ++j) { g[j] = 0.f;
#pragma unroll
                for (int i = 0; i < 4; ++i) { const float lg = s[j][i] * scale; const float lsg = logsigmoidf_(lg); const bool valid = (k0 + 16 * j + 4 * fq + i) < qrow;
                    ls[j][i] = lsg; lr[j][i] = valid ? lsg - lg : 0.f; g[j] += lr[j][i]; } }
            float suffix = Rtot;
#pragma unroll
            for (int j = 3; j >= 0; --j) {
                const float ga = g[j], gb = __shfl_xor(ga, 16), gc = __shfl_xor(ga, 32), gd = __shfl_xor(ga, 48);
                const float within = (fq == 0) ? (gb + gc + gd) : (fq == 1) ? (gc + gd) : (fq == 2) ? gb : 0.f;
                float run = suffix + within;
#pragma unroll
                for (int i = 3; i >= 0; --i) { const bool valid = (k0 + 16 * j + 4 * fq + i) < qrow; s[j][i] = valid ? __expf(ls[j][i] + run) : 0.f; run += lr[j][i]; }
                suffix += (ga + gb) + (gc + gd);
            }
            Rtot = suffix;
        }
        bf16x8 pf[2];
#pragma unroll
        for (int kvb = 0; kvb < 2; ++kvb) { u32x4 w; w.x = pk2(s[2 * kvb][0], s[2 * kvb][1]); w.y = pk2(s[2 * kvb][2], s[2 * kvb][3]); w.z = pk2(s[2 * kvb + 1][0], s[2 * kvb + 1][1]); w.w = pk2(s[2 * kvb + 1][2], s[2 * kvb + 1][3]);
            pf[kvb] = __builtin_bit_cast(bf16x8, w); }
#pragma unroll
        for (int dt = 0; dt < NDT; ++dt)
#pragma unroll
            for (int kvb = 0; kvb < 2; ++kvb) { const bf16x8 a = *(const bf16x8*)(Vts + (16 * dt + r16) * VP + (32 * kvb + 8 * fq) * 2); o[dt] = __builtin_amdgcn_mfma_f32_16x16x32_bf16(a, pf[kvb], o[dt], 0, 0, 0); }
        if (MODE == 1) { if (__syncthreads_and(Rtot < -105.0f)) break; }
        t = tn;
    }
    float inv = 1.0f;
    if (MODE != 1) { float lt = l_part; lt += __shfl_xor(lt, 16); lt += __shfl_xor(lt, 32); inv = 1.0f / lt; }
#pragma unroll
    for (int dt = 0; dt < NDT; ++dt) { const f32x4 v = o[dt] * inv; u32x2 w; w.x = pk2(v.x, v.y); w.y = pk2(v.z, v.w);
        if (store) *(u32x2*)(Og + (size_t)qrow * qpitch + 16 * dt + 4 * fq) = w; }
    __syncthreads();
#undef ATT_ISSUE
}

typedef float f32x16 __attribute__((ext_vector_type(16)));
__device__ __forceinline__ int crow_(int r, int hi) { return (r & 3) + 8 * (r >> 2) + 4 * hi; }
template <int MODE>
__device__ __forceinline__ void attn64_unit(unsigned char* ldsb, const bf16_t* Qg, const bf16_t* Kg, const bf16_t* Vg, int pitch, bf16_t* Og, int q0, const float* cseq, float scale,
                                            int tid, int lane, int wave, bool store, const float* ktmax = nullptr) {
    constexpr int KP = 144, VP = 144, BUF = 64 * KP + 64 * VP + 256;
    const int r32 = lane & 31, hi = lane >> 5;
    const int qrow = q0 + 32 * wave + r32;
    bf16x8 qf[4];
#pragma unroll
    for (int ks = 0; ks < 4; ++ks) qf[ks] = *(const bf16x8*)(Qg + (size_t)qrow * pitch + 16 * ks + 8 * hi);
    f32x16 o0, o1;
#pragma unroll
    for (int r = 0; r < 16; ++r) { o0[r] = 0.f; o1[r] = 0.f; }
    float m_run = -INFINITY, l_part = 0.f, Rtot = 0.f;
    float cq = 0.f; if (MODE == 0) cq = cseq[qrow];
    float qs = 0.f;
    float* pmx = (float*)(ldsb + 2 * BUF);
    if (MODE == 0) {
        float ss = 0.f;
#pragma unroll
        for (int ks = 0; ks < 4; ++ks)
#pragma unroll
            for (int e = 0; e < 8; ++e) { const float v = __uint_as_float((unsigned)(unsigned short)qf[ks][e] << 16); ss += v * v; }
        ss += __shfl_xor(ss, 32); qs = sqrtf(ss) * scale * 1.01f;
        if (tid < 64) { float v = tid < 32 ? ktmax[tid] : 0.f;
#pragma unroll
            for (int o = 1; o < 32; o <<= 1) { const float u = __shfl_up(v, o); if ((tid & 31) >= o) v = fmaxf(v, u); }
            if (tid < 32) { pmx[tid] = v * 1.01f; pmx[64 + tid] = tid ? cseq[64 * tid - 1] : 0.f; } }
    }
    const int ntiles = (q0 + 256) / 64;
    const int qlo = q0 + 32 * wave;
    u32x4 kregA = (u32x4){0u, 0u, 0u, 0u}, vregA = kregA, kregB = kregA, vregB = kregA; float cregA = 0.f, cregB = 0.f;
    const int krow = tid >> 3, kch = tid & 7, vrow = tid & 63, vch = tid >> 6;
    const int vperm = (vrow & 0x33) | ((vrow & 4) << 1) | ((vrow & 8) >> 1);
#define A64_ISSUE(S, tt_) do { const int k0_ = (tt_) * 64; \
        kreg##S = *(const u32x4*)(Kg + (size_t)(k0_ + krow) * pitch + 8 * kch); vreg##S = *(const u32x4*)(Vg + (size_t)(k0_ + vrow) * pitch + 8 * vch); \
        if (MODE == 0 && tid < 64) creg##S = cseq[k0_ + tid]; } while (0)
#define A64_STORE(S, b_) do { unsigned char* B_ = ldsb + (b_) * BUF; *(u32x4*)(B_ + krow * KP + kch * 16) = kreg##S; \
        bf16_t* vd = (bf16_t*)(B_ + 64 * KP + (8 * vch) * VP + vperm * 2); const u32x4 v = vreg##S; \
        vd[0 * 72] = (bf16_t)(v.x & 0xffffu); vd[1 * 72] = (bf16_t)(v.x >> 16); vd[2 * 72] = (bf16_t)(v.y & 0xffffu); vd[3 * 72] = (bf16_t)(v.y >> 16); \
        vd[4 * 72] = (bf16_t)(v.z & 0xffffu); vd[5 * 72] = (bf16_t)(v.z >> 16); vd[6 * 72] = (bf16_t)(v.w & 0xffffu); vd[7 * 72] = (bf16_t)(v.w >> 16); \
        if (MODE == 0 && tid < 64) ((float*)(B_ + 64 * KP + 64 * VP))[tid] = creg##S; } while (0)
    int t = ntiles - 1;
    const int dt_ = -1;
    A64_ISSUE(A, t);
    A64_ISSUE(B, t + dt_);
    A64_STORE(A, 0);
    A64_ISSUE(A, t + 2 * dt_);
    int* vt = (int*)(ldsb + 2 * BUF + 512);
    BAR_LGKM();
    bool leave = false;
    for (int it0 = 0; it0 < ntiles && !leave; it0 += 2) {
#pragma unroll
    for (int half = 0; half < 2; ++half) { const int it_ = it0 + half;
        const unsigned char* Bc = ldsb + half * BUF; const unsigned char* Ks = Bc; const unsigned char* Vts = Bc + 64 * KP; const float* cs = (const float*)(Bc + 64 * KP + 64 * VP);
        { const int tn3 = (t - 3 > 0) ? t - 3 : 0;
          if (half) { A64_STORE(A, 0); A64_ISSUE(A, tn3); } else { A64_STORE(B, 1); A64_ISSUE(B, tn3); } }
        const int k0 = t * 64;
        if (k0 <= qlo + 31) {
            f32x16 p0, p1;
#pragma unroll
            for (int r = 0; r < 16; ++r) { p0[r] = 0.f; p1[r] = 0.f; }
#pragma unroll
            for (int ks = 0; ks < 4; ++ks) {
                const bf16x8 a0 = *(const bf16x8*)(Ks + r32 * KP + (16 * ks + 8 * hi) * 2), a1 = *(const bf16x8*)(Ks + (32 + r32) * KP + (16 * ks + 8 * hi) * 2);
                p0 = __builtin_amdgcn_mfma_f32_32x32x16_bf16(a0, qf[ks], p0, 0, 0, 0); p1 = __builtin_amdgcn_mfma_f32_32x32x16_bf16(a1, qf[ks], p1, 0, 0, 0); }
            const bool diag = (k0 + 63 >= qlo);
            bool skip_pv = false;
            if (MODE == 0) {
#pragma unroll
                for (int g = 0; g < 4; ++g) { const f32x4 c0 = *(const f32x4*)(cs + 8 * g + 4 * hi), c1 = *(const f32x4*)(cs + 32 + 8 * g + 4 * hi);
#pragma unroll
                    for (int i = 0; i < 4; ++i) { p0[4 * g + i] = __builtin_fmaf(p0[4 * g + i], scale, cq - c0[i]); p1[4 * g + i] = __builtin_fmaf(p1[4 * g + i], scale, cq - c1[i]); } }
                if (diag) {
#pragma unroll
                    for (int r = 0; r < 16; ++r) { const int kv = k0 + crow_(r, hi); if (kv > qrow) p0[r] = -INFINITY; if (kv + 32 > qrow) p1[r] = -INFINITY; }
                }
                float tmax = fmaxf(p0[0], p1[0]);
#pragma unroll
                for (int r = 1; r < 16; ++r) tmax = fmaxf(tmax, fmaxf(p0[r], p1[r]));
                tmax = fmaxf(tmax, __shfl_xor(tmax, 32));
                skip_pv = __all(tmax < m_run - 40.0f);
                if (!skip_pv) {
                    const float mnew = fmaxf(m_run, tmax); const float mref = (mnew == -INFINITY) ? 0.f : mnew; const float alpha = __builtin_amdgcn_exp2f(m_run - mref); m_run = mnew;
                    float ps = 0.f;
#pragma unroll
                    for (int r = 0; r < 16; ++r) { p0[r] = __builtin_amdgcn_exp2f(p0[r] - mref); p1[r] = __builtin_amdgcn_exp2f(p1[r] - mref); ps += p0[r] + p1[r]; }
                    l_part = l_part * alpha + ps;
                    o0 = o0 * alpha; o1 = o1 * alpha;
                }
            } else {
                float G[8]; f32x16 l0, l1;
#pragma unroll
                for (int r = 0; r < 16; ++r) { l0[r] = p0[r] * scale; l1[r] = p1[r] * scale; p0[r] = logsigmoidf_(l0[r]); p1[r] = logsigmoidf_(l1[r]);
                    const int kv = k0 + crow_(r, hi); l0[r] = (kv < qrow) ? p0[r] - l0[r] : 0.f; l1[r] = (kv + 32 < qrow) ? p1[r] - l1[r] : 0.f; }
#pragma unroll
                for (int g = 0; g < 4; ++g) { G[g] = (l0[4 * g] + l0[4 * g + 1]) + (l0[4 * g + 2] + l0[4 * g + 3]); G[4 + g] = (l1[4 * g] + l1[4 * g + 1]) + (l1[4 * g + 2] + l1[4 * g + 3]); }
                float suffix = Rtot;
#pragma unroll
                for (int th = 1; th >= 0; --th)
#pragma unroll
                    for (int g = 3; g >= 0; --g) { const float mine = G[th * 4 + g]; const float other = __shfl_xor(mine, 32);
                        float run = suffix + (hi == 0 ? other : 0.f);
#pragma unroll
                        for (int i = 3; i >= 0; --i) { const int r = 4 * g + i; const bool valid = (k0 + 32 * th + crow_(r, hi)) < qrow;
                            const float lsg = th ? p1[r] : p0[r]; const float lrr = th ? l1[r] : l0[r];
                            const float att = valid ? __expf(lsg + run) : 0.f; run += lrr; if (th) p1[r] = att; else p0[r] = att; }
                        suffix += mine + other; }
                Rtot = suffix;
            }
            if (!skip_pv) {
            bf16x8 pf[4];
#pragma unroll
            for (int s = 0; s < 4; ++s) { u32x4 w;
                if (s < 2) { const int b8 = 8 * s; w.x = pg8::cvt_pk_bf16(p0[b8], p0[b8 + 1]); w.y = pg8::cvt_pk_bf16(p0[b8 + 2], p0[b8 + 3]); w.z = pg8::cvt_pk_bf16(p0[b8 + 4], p0[b8 + 5]); w.w = pg8::cvt_pk_bf16(p0[b8 + 6], p0[b8 + 7]); }
                else { const int b8 = 8 * (s - 2); w.x = pg8::cvt_pk_bf16(p1[b8], p1[b8 + 1]); w.y = pg8::cvt_pk_bf16(p1[b8 + 2], p1[b8 + 3]); w.z = pg8::cvt_pk_bf16(p1[b8 + 4], p1[b8 + 5]); w.w = pg8::cvt_pk_bf16(p1[b8 + 6], p1[b8 + 7]); }
                pf[s] = __builtin_bit_cast(bf16x8, w); }
#pragma unroll
            for (int s = 0; s < 4; ++s) {
                const bf16x8 v0 = *(const bf16x8*)(Vts + r32 * VP + (16 * s + 8 * hi) * 2), v1 = *(const bf16x8*)(Vts + (32 + r32) * VP + (16 * s + 8 * hi) * 2);
                o0 = __builtin_amdgcn_mfma_f32_32x32x16_bf16(v0, pf[s], o0, 0, 0, 0); o1 = __builtin_amdgcn_mfma_f32_32x32x16_bf16(v1, pf[s], o1, 0, 0, 0); }
            }
        }
        bool done = false;
        if (MODE == 1) done = Rtot < -105.0f;
        else if (t > 0) {
            const float bnd = qs * pmx[t - 1] + (cq - pmx[64 + t]); done = bnd < m_run - 40.0f; }
        { const int wall = __all(done) ? 1 : 0; if (lane == 0) vt[(it_ & 1) * 8 + wave] = wall;
          BAR_LGKM();
          const int* vv = vt + (it_ & 1) * 8; const int all8 = (vv[0] & vv[1]) & (vv[2] & vv[3]) & (vv[4] & vv[5]) & (vv[6] & vv[7]);
          if (all8) { leave = true; break; } }
        t += dt_;
    }
    }
    float inv = 1.0f;
    if (MODE == 0) { float lt = l_part; lt += __shfl_xor(lt, 32); inv = 1.0f / lt; }
#pragma unroll
    for (int g = 0; g < 4; ++g) {
        u32x2 w0, w1; w0.x = pg8::cvt_pk_bf16(o0[4 * g] * inv, o0[4 * g + 1] * inv); w0.y = pg8::cvt_pk_bf16(o0[4 * g + 2] * inv, o0[4 * g + 3] * inv);
        w1.x = pg8::cvt_pk_bf16(o1[4 * g] * inv, o1[4 * g + 1] * inv); w1.y = pg8::cvt_pk_bf16(o1[4 * g + 2] * inv, o1[4 * g + 3] * inv);
        if (store) { *(u32x2*)(Og + (size_t)qrow * pitch + 8 * g + 4 * hi) = w0; *(u32x2*)(Og + (size_t)qrow * pitch + 32 + 8 * g + 4 * hi) = w1; } }
    __syncthreads();
#undef A64_ISSUE
#undef A64_STORE
}

#define GAS __attribute__((address_space(1)))
#define LAS __attribute__((address_space(3)))
#define RLX_AGENT __ATOMIC_RELAXED, __HIP_MEMORY_SCOPE_AGENT
#define XB_TMO      128
#define XB_XCNT(j)  (256  + 64 * (j))
#define XB_XSUB(j)  (1280 + 64 * (j))
#define XB_XGEN(j)  (2304 + 64 * (j))
#define XB_TOP      3328
#define XB_TOPGEN   3392
#define XCD_BAR_WORDS 3456
#define XB_SPIN_CAP (1u << 18)

__device__ __forceinline__ unsigned xb_ld(unsigned* p)              { return __hip_atomic_load(p, __ATOMIC_RELAXED, __HIP_MEMORY_SCOPE_AGENT); }
__device__ __forceinline__ unsigned xb_add(unsigned* p, unsigned v) { return __hip_atomic_fetch_add(p, v, __ATOMIC_RELAXED, __HIP_MEMORY_SCOPE_AGENT); }
__device__ __forceinline__ unsigned xb_xcc_id() { return (unsigned)__builtin_amdgcn_s_getreg((3 << 11) | 20) & 0xFu; }
#define XB_SPIN(cond, bar) do { unsigned _sp = 0; while (cond) { __builtin_amdgcn_s_sleep(1); \
    if ((++_sp & 255u) == 0u) { if (xb_ld(&(bar)[XB_TMO])) break; if (_sp > XB_SPIN_CAP) { atomicAdd(&(bar)[XB_TMO], 1u); break; } } } } while (0)

struct XcdBarrier {
    unsigned* bar; unsigned x;
    volatile LAS unsigned* st;
};

__device__ __forceinline__ XcdBarrier xcd_barrier_post(unsigned* bar, volatile LAS unsigned* st) {
    XcdBarrier b; b.bar = bar; b.x = xb_xcc_id(); b.st = st;
    if (threadIdx.x == 0) (void)xb_add(&bar[XB_XCNT(b.x)], 1u);
    return b;
}
__device__ __forceinline__ void xcd_barrier_complete(unsigned* bar, unsigned x, unsigned& nloc, unsigned& nx) {
    const unsigned G = gridDim.x * gridDim.y * gridDim.z;
    unsigned sum, cnt, mine, sp = 0u;
    for (;;) {
        sum = 0u; cnt = 0u; mine = 0u;
#pragma unroll
        for (unsigned j = 0; j < 16; ++j) { const unsigned c = xb_ld(&bar[XB_XCNT(j)]); sum += c; cnt += (c > 0u) ? 1u : 0u; mine = (j == x) ? c : mine; }
        if (sum == G) break;
        __builtin_amdgcn_s_sleep(1);
        if ((++sp & 255u) == 0u) { if (xb_ld(&bar[XB_TMO])) break; if (sp > XB_SPIN_CAP) { atomicAdd(&bar[XB_TMO], 1u); break; } }
    }
    nloc = mine > 0u ? mine : 1u; nx = cnt > 0u ? cnt : 1u;
}

__device__ __forceinline__ void xcd_barrier(const XcdBarrier& b) {
    asm volatile("s_waitcnt vmcnt(0)" ::: "memory");
    __syncthreads();
    if (threadIdx.x == 0) {
        unsigned* bar = b.bar;
        __builtin_amdgcn_s_waitcnt(0);
        unsigned nloc = b.st[0], nx = b.st[1];
        if (nloc == 0u) { xcd_barrier_complete(bar, b.x, nloc, nx); b.st[0] = nloc; b.st[1] = nx; }
        const unsigned old = xb_add(&bar[XB_XSUB(b.x)], 1u);
        const unsigned gen = old / nloc;
        if (old + 1u == (gen + 1u) * nloc) {
            __builtin_amdgcn_fence(__ATOMIC_RELEASE, "agent");
            asm volatile("s_waitcnt vmcnt(0)" ::: "memory");
            const unsigned og = xb_add(&bar[XB_TOP], 1u);
            const unsigned tg = og / nx;
            if (og + 1u == (tg + 1u) * nx) xb_add(&bar[XB_TOPGEN], 1u);
            else XB_SPIN(xb_ld(&bar[XB_TOPGEN]) == tg, bar);
            __builtin_amdgcn_fence(__ATOMIC_ACQUIRE, "agent");
            xb_add(&bar[XB_XGEN(b.x)], 1u);
            asm volatile("s_waitcnt vmcnt(0)" ::: "memory");
        } else {
            XB_SPIN(xb_ld(&bar[XB_XGEN(b.x)]) == gen, bar);
            __builtin_amdgcn_fence(__ATOMIC_ACQUIRE, "agent");
            asm volatile("s_waitcnt vmcnt(0)" ::: "memory");
        }
    }
    __syncthreads();
}

__global__ void __launch_bounds__(NTHREADS, 2) fwd_megakernel(Params p) {
    extern __shared__ __attribute__((aligned(16))) unsigned char lds[];
    cg::grid_group grid = cg::this_grid();
    __shared__ int s_unit;
    __shared__ unsigned s_bst[2];
    if (threadIdx.x < 2) s_bst[threadIdx.x] = 0u;
    __syncthreads();
    (void)xcd_barrier_post((unsigned*)(p.ws + WS_CTL) + 4096, (volatile LAS unsigned*)s_bst);
#define FRESH() const int tid = fresh_tid(), lane = tid & 63, wave = __builtin_amdgcn_readfirstlane(tid >> 6); const int bx = fresh_s((int)blockIdx.x), G = fresh_s((int)gridDim.x); \
    const int gw = bx * NWAVES + wave, ngw = G * NWAVES; unsigned char* ws = p.ws; PG8_LAS unsigned char* ldsl = (PG8_LAS unsigned char*)lds; \
    bf16_t* R1 = (bf16_t*)(ws + WS_R1); bf16_t* R2 = (bf16_t*)(ws + WS_R2); bf16_t* R3 = (bf16_t*)p.out; bf16_t* XB = (bf16_t*)(ws + WS_R3); bf16_t* MEMN = (bf16_t*)(ws + WS_MEMN); bf16_t* MKV = (bf16_t*)(ws + WS_MKV); float* xres = p.out; \
    (void)tid; (void)lane; (void)wave; (void)gw; (void)ngw; (void)ldsl; (void)R1; (void)R2; (void)R3; (void)XB; (void)MEMN; (void)MKV; (void)xres; (void)bx; (void)G;
#define NOSEG 1 << 30, 0, 1 << 30, 0
#ifdef PROBE_DUP_SYNC
#define GSYNC() do { xcd_barrier(xbar); xcd_barrier(xbar); } while (0)
#else
#define GSYNC() do { XcdBarrier xb_; xb_.bar = (unsigned*)(p.ws + WS_CTL) + 4096; xb_.x = xb_xcc_id(); xb_.st = (volatile LAS unsigned*)s_bst; xcd_barrier(xb_); } while (0)
#endif
#ifdef PROBE_DUP_GEMM
#define GEMM_REP for (int rep_ = 0; rep_ < 2; ++rep_)
#else
#define GEMM_REP
#endif
#ifdef PROBE_DUP_NORM
#define NORM_DRY(...) norm_rows(__VA_ARGS__)
#else
#define NORM_DRY(...)
#endif

    { FRESH();
#ifdef PROBE_DUP_CONV
      convert_weights(p, 0, lds, gw, ngw, lane, wave);
#endif
      convert_weights(p, 0, lds, gw, ngw, lane, wave);
      norm_rows<false, false>(gw, ngw, lane, MEMR, p.in[1], nullptr, nullptr, nullptr, p.in[23], MEMN);
      norm_rows<false, true>(gw, ngw, lane, M, p.in[0], nullptr, nullptr, XB, p.in[2], R3); }
    if (p.pad[1] == 0x5eed) grid.sync();
    GSYNC();

    for (int l = 0; l < 2; ++l) {
        { FRESH(); pg8::Gemm g{R3, (const bf16_t*)(ws + WS_WIN), M, ZP, D, D, NOSEG}; pg8::StaticOrder S; S.init(M, ZP, G, bx);
          pg8::EpiBf16 E{R1, ZP, (float*)(ws + WS_FL), 3328};
          GEMM_REP pg8::gemm_phase<pg8::EpiBf16, pg8::StaticOrder, true, true>(ldsl, g, S, E); }
        { FRESH(); pg8::Gemm g{MEMN, (const bf16_t*)(ws + WS_WKV), MEMR, D, D, D, NOSEG}; pg8::StaticOrder S; S.init(MEMR, D, G, bx);
          pg8::EpiBf16 E{MKV, 2 * D, nullptr, 0};
          GEMM_REP pg8::gemm_phase<pg8::EpiBf16, pg8::StaticOrder, true, true>(ldsl, g, S, E); }
        { FRESH(); pg8::Gemm g{MEMN, (const bf16_t*)(ws + WS_WKV) + (size_t)D * D, MEMR, D, D, D, NOSEG}; pg8::StaticOrder S; S.init(MEMR, D, G, (bx + G - 64) % G);
          pg8::EpiVT E{(bf16_t*)p.out + (size_t)32 * 1024 * 1024};
          GEMM_REP pg8::gemm_phase<pg8::EpiVT, pg8::StaticOrder, true, true>(ldsl, g, S, E); }
        GSYNC();
#ifdef PROBE_DUP_PRE
        { FRESH(); rwkv_pre(p, l, gw, ngw, lane); }
#endif
        { FRESH(); rwkv_pre(p, l, gw, ngw, lane); }
        GSYNC();
        { FRESH(); const int Kl = l ? 640 : 256, Nl = l ? 1536 : 1280;
          pg8::Gemm g{R3, (const bf16_t*)(ws + WS_WLORA), M, Nl, Kl, Kl, NOSEG}; pg8::StaticOrder S; S.init(M, Nl, G, bx);
          pg8::EpiBf16 E{R2, Nl, nullptr, 0};
          GEMM_REP pg8::gemm_phase<pg8::EpiBf16, pg8::StaticOrder, true, true>(ldsl, g, S, E); }
        GSYNC();
#ifdef PROBE_DUP_PREP2
        { FRESH(); rwkv_prep2(p, l, gw, ngw, lane, lds, wave); }
#endif
        { FRESH(); rwkv_prep2(p, l, gw, ngw, lane, lds, wave); }
        GSYNC();
#ifdef PROBE_DUP_SCAN
        { FRESH(); if (bx < 96) scan_unit(p, l, bx, lds, tid, lane, wave, p.pad[0] != 0); }
#endif
        { FRESH(); if (bx < 96) scan_unit(p, l, bx, lds, tid, lane, wave, true); }
#ifdef PROBE_DUP_ATT
        { FRESH(); unsigned* ctl = (unsigned*)(ws + WS_CTL);
        for (;;) {
            if (tid == 0) s_unit = (int)atomicAdd(&ctl[64 * (3 + l)], 1u);
            __syncthreads();
            const int u = s_unit;
            __syncthreads();
            if (u >= 768 + 512) break;
            if (u < 768) { const int qb = 7 - u / 96, bh = u % 96, b = bh / 6, h = bh % 6;
                bf16_t* base = R1 + (size_t)b * T * ZP + 1408 + h * 64;
                attn64_unit<0>(lds, base, base + 384, base + 768, ZP, base, qb * 256, (const float*)(ws + WS_CBUF) + (size_t)bh * T, 0.125f * LOG2E, tid, lane, wave, p.pad[0] != 0, (const float*)(ws + 512 * 1024) + bh * 32);
            } else { const int u2 = u - 768; const int qb = 7 - u2 / 64, bh = u2 % 64, b = bh / 4, h = bh % 4;
                bf16_t* base = R1 + (size_t)b * T * ZP + 2560 + h * 64;
                attn64_unit<1>(lds, base, base + 256, base + 512, ZP, base, qb * 256, nullptr, 0.125f, tid, lane, wave, p.pad[0] != 0);
            }
        } }
#endif
        { FRESH(); unsigned* ctl = (unsigned*)(ws + WS_CTL);
        for (;;) {
            if (tid == 0) s_unit = (int)atomicAdd(&ctl[64 * (1 + l)], 1u);
            __syncthreads();
            const int u = s_unit;
            __syncthreads();
            if (u >= 768 + 512) break;
            if (u < 768) { const int qb = 7 - u / 96, bh = u % 96, b = bh / 6, h = bh % 6;
                bf16_t* base = R1 + (size_t)b * T * ZP + 1408 + h * 64;
                attn64_unit<0>(lds, base, base + 384, base + 768, ZP, base, qb * 256, (const float*)(ws + WS_CBUF) + (size_t)bh * T, 0.125f * LOG2E, tid, lane, wave, true, (const float*)(ws + 512 * 1024) + bh * 32);
            } else { const int u2 = u - 768; const int qb = 7 - u2 / 64, bh = u2 % 64, b = bh / 4, h = bh % 4;
                bf16_t* base = R1 + (size_t)b * T * ZP + 2560 + h * 64;
                attn64_unit<1>(lds, base, base + 256, base + 512, ZP, base, qb * 256, nullptr, 0.125f, tid, lane, wave, true);
            }
        } }
        GSYNC();
        { FRESH(); pg8::Gemm g{R1, (const bf16_t*)(ws + WS_WOUT), M, D, D, ZP, 6, 2048, 12, 1536}; pg8::StaticOrder S; S.init(M, D, G, bx);
          pg8::EpiBf16 E{R2, D, nullptr, 0};
          GEMM_REP pg8::gemm_phase<pg8::EpiBf16, pg8::StaticOrder, true, true>(ldsl, g, S, E); }
        GSYNC();
        { FRESH(); norm_rows<true, true>(gw, ngw, lane, M, XB, R2, p.in[3] + l * D, XB, p.in[21] + l * D, R3); }
        GSYNC();
        { FRESH(); pg8::Gemm g{R3, (const bf16_t*)(ws + WS_WQ), M, D, D, D, NOSEG}; pg8::StaticOrder S; S.init(M, D, G, bx);
          pg8::EpiBf16 E{R1, D, nullptr, 0};
          GEMM_REP pg8::gemm_phase<pg8::EpiBf16, pg8::StaticOrder, true, true>(ldsl, g, S, E); }
        GSYNC();
#ifdef PROBE_DUP_MEM
        { FRESH();
        for (int u = bx; u < 1024; u += G) { const int qb = u & 15, bh = u >> 4, b = bh >> 2, hh = bh & 3;
            bf16_t* qbase = R1 + (size_t)b * T * D + hh * 256; const bf16_t* kbase = MKV + (size_t)b * 256 * (2 * D) + hh * 256;
            attn_unit<256, 2>(lds, qbase, D, kbase, (const bf16_t*)p.out + (size_t)32 * 1024 * 1024 + (size_t)bh * 65536, 2 * D, qbase, qb * 128, 256, nullptr, 0.0625f * LOG2E, tid, lane, wave, p.pad[0] != 0); } }
#endif
        { FRESH();
        for (int u = bx; u < 1024; u += G) { const int qb = u & 15, bh = u >> 4, b = bh >> 2, hh = bh & 3;
            bf16_t* qbase = R1 + (size_t)b * T * D + hh * 256; const bf16_t* kbase = MKV + (size_t)b * 256 * (2 * D) + hh * 256;
            attn_unit<256, 2>(lds, qbase, D, kbase, (const bf16_t*)p.out + (size_t)32 * 1024 * 1024 + (size_t)bh * 65536, 2 * D, qbase, qb * 128, 256, nullptr, 0.0625f * LOG2E, tid, lane, wave, true); } }
        GSYNC();
        { FRESH(); pg8::Gemm g{R1, (const bf16_t*)(ws + WS_WO), M, D, D, D, NOSEG}; pg8::StaticOrder S; S.init(M, D, G, bx);
          pg8::EpiBf16 E{R2, D, nullptr, 0};
          GEMM_REP pg8::gemm_phase<pg8::EpiBf16, pg8::StaticOrder, true, true>(ldsl, g, S, E); }
        GSYNC();
        { FRESH(); norm_rows<true, true>(gw, ngw, lane, M, XB, R2, p.in[22] + l * D, XB, p.in[27] + l * D, R3); }
        GSYNC();
        { FRESH(); pg8::Gemm g{R3, (const bf16_t*)(ws + WS_WGU), M, 2 * DFF, D, D, NOSEG}; pg8::StaticOrder S; S.init(M, 2 * DFF, G, bx);
          pg8::EpiSwiGLU E{R1, DFF};
          GEMM_REP pg8::gemm_phase<pg8::EpiSwiGLU, pg8::StaticOrder, true, true>(ldsl, g, S, E); }
        GSYNC();
        { FRESH(); pg8::Gemm g{R1, (const bf16_t*)(ws + WS_WDN), M, D, DFF, DFF, NOSEG}; pg8::StaticOrder S; S.init(M, D, G, bx);
          pg8::EpiBf16 E{R2, D, nullptr, 0};
          GEMM_REP pg8::gemm_phase<pg8::EpiBf16, pg8::StaticOrder, true, true>(ldsl, g, S, E); }
        GSYNC();
        if (l == 0) {
            { FRESH(); norm_rows<true, true>(gw, ngw, lane, M, XB, R2, p.in[28], XB, p.in[2] + D, R3);
#ifdef PROBE_DUP_CONV
              convert_weights(p, 1, lds, gw, ngw, lane, wave);
#endif
              convert_weights(p, 1, lds, gw, ngw, lane, wave);
              norm_rows<false, false>(gw, ngw, lane, MEMR, p.in[1], nullptr, nullptr, nullptr, p.in[23] + D, MEMN); }
            GSYNC();
        } else {
            { FRESH(); norm_rows<true, false>(gw, ngw, lane, M, XB, R2, p.in[28] + D, xres, nullptr, nullptr); }
        }
    }
}

extern "C" void kernel_launch(void* const* d_in, const int* in_sizes, int n_in, void* d_out, int out_size, void* d_ws, size_t ws_size, hipStream_t stream) {
    static int grid_blocks = 0;
    if (grid_blocks == 0) {
        if (n_in != 31 || out_size != M * D || ws_size < WS_END) { fprintf(stderr, "kernel_launch: unexpected shapes (n_in %d out %d ws %zu)\n", n_in, out_size, ws_size); grid_blocks = -1; return; }
        int dev = 0, cus = 0, per_cu = 0;
        hipGetDevice(&dev); hipDeviceGetAttribute(&cus, hipDeviceAttributeMultiprocessorCount, dev);
        if (hipFuncSetAttribute((const void*)fwd_megakernel, hipFuncAttributeMaxDynamicSharedMemorySize, LDS_BYTES) != hipSuccess) { fprintf(stderr, "kernel_launch: hipFuncSetAttribute failed\n"); grid_blocks = -1; return; }
        if (hipOccupancyMaxActiveBlocksPerMultiprocessor(&per_cu, (const void*)fwd_megakernel, NTHREADS, LDS_BYTES) != hipSuccess || per_cu < 1) { fprintf(stderr, "kernel_launch: occupancy query gave %d\n", per_cu); per_cu = 1; }
        (void)hipGetLastError();
        grid_blocks = cus * 1;
    }
    if (grid_blocks < 0) return;
    (void)hipMemsetAsync((char*)d_ws + WS_CTL, 0, 65536, stream);
    Params p{};
    for (int i = 0; i < 31; ++i) p.in[i] = (const float*)d_in[i];
    p.out = (float*)d_out; p.ws = (unsigned char*)d_ws;
    void* args[] = {&p};
    hipError_t e = hipLaunchCooperativeKernel((const void*)fwd_megakernel, dim3(grid_blocks), dim3(NTHREADS), args, LDS_BYTES, stream);
    if (e != hipSuccess) fprintf(stderr, "cooperative launch failed: %s (grid %d)\n", hipGetErrorString(e), grid_blocks);
}
```

```cpp
#include <hip/hip_runtime.h>
#include <hip/hip_cooperative_groups.h>
#include <cstdio>
#include <cstdint>
namespace cg = cooperative_groups;
__device__ __forceinline__ int fresh_tid() { int t = threadIdx.x; asm volatile("" : "+v"(t)); return t; }
__device__ __forceinline__ int fresh_s(int v) { asm volatile("" : "+s"(v)); return v; }
namespace pg8 {
#define PG8_LAS __attribute__((address_space(3)))
typedef unsigned short bf16_t;
typedef short bf16x8 __attribute__((ext_vector_type(8)));
typedef float f32x4 __attribute__((ext_vector_type(4)));
typedef unsigned u32x4 __attribute__((ext_vector_type(4)));
constexpr int BM = 256, BK = 64, HALF = 128, HTB = HALF * BK * 2  , STAGE_BYTES = 8 * HTB, NXCD = 8, WGM = 8;

__host__ __device__ __forceinline__ int lds_byte(int r, int c) { const int st = (r >> 4) * 2 + (c >> 5), rr = r & 15, cc = c & 31, ob = rr * 64 + cc * 2; return st * 1024 + (ob ^ (((ob >> 9) & 1) << 5)); }
__host__ __device__ __forceinline__ void stage_rc(int b, int& R, int& C) { const int st = b / 1024, sb = b % 1024, swz = sb ^ (((sb >> 9) & 1) << 5); R = (st >> 1) * 16 + swz / 64; C = (st & 1) * 32 + (swz % 64) / 2; }
__host__ __device__ __forceinline__ int perm32(int rho) { const int n = rho >> 4, i = rho & 15; return 8 * (i >> 2) + 4 * n + (i & 3); }

struct Unit { int pm, pn; };
struct Gemm { const bf16_t* A; const bf16_t* Bt; int M, N, K; int lda; int s1, d1, s2, d2; };

struct StaticOrder {
    int nM, nN, nwg, G, c;
    __host__ __device__ void init(int M, int N, int G_, int c_) { nM = M / BM; nN = N / BM; nwg = nM * nN; G = G_; c = c_; }
    __host__ __device__ bool next(int i, Unit& u) const {
        const long L = (long)i * G + c; if (L >= nwg) return false;
        int wgid = (int)L; { const int q = nwg / NXCD, r = nwg % NXCD, xcd = wgid % NXCD, off = wgid / NXCD; wgid = (xcd < r ? xcd * (q + 1) : r * (q + 1) + (xcd - r) * q) + off; }
        const int nig = WGM * nN, gid = wgid / nig, fm = gid * WGM, gsz = (nM - fm) < WGM ? (nM - fm) : WGM;
        u.pm = fm + ((wgid % nig) % gsz); u.pn = (wgid % nig) / gsz; return true;
    }
    __device__ __forceinline__ void a_ready(const Unit&) const {}
    __device__ __forceinline__ void done(const Unit&) const {}
};

__device__ __forceinline__ unsigned cvt_pk_bf16(float lo, float hi) { unsigned r; asm("v_cvt_pk_bf16_f32 %0, %1, %2" : "=v"(r) : "v"(lo), "v"(hi)); return r; }
typedef float f32x2 __attribute__((ext_vector_type(2)));
template <class Epi, class Sched, bool ALIGN_EPI = false, bool SP2 = false>
__device__ __forceinline__ void gemm_phase(PG8_LAS unsigned char* lds, const Gemm g, const Sched& S, const Epi& E) {
    static_assert(SP2, "only the SP2 loop carries the lda / segment changes");
    const int tid = fresh_tid(), wid = __builtin_amdgcn_readfirstlane(tid >> 6), lane = tid & 63, wr = wid >> 2, wc = wid & 3, fr = lane & 15, fq = lane >> 4;
    const int K = g.K, nt = K / BK;
    unsigned voffA[2], voffB[2];
#pragma unroll
    for (int i = 0; i < 2; ++i) { int R, C; stage_rc(tid * 16 + i * 8192, R, C); const int Rb = Epi::PERM ? ((R & ~31) + perm32(R & 31)) : R;
        voffA[i] = (unsigned)(R * g.lda + C) * 2u; voffB[i] = (unsigned)(Rb * K + C) * 2u; }
    const size_t kstep = (size_t)(BK * 2);
    const size_t hstep = (size_t)HALF * K * 2, hstepA = (size_t)HALF * g.lda * 2;
    const size_t tstep = 2 * hstep, tstepA = 2 * hstepA;
#define PG8_KA(t) ((size_t)(t) * 128 + ((t) >= g.s1 ? (size_t)g.d1 : 0) + ((t) >= g.s2 ? (size_t)g.d2 : 0))
    const unsigned ldsw = (unsigned)wid * 1024u;
    const int aoff = lds_byte(wr * 64 + fr, fq * 8), boff = lds_byte(wc * 32 + fr, fq * 8);
#define PG8_SA(b, h) (((b) * 2 + (h)) * HTB)
#define PG8_SB(b, h) ((4 + (b) * 2 + (h)) * HTB)
#define PG8_STAGE(bufoff, gbase, voff) do { _Pragma("unroll") for (int _i = 0; _i < 2; ++_i) \
        __builtin_amdgcn_global_load_lds((const unsigned*)((const char*)(gbase) + (voff)[_i]), (PG8_LAS unsigned*)(lds + (bufoff) + ldsw + _i * 8192), 16, 0, 0); } while (0)
#define PG8_LDA(dst, b, h) do { _Pragma("unroll") for (int m = 0; m < 4; ++m) _Pragma("unroll") for (int k = 0; k < 2; ++k) dst[m][k] = *(const PG8_LAS bf16x8*)(lds + PG8_SA(b, h) + aoff + m * 2048 + k * 1024); } while (0)
#define PG8_LDB(dst, b, h) do { _Pragma("unroll") for (int n = 0; n < 2; ++n) _Pragma("unroll") for (int k = 0; k < 2; ++k) dst[n][k] = *(const PG8_LAS bf16x8*)(lds + PG8_SB(b, h) + boff + n * 2048 + k * 1024); } while (0)
#define PG8_MMA(ai, bj, At, Bt) do { __builtin_amdgcn_s_setprio(1); _Pragma("unroll") for (int m = 0; m < 4; ++m) _Pragma("unroll") for (int n = 0; n < 2; ++n) _Pragma("unroll") for (int k = 0; k < 2; ++k) \
        acc[ai][bj][m][n] = __builtin_amdgcn_mfma_f32_16x16x32_bf16(Bt[n][k], At[m][k], acc[ai][bj][m][n], 0, 0, 0); __builtin_amdgcn_s_setprio(0); } while (0)
#define PG8_WAIT_V(n) asm volatile("s_waitcnt vmcnt(" #n ")" ::: "memory")
#define PG8_WAIT_L(n) asm volatile("s_waitcnt lgkmcnt(" #n ")" ::: "memory")
#define PG8_BAR __builtin_amdgcn_s_barrier()
#define PG8_SCHED __builtin_amdgcn_sched_barrier(0)
    Unit cur, nxt; int ui = 0;
    if (!S.next(0, cur)) return;
    f32x4 acc[2][2][4][2];
#pragma unroll
    for (int a = 0; a < 2; ++a)
#pragma unroll
        for (int b = 0; b < 2; ++b)
#pragma unroll
            for (int m = 0; m < 4; ++m)
#pragma unroll
                for (int n = 0; n < 2; ++n) acc[a][b][m][n] = (f32x4){0.f, 0.f, 0.f, 0.f};
    bf16x8 At[4][2], B0[2][2], B1[2][2];
    const char* cA = (const char*)g.A + (size_t)cur.pm * tstepA; const char* cB = (const char*)g.Bt + (size_t)cur.pn * tstep;
    S.a_ready(cur);
    if constexpr (SP2) {
        PG8_STAGE(PG8_SB(0, 0), cB, voffB); PG8_STAGE(PG8_SB(0, 1), cB + hstep, voffB); PG8_STAGE(PG8_SA(0, 0), cA, voffA); PG8_STAGE(PG8_SA(0, 1), cA + hstepA, voffA);
        if (wr == 1) PG8_BAR;
        PG8_WAIT_V(2); PG8_BAR;
        PG8_STAGE(PG8_SB(1, 0), cB + kstep, voffB); PG8_STAGE(PG8_SA(1, 0), cA + PG8_KA(1), voffA); PG8_STAGE(PG8_SB(1, 1), cB + hstep + kstep, voffB);
        PG8_WAIT_V(6); PG8_BAR;
    } else {
        PG8_STAGE(PG8_SB(0, 0), cB, voffB); PG8_STAGE(PG8_SA(0, 0), cA, voffA); PG8_STAGE(PG8_SB(0, 1), cB + hstep, voffB); PG8_STAGE(PG8_SA(0, 1), cA + hstep, voffA);
        if (wr == 1) PG8_BAR;
        PG8_WAIT_V(4); PG8_BAR;
        PG8_STAGE(PG8_SB(1, 0), cB + kstep, voffB); PG8_STAGE(PG8_SA(1, 0), cA + kstep, voffA); PG8_STAGE(PG8_SB(1, 1), cB + hstep + kstep, voffB);
        PG8_WAIT_V(6); PG8_BAR;
    }
    for (;;) {
        const bool has_next = S.next(ui + 1, nxt);
        const char* nA = has_next ? (const char*)g.A + (size_t)nxt.pm * tstepA : cA; const char* nB = has_next ? (const char*)g.Bt + (size_t)nxt.pn * tstep : cB;
        for (int t = 0; t < nt; t += 2) {
            const bool last = (t == nt - 2);
            const char* a1 = cA + PG8_KA(t + 1);
            const char* a2 = last ? nA : cA + PG8_KA(t + 2); const char* b2 = last ? nB : cB + (size_t)(t + 2) * kstep;
            const char* a3 = last ? nA + PG8_KA(1) : cA + PG8_KA(t + 3); const char* b3 = b2 + kstep;
            if (last && has_next) S.a_ready(nxt);
            if constexpr (SP2) {
            PG8_LDB(B0, 0, 0); PG8_LDB(B1, 0, 1); PG8_SCHED; PG8_LDA(At, 0, 0); PG8_STAGE(PG8_SA(1, 1), a1 + hstepA, voffA);
            PG8_WAIT_V(8); PG8_WAIT_L(0); PG8_BAR; PG8_MMA(0, 0, At, B0); PG8_MMA(0, 1, At, B1); PG8_BAR; PG8_SCHED;
            PG8_LDA(At, 0, 1); PG8_STAGE(PG8_SB(0, 0), b2, voffB); PG8_STAGE(PG8_SB(0, 1), b2 + hstep, voffB); PG8_STAGE(PG8_SA(0, 0), a2, voffA);
            PG8_WAIT_V(8); PG8_WAIT_L(0); PG8_BAR; PG8_MMA(1, 0, At, B0); PG8_MMA(1, 1, At, B1); PG8_BAR; PG8_SCHED;
            PG8_LDB(B0, 1, 0); PG8_LDB(B1, 1, 1); PG8_SCHED; PG8_LDA(At, 1, 0); PG8_STAGE(PG8_SA(0, 1), a2 + hstepA, voffA);
            PG8_WAIT_V(8); PG8_WAIT_L(0); PG8_BAR; PG8_MMA(0, 0, At, B0); PG8_MMA(0, 1, At, B1); PG8_BAR; PG8_SCHED;
            PG8_LDA(At, 1, 1); PG8_STAGE(PG8_SB(1, 0), b3, voffB); PG8_STAGE(PG8_SB(1, 1), b3 + hstep, voffB); PG8_STAGE(PG8_SA(1, 0), a3, voffA);
            PG8_WAIT_V(8); PG8_WAIT_L(0); PG8_BAR; PG8_MMA(1, 0, At, B0); PG8_MMA(1, 1, At, B1); PG8_BAR; PG8_SCHED;
            } else {
            PG8_LDB(B0, 0, 0); PG8_SCHED; PG8_LDA(At, 0, 0); PG8_STAGE(PG8_SA(1, 1), a1 + hstep, voffA);
            PG8_WAIT_L(8); PG8_BAR; PG8_WAIT_L(0); PG8_MMA(0, 0, At, B0); PG8_BAR; PG8_SCHED;
            PG8_LDB(B1, 0, 1); PG8_STAGE(PG8_SB(0, 0), b2, voffB);
            PG8_BAR; PG8_WAIT_L(0); PG8_MMA(0, 1, At, B1); PG8_BAR;
            PG8_LDA(At, 0, 1); PG8_STAGE(PG8_SA(0, 0), a2, voffA);
            PG8_BAR; PG8_WAIT_L(0); PG8_MMA(1, 0, At, B0); PG8_BAR; PG8_SCHED;
            PG8_STAGE(PG8_SB(0, 1), b2 + hstep, voffB);
            PG8_WAIT_V(6); PG8_BAR; PG8_MMA(1, 1, At, B1); PG8_BAR;
            PG8_LDB(B0, 1, 0); PG8_SCHED; PG8_LDA(At, 1, 0); PG8_STAGE(PG8_SA(0, 1), a2 + hstep, voffA);
            PG8_WAIT_L(8); PG8_BAR; PG8_WAIT_L(0); PG8_MMA(0, 0, At, B0); PG8_BAR; PG8_SCHED;
            PG8_LDB(B1, 1, 1); PG8_STAGE(PG8_SB(1, 0), b3, voffB);
            PG8_BAR; PG8_WAIT_L(0); PG8_MMA(0, 1, At, B1); PG8_BAR;
            PG8_LDA(At, 1, 1); PG8_STAGE(PG8_SA(1, 0), a3, voffA);
            PG8_BAR; PG8_WAIT_L(0); PG8_MMA(1, 0, At, B0); PG8_BAR; PG8_SCHED;
            PG8_STAGE(PG8_SB(1, 1), b3 + hstep, voffB);
            PG8_WAIT_V(6); PG8_BAR; PG8_MMA(1, 1, At, B1); PG8_BAR;
            }
        }
        if constexpr (ALIGN_EPI) { if (wr == 0) PG8_BAR; }
        if constexpr (!Epi::AFTER_DRAIN) { E(acc, cur, wr, wc, fr, fq); S.done(cur); }
        if (!has_next) break;
#pragma unroll
        for (int a = 0; a < 2; ++a)
#pragma unroll
            for (int b = 0; b < 2; ++b)
#pragma unroll
                for (int m = 0; m < 4; ++m)
#pragma unroll
                    for (int n = 0; n < 2; ++n) acc[a][b][m][n] = (f32x4){0.f, 0.f, 0.f, 0.f};
        cur = nxt; cA = nA; cB = nB; ++ui;
        if constexpr (ALIGN_EPI) { if (wr == 1) PG8_BAR; }
    }
    PG8_WAIT_V(0);
    if constexpr (!ALIGN_EPI) { if (wr == 0) PG8_BAR; }
    PG8_BAR;
    if constexpr (Epi::AFTER_DRAIN) { E.fused(acc, cur, wr, wc, fr, fq, lds, wid, lane); S.done(cur); }
#undef PG8_SA
#undef PG8_KA
#undef PG8_SB
#undef PG8_STAGE
#undef PG8_LDA
#undef PG8_LDB
#undef PG8_MMA
#undef PG8_WAIT_V
#undef PG8_WAIT_L
#undef PG8_BAR
#undef PG8_SCHED
}
}

namespace pg8 {
struct EpiBf16 {
    static constexpr bool PERM = true, AFTER_DRAIN = false;
    bf16_t* O; int ldc; float* fl; int flcol;
    __device__ __forceinline__ void operator()(const f32x4 (&acc)[2][2][4][2], const Unit& u, int wr, int wc, int fr, int fq) const {
        const int row0 = u.pm * BM + wr * 64 + fr; const int colt = u.pn * BM; const int col0 = colt + wc * 32 + 8 * fq;
#pragma unroll
        for (int ai = 0; ai < 2; ++ai)
#pragma unroll
            for (int m = 0; m < 4; ++m) { bf16_t* rowp = O + (size_t)(row0 + ai * HALF + m * 16) * ldc + col0;
#pragma unroll
                for (int bj = 0; bj < 2; ++bj) { const f32x4 v0 = acc[ai][bj][m][0], v1 = acc[ai][bj][m][1];
                    u32x4 w; w.x = cvt_pk_bf16(v0[0], v0[1]); w.y = cvt_pk_bf16(v0[2], v0[3]); w.z = cvt_pk_bf16(v1[0], v1[1]); w.w = cvt_pk_bf16(v1[2], v1[3]);
                    *(u32x4*)(rowp + bj * HALF) = w; } }
        if (fl != nullptr && colt == flcol && wc == 0 && fq == 0) {
#pragma unroll
            for (int ai = 0; ai < 2; ++ai)
#pragma unroll
                for (int m = 0; m < 4; ++m) { float* p = fl + (size_t)(row0 + ai * HALF + m * 16) * 8; *(f32x4*)p = acc[ai][0][m][0]; *(f32x4*)(p + 4) = acc[ai][0][m][1]; }
        }
    }
};

struct EpiVT {
    static constexpr bool PERM = true, AFTER_DRAIN = false;
    bf16_t* VT;
    __device__ __forceinline__ void operator()(const f32x4 (&acc)[2][2][4][2], const Unit& u, int wr, int wc, int fr, int fq) const {
        {
            bf16_t* lanebase = VT + (size_t)(u.pm * 4 + u.pn) * 65536 + (size_t)(wc * 32 + 8 * fq) * 256 + wr * 64 + fr;
#pragma unroll
            for (int ai = 0; ai < 2; ++ai)
#pragma unroll
                for (int m = 0; m < 4; ++m) { bf16_t* pk = lanebase + ai * HALF + m * 16; asm volatile("" : "+v"(pk));
#pragma unroll
                    for (int bj = 0; bj < 2; ++bj)
#pragma unroll
                        for (int n = 0; n < 2; ++n) { const int d0 = bj * HALF + 4 * n; const f32x4 v = acc[ai][bj][m][n];
                            const unsigned w0 = cvt_pk_bf16(v[0], v[1]), w1 = cvt_pk_bf16(v[2], v[3]);
                            pk[(d0 + 0) * 256] = (bf16_t)(w0 & 0xffffu); pk[(d0 + 1) * 256] = (bf16_t)(w0 >> 16);
                            pk[(d0 + 2) * 256] = (bf16_t)(w1 & 0xffffu); pk[(d0 + 3) * 256] = (bf16_t)(w1 >> 16); }
                    asm volatile("" ::: "memory"); }
        }
    }
};
struct EpiSwiGLU {
    static constexpr bool PERM = true, AFTER_DRAIN = false;
    bf16_t* O; int ldc;
    __device__ __forceinline__ void operator()(const f32x4 (&acc)[2][2][4][2], const Unit& u, int wr, int wc, int fr, int fq) const {
        const int row0 = u.pm * BM + wr * 64 + fr; const int col0 = u.pn * HALF + wc * 32 + 8 * fq;
#pragma unroll
        for (int ai = 0; ai < 2; ++ai)
#pragma unroll
            for (int m = 0; m < 4; ++m) { bf16_t* rowp = O + (size_t)(row0 + ai * HALF + m * 16) * ldc + col0;
                float h[8];
#pragma unroll
                for (int n = 0; n < 2; ++n)
#pragma unroll
                    for (int i = 0; i < 4; ++i) { const float g = acc[ai][0][m][n][i], up = acc[ai][1][m][n][i]; h[n * 4 + i] = g * __builtin_amdgcn_rcpf(1.0f + __expf(-g)) * up; }
                u32x4 w; w.x = cvt_pk_bf16(h[0], h[1]); w.y = cvt_pk_bf16(h[2], h[3]); w.z = cvt_pk_bf16(h[4], h[5]); w.w = cvt_pk_bf16(h[6], h[7]);
                *(u32x4*)rowp = w; }
    }
};
}

typedef unsigned short bf16_t;
typedef short bf16x8 __attribute__((ext_vector_type(8)));
typedef float f32x4 __attribute__((ext_vector_type(4)));
typedef unsigned u32x4 __attribute__((ext_vector_type(4)));
typedef unsigned u32x2 __attribute__((ext_vector_type(2)));

constexpr int NB = 16, T = 2048, D = 1024, M = NB * T;
constexpr int ZP = 3584;
constexpr int A_COLS = 1408, IN_COLS = 3334, DFF = 2816;
constexpr int MEMR = NB * 256;
constexpr float RMS_EPS = 1e-6f, GN_EPS = 64e-5f;
constexpr float LOG2E = 1.4426950408889634f;
constexpr size_t MiB = 1u << 20;
constexpr size_t WS_CTL = 0, WS_WIN = 1 * MiB, WS_WLORA = 8 * MiB, WS_WOUT = 10 * MiB, WS_WQ = 12 * MiB, WS_WKV = 14 * MiB, WS_WO = 18 * MiB, WS_WGU = 20 * MiB, WS_WDN = 31 * MiB,
                 WS_CBUF = 37 * MiB, WS_FL = 38 * MiB, WS_MKV = 40 * MiB, WS_VFIRST = 56 * MiB, WS_R3 = 80 * MiB, WS_R2 = 144 * MiB, WS_R1 = 240 * MiB, WS_MEMN = 464 * MiB, WS_VFIN = 472 * MiB, WS_GEND = 496 * MiB, WS_SCAL = 502 * MiB, WS_END = 505 * MiB;
constexpr int NTHREADS = 512, NWAVES = 8;
constexpr int LDS_BYTES = 147456;

struct Params { const float* in[31]; float* out; unsigned char* ws; int pad[2]; };

__device__ __forceinline__ float bf2f(bf16_t v) { return __uint_as_float((unsigned)v << 16); }
__device__ __forceinline__ unsigned f2bf(float f) { return pg8::cvt_pk_bf16(f, 0.f) & 0xffffu; }
__device__ __forceinline__ unsigned pk2(float lo, float hi) { return pg8::cvt_pk_bf16(lo, hi); }
__device__ __forceinline__ float lo16(unsigned w) { return __uint_as_float(w << 16); }
__device__ __forceinline__ float hi16(unsigned w) { return __uint_as_float(w & 0xffff0000u); }
#define WS_DPP(x, ctrl) ((x) + __int_as_float(__builtin_amdgcn_update_dpp(0, __float_as_int(x), (ctrl), 0xF, 0xF, true)))
__device__ __forceinline__ float wave_sum(float v) {
    v = WS_DPP(v, 0xB1); v = WS_DPP(v, 0x4E); v = WS_DPP(v, 0x141); v = WS_DPP(v, 0x140);
    const int iv = __float_as_int(v);
    return (__int_as_float(__builtin_amdgcn_readlane(iv, 0)) + __int_as_float(__builtin_amdgcn_readlane(iv, 16))) + (__int_as_float(__builtin_amdgcn_readlane(iv, 32)) + __int_as_float(__builtin_amdgcn_readlane(iv, 48)));
}
#define BAR_LGKM() asm volatile("s_waitcnt lgkmcnt(0)\n\ts_barrier" ::: "memory")
__device__ __forceinline__ float sigmoidf_(float x) { return __builtin_amdgcn_rcpf(1.0f + __expf(-x)); }
__device__ __forceinline__ float logsigmoidf_(float x) { return fminf(x, 0.f) - __logf(1.0f + __expf(-fabsf(x))); }

__device__ __forceinline__ int colmap(int mode, int n) {
    if (mode == 1) { if (n < 2560) return n; if (n < 3328) return n + 6; if (n < 3334) return n - 768; return -1; }
    if (mode == 2) { const int tile = n >> 8, w = n & 255; return w < 128 ? tile * 128 + w : DFF + tile * 128 + (w - 128); }
    return n;
}
__device__ __forceinline__ void transpose_item(const float* __restrict__ W, int Nsrc, int K, bf16_t* WT, int nblk, int mode, float* scr, int item, int lane) {
    const int kb = item / nblk, nb = item % nblk, k0 = 64 * kb, n0 = 32 * nb;
    const int src = colmap(mode, n0 + (lane & 31));
#pragma unroll 8
    for (int i = 0; i < 32; ++i) { const int kk = 2 * i + (lane >> 5); scr[kk * 33 + (lane & 31)] = src >= 0 ? W[(size_t)(k0 + kk) * Nsrc + src] : 0.f; }
    asm volatile("s_waitcnt lgkmcnt(0)" ::: "memory");
    const int c = lane & 7;
#pragma unroll
    for (int j = 0; j < 4; ++j) { const int n = (lane >> 3) + 8 * j; const float* s = scr + (8 * c) * 33 + n;
        u32x4 o; o.x = pk2(s[0 * 33], s[1 * 33]); o.y = pk2(s[2 * 33], s[3 * 33]); o.z = pk2(s[4 * 33], s[5 * 33]); o.w = pk2(s[6 * 33], s[7 * 33]);
        *(u32x4*)(WT + (size_t)(n0 + n) * K + k0 + 8 * c) = o; }
    asm volatile("s_waitcnt lgkmcnt(0)" ::: "memory");
}
__device__ __forceinline__ void convert_weights(const Params& p, int l, unsigned char* lds, int gw, int ngw, int lane, int wave) {
    unsigned char* ws = p.ws;
    float* scr = (float*)(lds + wave * 16384);
    constexpr int I_IN = 16 * (ZP / 32), I_SQ = 16 * 32, I_KV = 16 * 64, I_GU = 16 * (2 * DFF / 32), I_DN = (DFF / 64) * 32;
    constexpr int NITEMS = I_IN + 3 * I_SQ + I_KV + I_GU + I_DN;
    for (int it = gw; it < NITEMS; it += ngw) {
        int r = it;
        if (r < I_IN) { transpose_item(p.in[4] + (size_t)l * D * IN_COLS, IN_COLS, D, (bf16_t*)(ws + WS_WIN), ZP / 32, 1, scr, r, lane); continue; } r -= I_IN;
        if (r < I_SQ) { transpose_item(p.in[20] + (size_t)l * D * D, D, D, (bf16_t*)(ws + WS_WOUT), 32, 0, scr, r, lane); continue; } r -= I_SQ;
        if (r < I_SQ) { transpose_item(p.in[24] + (size_t)l * D * D, D, D, (bf16_t*)(ws + WS_WQ), 32, 0, scr, r, lane); continue; } r -= I_SQ;
        if (r < I_SQ) { transpose_item(p.in[26] + (size_t)l * D * D, D, D, (bf16_t*)(ws + WS_WO), 32, 0, scr, r, lane); continue; } r -= I_SQ;
        if (r < I_KV) { transpose_item(p.in[25] + (size_t)l * D * 2 * D, 2 * D, D, (bf16_t*)(ws + WS_WKV), 64, 0, scr, r, lane); continue; } r -= I_KV;
        if (r < I_GU) { transpose_item(p.in[29] + (size_t)l * D * 2 * DFF, 2 * DFF, D, (bf16_t*)(ws + WS_WGU), 2 * DFF / 32, 2, scr, r, lane); continue; } r -= I_GU;
        transpose_item(p.in[30] + (size_t)l * DFF * D, D, DFF, (bf16_t*)(ws + WS_WDN), 32, 0, scr, r, lane);
    }
    const int Kl = l ? 640 : 256, Nl = l ? 1536 : 1280, kch = Kl / 8;
    const float* w_up = p.in[7] + (size_t)l * 64 * 384; const float* a_up = p.in[9] + (size_t)l * 64 * 384; const float* g_up = p.in[10] + (size_t)l * 128 * 384;
    const float* vdn = p.in[17]; const float* vup = p.in[18];
    bf16_t* WL = (bf16_t*)(ws + WS_WLORA);
    for (int ci = gw * 64 + lane; ci < Nl * kch; ci += ngw * 64) {
        const int n = ci / kch, k0 = (ci % kch) * 8; float v[8];
#pragma unroll
        for (int e = 0; e < 8; ++e) { const int k = k0 + e; float x = 0.f;
            if (n < 384) { if (k < 64) x = w_up[k * 384 + n]; }
            else if (n < 768) { if (k >= 64 && k < 128) x = a_up[(k - 64) * 384 + n - 384]; }
            else if (n < 1152) { if (k >= 128 && k < 256) x = g_up[(k - 128) * 384 + n - 768]; }
            else if (n < 1536 && l == 1) { if (k >= 256) { float s = 0.f; for (int r = 0; r < 32; ++r) s += vdn[(k - 256) * 32 + r] * vup[r * 384 + n - 1152]; x = s; } }
            v[e] = x; }
        u32x4 o; o.x = pk2(v[0], v[1]); o.y = pk2(v[2], v[3]); o.z = pk2(v[4], v[5]); o.w = pk2(v[6], v[7]);
        *(u32x4*)(WL + (size_t)n * Kl + k0) = o;
    }
}

template <bool XIB, bool XOB>
__device__ __forceinline__ void norm_rows(int gw, int ngw, int lane, int rows, const void* xin_, const bf16_t* y, const float* gpost, void* xout_, const float* gpre, bf16_t* hout) {
    constexpr int NR = 4;
    const float* xin = (const float*)xin_; const bf16_t* xinb = (const bf16_t*)xin_; float* xout = (float*)xout_; bf16_t* xoutb = (bf16_t*)xout_;
    for (int row0 = gw; row0 < rows; row0 += NR * ngw) {
        int rw[NR]; bool ok[NR];
#pragma unroll
        for (int k = 0; k < NR; ++k) { const int r = row0 + k * ngw; ok[k] = r < rows; rw[k] = ok[k] ? r : row0; }
        f32x4 x[NR][4]; u32x2 yy[NR][4];
#pragma unroll
        for (int k = 0; k < NR; ++k)
#pragma unroll
            for (int j = 0; j < 4; ++j) {
                if (XIB) { const u32x2 w = *(const u32x2*)(xinb + (size_t)rw[k] * D + 256 * j + 4 * lane); x[k][j] = (f32x4){lo16(w.x), hi16(w.x), lo16(w.y), hi16(w.y)}; }
                else x[k][j] = *(const f32x4*)(xin + (size_t)rw[k] * D + 256 * j + 4 * lane); }
        if (y != nullptr) {
#pragma unroll
            for (int k = 0; k < NR; ++k)
#pragma unroll
                for (int j = 0; j < 4; ++j) yy[k][j] = *(const u32x2*)(y + (size_t)rw[k] * D + 256 * j + 4 * lane);
#pragma unroll
            for (int k = 0; k < NR; ++k) {
                f32x4 v[4]; float ss = 0.f;
#pragma unroll
                for (int j = 0; j < 4; ++j) { v[j] = (f32x4){lo16(yy[k][j].x), hi16(yy[k][j].x), lo16(yy[k][j].y), hi16(yy[k][j].y)}; ss += (v[j].x * v[j].x + v[j].y * v[j].y) + (v[j].z * v[j].z + v[j].w * v[j].w); }
                const float r = rsqrtf(wave_sum(ss) * (1.0f / D) + RMS_EPS);
#pragma unroll
                for (int j = 0; j < 4; ++j) { const f32x4 g = *(const f32x4*)(gpost + 256 * j + 4 * lane); x[k][j] = x[k][j] + v[j] * r * g; }
            }
        }
        if (xout_ != nullptr) {
#pragma unroll
            for (int k = 0; k < NR; ++k) if (ok[k]) {
#pragma unroll
                for (int j = 0; j < 4; ++j) {
                    if (XOB) { u32x2 w; w.x = pk2(x[k][j].x, x[k][j].y); w.y = pk2(x[k][j].z, x[k][j].w); *(u32x2*)(xoutb + (size_t)rw[k] * D + 256 * j + 4 * lane) = w; }
                    else *(f32x4*)(xout + (size_t)rw[k] * D + 256 * j + 4 * lane) = x[k][j]; } }
        }
        if (gpre != nullptr) {
#pragma unroll
            for (int k = 0; k < NR; ++k) {
                float ss = 0.f;
#pragma unroll
                for (int j = 0; j < 4; ++j) ss += (x[k][j].x * x[k][j].x + x[k][j].y * x[k][j].y) + (x[k][j].z * x[k][j].z + x[k][j].w * x[k][j].w);
                const float r = rsqrtf(wave_sum(ss) * (1.0f / D) + RMS_EPS);
                if (ok[k]) {
#pragma unroll
                    for (int j = 0; j < 4; ++j) { const f32x4 g = *(const f32x4*)(gpre + 256 * j + 4 * lane); const f32x4 h = x[k][j] * r * g;
                        u32x2 w; w.x = pk2(h.x, h.y); w.y = pk2(h.z, h.w); *(u32x2*)(hout + (size_t)rw[k] * D + 256 * j + 4 * lane) = w; } }
            }
        }
    }
}

__device__ __forceinline__ void rwkv_pre(const Params& p, int l, int gw, int ngw, int lane) {
    const bf16_t* z = (const bf16_t*)(p.ws + WS_R1); bf16_t* lin = (bf16_t*)p.out; bf16_t* vfirst = (bf16_t*)(p.ws + WS_VFIRST);
    const float* mu = p.in[5] + (size_t)l * A_COLS; const int Kl = l ? 640 : 256;
    constexpr int NU = 4; const int nlanes = ngw * 64;
    for (int base = gw * 64 + lane; base < M * 80; base += NU * nlanes) {
        u32x4 zc[NU], zp[NU]; int tokv[NU], chv[NU]; bool okv[NU];
#pragma unroll
        for (int k = 0; k < NU; ++k) { const int idx = base + k * nlanes; okv[k] = idx < M * 80; const int id2 = okv[k] ? idx : base; tokv[k] = id2 / 80; chv[k] = id2 % 80;
            const int col = chv[k] < 48 ? 768 + 8 * chv[k] : 1152 + 8 * (chv[k] - 48);
            zc[k] = *(const u32x4*)(z + (size_t)tokv[k] * ZP + col);
            zp[k] = (u32x4){0u, 0u, 0u, 0u}; if ((tokv[k] % T) > 0) zp[k] = *(const u32x4*)(z + (size_t)(tokv[k] - 1) * ZP + col); }
#pragma unroll
        for (int k = 0; k < NU; ++k) { const int tok = tokv[k], ch = chv[k];
            const int col = ch < 48 ? 768 + 8 * ch : 1152 + 8 * (ch - 48);
            const f32x4 m0 = *(const f32x4*)(mu + col), m1 = *(const f32x4*)(mu + col + 4);
            float s[8];
            { const float c0 = lo16(zc[k].x), c1 = hi16(zc[k].x), c2 = lo16(zc[k].y), c3 = hi16(zc[k].y), c4 = lo16(zc[k].z), c5 = hi16(zc[k].z), c6 = lo16(zc[k].w), c7 = hi16(zc[k].w);
              s[0] = c0 + (lo16(zp[k].x) - c0) * m0.x; s[1] = c1 + (hi16(zp[k].x) - c1) * m0.y; s[2] = c2 + (lo16(zp[k].y) - c2) * m0.z; s[3] = c3 + (hi16(zp[k].y) - c3) * m0.w;
              s[4] = c4 + (lo16(zp[k].z) - c4) * m1.x; s[5] = c5 + (hi16(zp[k].z) - c5) * m1.y; s[6] = c6 + (lo16(zp[k].w) - c6) * m1.z; s[7] = c7 + (hi16(zp[k].w) - c7) * m1.w; }
            bf16_t* dst;
            if (ch < 48) { dst = (l == 0) ? vfirst + (size_t)tok * 384 + 8 * ch : lin + (size_t)tok * Kl + 256 + 8 * ch; }
            else { const int c2 = 8 * (ch - 48); dst = lin + (size_t)tok * Kl + c2;
                if (c2 < 64) {
#pragma unroll
                    for (int e = 0; e < 8; ++e) s[e] = 1.0f - 2.0f * __builtin_amdgcn_rcpf(__expf(2.0f * s[e]) + 1.0f);
                } else if (c2 >= 128) {
#pragma unroll
                    for (int e = 0; e < 8; ++e) s[e] = sigmoidf_(s[e]);
                } }
            u32x4 o; o.x = pk2(s[0], s[1]); o.y = pk2(s[2], s[3]); o.z = pk2(s[4], s[5]); o.w = pk2(s[6], s[7]);
            if (okv[k]) *(u32x4*)dst = o;
        }
    }
    {
        float* ktmax = (float*)(p.ws + 512 * 1024);
        for (int item = gw; item < 96 * 32; item += ngw) { const int bh = item >> 5, tile = item & 31, b = bh / 6, h = bh % 6;
            const bf16_t* kp = z + ((size_t)b * T + tile * 64 + lane) * ZP + 1792 + h * 64; float ss = 0.f;
#pragma unroll
            for (int c8 = 0; c8 < 8; ++c8) { const u32x4 w = *(const u32x4*)(kp + 8 * c8); const float a0 = lo16(w.x), a1 = hi16(w.x), a2 = lo16(w.y), a3 = hi16(w.y), a4 = lo16(w.z), a5 = hi16(w.z), a6 = lo16(w.w), a7 = hi16(w.w);
                ss += (a0 * a0 + a1 * a1) + (a2 * a2 + a3 * a3) + (a4 * a4 + a5 * a5) + (a6 * a6 + a7 * a7); }
#pragma unroll
            for (int o = 1; o < 64; o <<= 1) ss = fmaxf(ss, __shfl_xor(ss, o));
            if (lane == 0) ktmax[item] = sqrtf(ss); }
    }
    if (gw < 96) {
        const int b = gw / 6, h = gw % 6; const float* fl = (const float*)(p.ws + WS_FL); float* cb = (float*)(p.ws + WS_CBUF) + (size_t)gw * T;
        const float fb = p.in[19][l * 6 + h]; float carry = 0.f;
        for (int i0 = 0; i0 < 32; i0 += 8) {
            float fv[8];
#pragma unroll
            for (int i = 0; i < 8; ++i) fv[i] = fl[(size_t)(b * T + 64 * (i0 + i) + lane) * 8 + h];
#pragma unroll
            for (int i = 0; i < 8; ++i) {
                float v = logsigmoidf_(fv[i] + fb);
#pragma unroll
                for (int o = 1; o < 64; o <<= 1) { const float u = __shfl_up(v, o); if (lane >= o) v += u; }
                v += carry; cb[64 * (i0 + i) + lane] = v * LOG2E; carry = __shfl(v, 63);
            }
        }
    }
}

typedef float f32x2 __attribute__((ext_vector_type(2)));
__device__ __forceinline__ void rwkv_prep2(const Params& p, int l, int gw, int ngw, int lane, unsigned char* ldsb, int wave) {
    const bf16_t* z = (const bf16_t*)(p.ws + WS_R1); bf16_t* lo = (bf16_t*)(p.ws + WS_R2); const bf16_t* vfirst = (const bf16_t*)(p.ws + WS_VFIRST);
    bf16_t* rk = (bf16_t*)p.out; bf16_t* vfin = (bf16_t*)(p.ws + WS_VFIN); float* gend = (float*)(p.ws + WS_GEND); float* scal = (float*)(p.ws + WS_SCAL);
    const int Nl = l ? 1536 : 1280;
    for (int item = gw; item < NB * 256 * 6; item += ngw) {
        const int h = item % 6, bw = item / 6, b = bw >> 8, win = bw & 255; const int hj = h * 64 + lane; const int item2 = bw * 6 + h;
        const float mu_r = p.in[5][l * A_COLS + hj], mu_k = p.in[5][l * A_COLS + 384 + hj], mu_v = p.in[5][l * A_COLS + 768 + hj];
        const float w0 = p.in[6][l * 384 + hj], a0 = p.in[8][l * 384 + hj], k_k = p.in[11][l * 384 + hj], k_a = p.in[12][l * 384 + hj], r_k = p.in[13][l * 384 + hj];
        const float vbias = l ? p.in[16][hj] : 0.f;
        const size_t tok0 = (size_t)b * T + 8 * win;
        float pr = 0.f, pk = 0.f, pv = 0.f;
        if (win > 0) { const bf16_t* zq = z + (tok0 - 1) * ZP; pr = bf2f(zq[hj]); pk = bf2f(zq[384 + hj]); pv = bf2f(zq[768 + hj]); }
        float zr[8], zk[8], zv[8], wl[8], al[8], vl[8], vf[8];
#pragma unroll
        for (int i = 0; i < 8; ++i) { const size_t tok = tok0 + i; const bf16_t* zp_ = z + tok * ZP; const bf16_t* lor = lo + tok * Nl;
            zr[i] = bf2f(zp_[hj]); zk[i] = bf2f(zp_[384 + hj]); zv[i] = bf2f(zp_[768 + hj]); wl[i] = bf2f(lor[hj]); al[i] = bf2f(lor[384 + hj]);
            vl[i] = 0.f; vf[i] = 0.f; if (l) { vl[i] = bf2f(lor[1152 + hj]); vf[i] = bf2f(vfirst[tok * 384 + hj]); } }
        float G = 1.0f; float at[8], rt[8], bhv[8], khv[8];
#pragma unroll
        for (int i = 0; i < 8; ++i) { const size_t tok = tok0 + i;
            const float r = zr[i] + (pr - zr[i]) * mu_r, k = zk[i] + (pk - zk[i]) * mu_k; float v = zv[i] + (pv - zv[i]) * mu_v;
            pr = zr[i]; pk = zk[i]; pv = zv[i];
            if (l) v = v + (vf[i] - v) * sigmoidf_(vbias + vl[i]);
            const float xw = w0 + wl[i];
            const float wlog = -(fmaxf(-xw, 0.f) + __logf(1.0f + __expf(-fabsf(xw)))) - 0.5f;
            const float dec = __expf(-__expf(wlog));
            const float a = sigmoidf_(a0 + al[i]);
            float kk = k * k_k; const float n2 = wave_sum(kk * kk); kk *= rsqrtf(fmaxf(n2, 1e-24f));
            const float k2 = k * (1.0f + (a - 1.0f) * k_a);
            const float bvv = kk * a;
            const float bon = wave_sum(r * k2 * r_k);
            const float Gp = G; G = Gp * dec; const float iG = __builtin_amdgcn_rcpf(G);
            const unsigned bb = f2bf(bvv * iG), kb = f2bf(k2 * iG);
            at[i] = -kk * Gp; rt[i] = r * G; bhv[i] = __uint_as_float(bb << 16); khv[i] = __uint_as_float(kb << 16);
            lo[tok * Nl + 384 + hj] = (bf16_t)bb; rk[tok * 768 + 384 + hj] = (bf16_t)kb;
            vfin[tok * 384 + hj] = (bf16_t)f2bf(v);
            if (lane == 0) *(f32x4*)(scal + (tok * 6 + h) * 4) = (f32x4){0.f, 0.f, bon, 0.f};
        }
        gend[(tok0 >> 3) * 384 + hj] = G;
        float Tm[8][8], N1m[8][8], atp[8];
#pragma unroll
        for (int j = 0; j < 8; ++j)
#pragma unroll
            for (int m = 0; m < 8; ++m) { Tm[j][m] = 0.f; N1m[j][m] = 0.f; }
        float* nimg = (float*)((unsigned char*)p.out + 80 * MiB) + (size_t)item2 * 128;
        float* Pm = (float*)(ldsb + wave * 16384); float* Qm = Pm + 1024; float* GT = Qm + 1024;
#pragma unroll
        for (int m = 0; m < 8; ++m) { Pm[m * 64 + lane] = bhv[m]; Pm[(8 + m) * 64 + lane] = khv[m]; Qm[m * 64 + lane] = at[m]; Qm[(8 + m) * 64 + lane] = rt[m]; }
        { const int n16 = lane & 15, q = lane >> 4; f32x4 Dg = (f32x4){0.f, 0.f, 0.f, 0.f};
#pragma unroll
          for (int jt = 0; jt < 4; ++jt) { const f32x4 pa = *(const f32x4*)(Pm + n16 * 64 + 16 * jt + 4 * q), qb = *(const f32x4*)(Qm + n16 * 64 + 16 * jt + 4 * q);
              Dg = __builtin_amdgcn_mfma_f32_16x16x4f32(pa.x, qb.x, Dg, 0, 0, 0); Dg = __builtin_amdgcn_mfma_f32_16x16x4f32(pa.y, qb.y, Dg, 0, 0, 0);
              Dg = __builtin_amdgcn_mfma_f32_16x16x4f32(pa.z, qb.z, Dg, 0, 0, 0); Dg = __builtin_amdgcn_mfma_f32_16x16x4f32(pa.w, qb.w, Dg, 0, 0, 0); }
          *(f32x4*)(GT + n16 * 16 + 4 * q) = Dg; }
#pragma unroll
        for (int s = 0; s < 8; ++s) {
            float mab[8], mka[8], mbr[8], mkr[8];
#pragma unroll
            for (int j = 0; j < 8; ++j) { mab[j] = GT[s * 16 + j]; mka[j] = GT[s * 16 + 8 + j]; mbr[j] = GT[(8 + s) * 16 + j]; mkr[j] = GT[(8 + s) * 16 + 8 + j]; }
#pragma unroll
            for (int j = 0; j < 8; ++j) if (j <= s) { float t = (j == s) ? 1.0f : 0.f;
#pragma unroll
                for (int m = 0; m < 8; ++m) if (m >= j && m < s) t += Tm[j][m] * mab[m];
                Tm[j][s] = t; }
            float ap = 0.f;
#pragma unroll
            for (int m = 0; m < 8; ++m) if (m <= s) ap += at[m] * Tm[m][s];
            atp[s] = ap;
#pragma unroll
            for (int j = 0; j < 8; ++j) if (j < s) { float n = mka[j];
#pragma unroll
                for (int m = 0; m < 8; ++m) if (m > j && m < s) n += N1m[j][m] * mab[m];
                N1m[j][s] = n; }
            float rp = rt[s];
#pragma unroll
            for (int m = 0; m < 8; ++m) if (m <= s) rp += atp[m] * mbr[m];
            float n2c[8];
#pragma unroll
            for (int j = 0; j < 8; ++j) { float n = 0.f; if (j <= s) { n = mkr[j];
#pragma unroll
                    for (int m = 0; m < 8; ++m) if (m > j && m <= s) n += N1m[j][m] * mbr[m]; }
                n2c[j] = n; }
            const size_t tok = tok0 + s;
            lo[tok * Nl + hj] = (bf16_t)f2bf(ap); rk[tok * 768 + hj] = (bf16_t)f2bf(rp);
            if (lane == 0) { *(f32x4*)(nimg + s * 8) = (f32x4){N1m[0][s], N1m[1][s], N1m[2][s], N1m[3][s]}; *(f32x4*)(nimg + s * 8 + 4) = (f32x4){N1m[4][s], N1m[5][s], N1m[6][s], N1m[7][s]};
                             *(f32x4*)(nimg + 64 + s * 8) = (f32x4){n2c[0], n2c[1], n2c[2], n2c[3]}; *(f32x4*)(nimg + 64 + s * 8 + 4) = (f32x4){n2c[4], n2c[5], n2c[6], n2c[7]}; }
        }
    }
}

#define DPP_ADD(x, ctrl) ((x) + __int_as_float(__builtin_amdgcn_update_dpp(0, __float_as_int(x), (ctrl), 0xF, 0xF, true)))
__device__ __forceinline__ float red8(float x) { x = DPP_ADD(x, 0xB1); x = DPP_ADD(x, 0x4E); x = DPP_ADD(x, 0x141); return x; }
__device__ __forceinline__ f32x2 fma2(f32x2 a, f32x2 b, f32x2 c) { return __builtin_elementwise_fma(a, b, c); }
#define SCAN_BAR() asm volatile("s_waitcnt vmcnt(0) lgkmcnt(0)\n\ts_barrier" ::: "memory")
#define SCAN_BAR_L() asm volatile("s_waitcnt lgkmcnt(0)\n\ts_barrier" ::: "memory")

__device__ __forceinline__ void scan_unit(const Params& p, int l, int bh, unsigned char* ldsb, int tid, int lane, int wave, bool store) {
    const int b = bh / 6, h = bh % 6;
    constexpr int BUFSZ = 6 * 2048 + 128 + 256 + 512;
    float* base = (float*)ldsb; float* Ybase = base + 2 * BUFSZ;
    if (wave < 4) {
        const int n16 = lane & 15, q = lane >> 4; const int irow = 16 * wave + n16;
        f32x4 Z0 = (f32x4){0.f, 0.f, 0.f, 0.f}, Z1 = Z0, Z2 = Z0, Z3 = Z0;
        SCAN_BAR();
        for (int c = 0; c < T / 32; ++c) {
            const float* buf = base + (c & 1) * BUFSZ; float* Y = Ybase + (c & 1) * 2048;
            const float* AT = buf; const float* RT = buf + 2048; const float* BH = buf + 4096; const float* KH = buf + 6144; const float* Vv = buf + 8192; const float* GE = buf + 12416; const float* NI = buf + 12672;
#define MF4(a_, b_, c_) __builtin_amdgcn_mfma_f32_16x16x4f32((a_), (b_), (c_), 0, 0, 0)
#pragma unroll 1
            for (int w8 = 0; w8 < 4; ++w8) {
                const int tt0 = 8 * w8;
                const float* xrow = (n16 < 8 ? AT + (tt0 + n16) * 64 : RT + (tt0 + n16 - 8) * 64) + 4 * q;
                const f32x4 x0 = *(const f32x4*)(xrow), x1 = *(const f32x4*)(xrow + 16), x2 = *(const f32x4*)(xrow + 32), x3 = *(const f32x4*)(xrow + 48);
                const float na = NI[w8 * 128 + n16 * 8 + q], nb = NI[w8 * 128 + n16 * 8 + 4 + q];
                const float va = Vv[(tt0 + q) * 64 + irow], vb = Vv[(tt0 + 4 + q) * 64 + irow];
                f32x4 D1 = (f32x4){0.f, 0.f, 0.f, 0.f};
                D1 = MF4(x0.x, Z0.x, D1); D1 = MF4(x0.y, Z0.y, D1); D1 = MF4(x0.z, Z0.z, D1); D1 = MF4(x0.w, Z0.w, D1);
                D1 = MF4(x1.x, Z1.x, D1); D1 = MF4(x1.y, Z1.y, D1); D1 = MF4(x1.z, Z1.z, D1); D1 = MF4(x1.w, Z1.w, D1);
                D1 = MF4(x2.x, Z2.x, D1); D1 = MF4(x2.y, Z2.y, D1); D1 = MF4(x2.z, Z2.z, D1); D1 = MF4(x2.w, Z2.w, D1);
                D1 = MF4(x3.x, Z3.x, D1); D1 = MF4(x3.y, Z3.y, D1); D1 = MF4(x3.z, Z3.z, D1); D1 = MF4(x3.w, Z3.w, D1);
                D1 = MF4(na, va, D1); D1 = MF4(nb, vb, D1);
                const int sq = tt0 + 4 * (q & 1);
                const float* vsel = Vv + sq * 64 + irow;
                const float v0 = vsel[0], v1 = vsel[64], v2 = vsel[128], v3 = vsel[192];
                if (q >= 2) { float* yp = Y + sq * 64 + irow; yp[0] = D1.x; yp[64] = D1.y; yp[128] = D1.z; yp[192] = D1.w; }
                const float b0 = q < 2 ? D1.x : v0, b1 = q < 2 ? D1.y : v1, b2 = q < 2 ? D1.z : v2, b3 = q < 2 ? D1.w : v3;
                const float* arow = (q < 2 ? BH : KH) + sq * 64 + n16;
                Z0 = MF4(arow[0], b0, Z0);  Z0 = MF4(arow[64], b1, Z0);  Z0 = MF4(arow[128], b2, Z0);  Z0 = MF4(arow[192], b3, Z0);
                Z1 = MF4(arow[16], b0, Z1); Z1 = MF4(arow[80], b1, Z1);  Z1 = MF4(arow[144], b2, Z1);  Z1 = MF4(arow[208], b3, Z1);
                Z2 = MF4(arow[32], b0, Z2); Z2 = MF4(arow[96], b1, Z2);  Z2 = MF4(arow[160], b2, Z2);  Z2 = MF4(arow[224], b3, Z2);
                Z3 = MF4(arow[48], b0, Z3); Z3 = MF4(arow[112], b1, Z3); Z3 = MF4(arow[176], b2, Z3);  Z3 = MF4(arow[240], b3, Z3);
                const float* gp = GE + w8 * 64 + 4 * q;
                Z0 *= *(const f32x4*)(gp); Z1 *= *(const f32x4*)(gp + 16); Z2 *= *(const f32x4*)(gp + 32); Z3 *= *(const f32x4*)(gp + 48);
            }
#undef MF4
            SCAN_BAR();
        }
    } else {
        bf16_t* z = (bf16_t*)(p.ws + WS_R1); const bf16_t* lo = (const bf16_t*)(p.ws + WS_R2); const bf16_t* rk = (const bf16_t*)p.out;
        const bf16_t* vfin = (const bf16_t*)(p.ws + WS_VFIN); const float* gend = (const float*)(p.ws + WS_GEND); const float* scal = (const float*)(p.ws + WS_SCAL);
        const int Nl = l ? 1536 : 1280; const int pw = wave - 4; const int hj = h * 64 + lane;
        const float gn_g = p.in[14][l * 384 + hj], gn_b = p.in[15][l * 384 + hj];
        const int li = lane >> 3, lc = 8 * (lane & 7);
        u32x4 rAT, rBH, rGL, rRT, rKH, rV; float rGE = 0.f; f32x4 rSC = (f32x4){0.f, 0.f, 0.f, 0.f}; f32x2 rNI = (f32x2){0.f, 0.f};
        const float* nimg = (const float*)((const unsigned char*)p.out + 80 * MiB);
#define SCAN_LOAD(c_) do { const int cc = (c_); const size_t tok = (size_t)b * T + 32 * cc + 8 * pw + li; \
            rAT = *(const u32x4*)(lo + tok * Nl + h * 64 + lc); rBH = *(const u32x4*)(lo + tok * Nl + 384 + h * 64 + lc); rGL = *(const u32x4*)(lo + tok * Nl + 768 + h * 64 + lc); \
            rRT = *(const u32x4*)(rk + tok * 768 + h * 64 + lc); rKH = *(const u32x4*)(rk + tok * 768 + 384 + h * 64 + lc); rV = *(const u32x4*)(vfin + tok * 384 + h * 64 + lc); \
            rGE = gend[(((size_t)b * T + 32 * cc + 8 * pw) >> 3) * 384 + hj]; rNI = *(const f32x2*)(nimg + ((((size_t)b * T + 32 * cc + 8 * pw) >> 3) * 6 + h) * 128 + 2 * lane); \
            if (lane < 8) rSC = *(const f32x4*)(scal + (((size_t)b * T + 32 * cc + 8 * pw + lane) * 6 + h) * 4); } while (0)
#define SCAN_ST1(arr_, reg_) do { float* d_ = buf + (arr_) + (8 * pw + li) * 64 + lc; \
            *(f32x4*)d_ = (f32x4){lo16(reg_.x), hi16(reg_.x), lo16(reg_.y), hi16(reg_.y)}; *(f32x4*)(d_ + 4) = (f32x4){lo16(reg_.z), hi16(reg_.z), lo16(reg_.w), hi16(reg_.w)}; } while (0)
#define SCAN_STORE(c_) do { const int cc = (c_); float* buf = base + (cc & 1) * BUFSZ; \
            SCAN_ST1(0, rAT); SCAN_ST1(2048, rRT); SCAN_ST1(4096, rBH); SCAN_ST1(6144, rKH); SCAN_ST1(8192, rV); SCAN_ST1(10240, rGL); \
            buf[12416 + pw * 64 + lane] = rGE; *(f32x2*)(buf + 12672 + pw * 128 + 2 * lane) = rNI; if (lane < 8) *(f32x4*)(buf + 12288 + (8 * pw + lane) * 4) = rSC; } while (0)
#define SCAN_POST(c_) do { const int cc = (c_); const float* buf = base + (cc & 1) * BUFSZ; const float* Y = Ybase + (cc & 1) * 2048; \
            _Pragma("unroll") for (int i = 0; i < 8; ++i) { const int tt = 8 * pw + i; const int o = tt * 64 + lane; const float y = Y[o]; \
                const float mean = wave_sum(y) * (1.0f / 64.0f); const float d = y - mean; const float var = wave_sum(d * d) * (1.0f / 64.0f); \
                const float yn = d * rsqrtf(var + GN_EPS) * gn_g + gn_b; \
                const float outv = (yn + buf[12288 + tt * 4 + 2] * buf[8192 + o]) * buf[10240 + o]; \
                if (store) z[((size_t)b * T + 32 * cc + tt) * ZP + hj] = (bf16_t)f2bf(outv); } } while (0)
        SCAN_LOAD(0);
        SCAN_STORE(0);
        SCAN_LOAD(1);
        SCAN_BAR_L();
        for (int c = 0; c < T / 32; ++c) {
            if (c > 0) SCAN_POST(c - 1);
            if (c + 1 < T / 32) SCAN_STORE(c + 1);
            if (c + 2 < T / 32) SCAN_LOAD(c + 2);
            SCAN_BAR_L();
        }
        SCAN_POST(T / 32 - 1);
#undef SCAN_LOAD
#undef SCAN_ST1
#undef SCAN_STORE
#undef SCAN_POST
    }
    __syncthreads();
}

template <int HD, int MODE>
__device__ __forceinline__ void attn_unit(unsigned char* ldsb, const bf16_t* Qg, int qpitch, const bf16_t* Kg, const bf16_t* Vg, int kvpitch, bf16_t* Og, int q0, int nkeys, const float* cseq, float scale,
                                          int tid, int lane, int wave, bool store) {
    constexpr int KP = (HD + 8) * 2;
    constexpr int VP = 72 * 2;
    constexpr int NCH = HD / 64;
    constexpr int NKB = HD / 32, NDT = HD / 16;
    unsigned char* Ks = ldsb; unsigned char* Vts = ldsb + 64 * KP; float* cs = (float*)(Vts + HD * VP);
    const int r16 = lane & 15, fq = lane >> 4;
    const int qrow = q0 + 16 * wave + r16;
    bf16x8 qf[NKB];
#pragma unroll
    for (int kb = 0; kb < NKB; ++kb) qf[kb] = *(const bf16x8*)(Qg + (size_t)qrow * qpitch + 32 * kb + 8 * fq);
    f32x4 o[NDT];
#pragma unroll
    for (int dt = 0; dt < NDT; ++dt) o[dt] = (f32x4){0.f, 0.f, 0.f, 0.f};
    float m_run = -INFINITY, l_part = 0.f, Rtot = 0.f;
    float cq = 0.f; if (MODE == 0) cq = cseq[qrow];
    const int ntiles = (MODE == 2) ? nkeys / 64 : (q0 + 128) / 64;
    u32x4 kreg[NCH], vreg[NCH]; float creg = 0.f;
#define ATT_ISSUE(tt_) do { const int k0_ = (tt_) * 64; \
        _Pragma("unroll") for (int it = 0; it < NCH; ++it) { const int ci = tid + 512 * it; const int row = ci / (HD / 8), ch = ci % (HD / 8); \
            kreg[it] = *(const u32x4*)(Kg + (size_t)(k0_ + row) * kvpitch + 8 * ch); \
            vreg[it] = *(const u32x4*)(Vg + (size_t)((tid >> 3) + 64 * it) * 256 + k0_ + 8 * (tid & 7)); } \
        if (MODE == 0 && tid < 64) creg = cseq[k0_ + tid]; } while (0)
    int t = (MODE == 1) ? ntiles - 1 : 0;
    ATT_ISSUE(t);
    for (int it_ = 0; it_ < ntiles; ++it_) {
        BAR_LGKM();
#pragma unroll
        for (int it = 0; it < NCH; ++it) { const int ci = tid + 512 * it; const int row = ci / (HD / 8), ch = ci % (HD / 8);
            *(u32x4*)(Ks + row * KP + ch * 16) = kreg[it];
            unsigned char* vp_ = Vts + ((tid >> 3) + 64 * it) * VP + (32 * ((tid & 7) >> 2) + 16 * (tid & 1) + 4 * ((tid >> 1) & 1)) * 2; const u32x4 v = vreg[it];
            *(u32x2*)vp_ = (u32x2){v.x, v.y}; *(u32x2*)(vp_ + 16) = (u32x2){v.z, v.w}; }
        if (MODE == 0 && tid < 64) cs[tid] = creg;
        BAR_LGKM();
        const int k0 = t * 64;
        const int tn = (MODE == 1) ? t - 1 : t + 1;
        if (it_ + 1 < ntiles) ATT_ISSUE(tn);
        f32x4 s[4];
#pragma unroll
        for (int j = 0; j < 4; ++j) { s[j] = (f32x4){0.f, 0.f, 0.f, 0.f};
#pragma unroll
            for (int kb = 0; kb < NKB; ++kb) { const bf16x8 a = *(const bf16x8*)(Ks + (16 * j + r16) * KP + (32 * kb + 8 * fq) * 2); s[j] = __builtin_amdgcn_mfma_f32_16x16x32_bf16(a, qf[kb], s[j], 0, 0, 0); } }
        if (MODE == 0 || MODE == 2) {
            float tmax = -INFINITY;
#pragma unroll
            for (int j = 0; j < 4; ++j) {
                f32x4 ck = (f32x4){0.f, 0.f, 0.f, 0.f}; if (MODE == 0) ck = *(const f32x4*)(cs + 16 * j + 4 * fq);
#pragma unroll
                for (int i = 0; i < 4; ++i) { float v = s[j][i] * scale; if (MODE == 0) { v += (cq - ck[i]) * LOG2E; if (k0 + 16 * j + 4 * fq + i > qrow) v = -INFINITY; } s[j][i] = v; tmax = fmaxf(tmax, v); } }
            tmax = fmaxf(tmax, __shfl_xor(tmax, 16)); tmax = fmaxf(tmax, __shfl_xor(tmax, 32));
            const float mnew = fmaxf(m_run, tmax); const float alpha = __builtin_amdgcn_exp2f(m_run - mnew); m_run = mnew;
            float ps = 0.f;
#pragma unroll
            for (int j = 0; j < 4; ++j)
#pragma unroll
                for (int i = 0; i < 4; ++i) { const float pv = __builtin_amdgcn_exp2f(s[j][i] - mnew); s[j][i] = pv; ps += pv; }
            l_part = l_part * alpha + ps;
#pragma unroll
            for (int dt = 0; dt < NDT; ++dt) o[dt] = o[dt] * alpha;
        } else {
            float lr[4][4], ls[4][4], g[4];
#pragma unroll
            for (int j = 0; j < 4; ++j) { g[j] = 0.f;
#pragma unroll
                for (int i = 0; i < 4; ++i) { const float lg = s[j][i] * scale; const float lsg = logsigmoidf_(lg); const bool valid = (k0 + 16 * j + 4 * fq + i) < qrow;
                    ls[j][i] = lsg; lr[j][i] = valid ? lsg - lg : 0.f; g[j] += lr[j][i]; } }
            float suffix = Rtot;
#pragma unroll
            for (int j = 3; j >= 0; --j) {
                const float ga = g[j], gb = __shfl_xor(ga, 16), gc = __shfl_xor(ga, 32), gd = __shfl_xor(ga, 48);
                const float within = (fq == 0) ? (gb + gc + gd) : (fq == 1) ? (gc + gd) : (fq == 2) ? gb : 0.f;
                float run = suffix + within;
#pragma unroll
                for (int i = 3; i >= 0; --i) { const bool valid = (k0 + 16 * j + 4 * fq + i) < qrow; s[j][i] = valid ? __expf(ls[j][i] + run) : 0.f; run += lr[j][i]; }
                suffix += (ga + gb) + (gc + gd);
            }
            Rtot = suffix;
        }
        bf16x8 pf[2];
#pragma unroll
        for (int kvb = 0; kvb < 2; ++kvb) { u32x4 w; w.x = pk2(s[2 * kvb][0], s[2 * kvb][1]); w.y = pk2(s[2 * kvb][2], s[2 * kvb][3]); w.z = pk2(s[2 * kvb + 1][0], s[2 * kvb + 1][1]); w.w = pk2(s[2 * kvb + 1][2], s[2 * kvb + 1][3]);
            pf[kvb] = __builtin_bit_cast(bf16x8, w); }
#pragma unroll
        for (int dt = 0; dt < NDT; ++dt)
#pragma unroll
            for (int kvb = 0; kvb < 2; ++kvb) { const bf16x8 a = *(const bf16x8*)(Vts + (16 * dt + r16) * VP + (32 * kvb + 8 * fq) * 2); o[dt] = __builtin_amdgcn_mfma_f32_16x16x32_bf16(a, pf[kvb], o[dt], 0, 0, 0); }
        if (MODE == 1) { if (__syncthreads_and(Rtot < -105.0f)) break; }
        t = tn;
    }
    float inv = 1.0f;
    if (MODE != 1) { float lt = l_part; lt += __shfl_xor(lt, 16); lt += __shfl_xor(lt, 32); inv = 1.0f / lt; }
#pragma unroll
    for (int dt = 0; dt < NDT; ++dt) { const f32x4 v = o[dt] * inv; u32x2 w; w.x = pk2(v.x, v.y); w.y = pk2(v.z, v.w);
        if (store) *(u32x2*)(Og + (size_t)qrow * qpitch + 16 * dt + 4 * fq) = w; }
    __syncthreads();
#undef ATT_ISSUE
}

typedef float f32x16 __attribute__((ext_vector_type(16)));
__device__ __forceinline__ int crow_(int r, int hi) { return (r & 3) + 8 * (r >> 2) + 4 * hi; }
template <int MODE>
__device__ __forceinline__ void attn64_unit(unsigned char* ldsb, const bf16_t* Qg, const bf16_t* Kg, const bf16_t* Vg, int pitch, bf16_t* Og, int q0, const float* cseq, float scale,
                                            int tid, int lane, int wave, bool store, const float* ktmax = nullptr) {
    constexpr int KP = 144, VP = 144, BUF = 64 * KP + 64 * VP + 256;
    const int r32 = lane & 31, hi = lane >> 5;
    const int qrow = q0 + 32 * wave + r32;
    bf16x8 qf[4];
#pragma unroll
    for (int ks = 0; ks < 4; ++ks) qf[ks] = *(const bf16x8*)(Qg + (size_t)qrow * pitch + 16 * ks + 8 * hi);
    f32x16 o0, o1;
#pragma unroll
    for (int r = 0; r < 16; ++r) { o0[r] = 0.f; o1[r] = 0.f; }
    float m_run = -INFINITY, l_part = 0.f, Rtot = 0.f;
    float cq = 0.f; if (MODE == 0) cq = cseq[qrow];
    float qs = 0.f;
    float* pmx = (float*)(ldsb + 2 * BUF);
    if (MODE == 0) {
        float ss = 0.f;
#pragma unroll
        for (int ks = 0; ks < 4; ++ks)
#pragma unroll
            for (int e = 0; e < 8; ++e) { const float v = __uint_as_float((unsigned)(unsigned short)qf[ks][e] << 16); ss += v * v; }
        ss += __shfl_xor(ss, 32); qs = sqrtf(ss) * scale * 1.01f;
        if (tid < 64) { float v = tid < 32 ? ktmax[tid] : 0.f;
#pragma unroll
            for (int o = 1; o < 32; o <<= 1) { const float u = __shfl_up(v, o); if ((tid & 31) >= o) v = fmaxf(v, u); }
            if (tid < 32) { pmx[tid] = v * 1.01f; pmx[64 + tid] = tid ? cseq[64 * tid - 1] : 0.f; } }
    }
    const int ntiles = (q0 + 256) / 64;
    const int qlo = q0 + 32 * wave;
    u32x4 kregA = (u32x4){0u, 0u, 0u, 0u}, vregA = kregA, kregB = kregA, vregB = kregA; float cregA = 0.f, cregB = 0.f;
    const int krow = tid >> 3, kch = tid & 7, vrow = tid & 63, vch = tid >> 6;
    const int vperm = (vrow & 0x33) | ((vrow & 4) << 1) | ((vrow & 8) >> 1);
#define A64_ISSUE(S, tt_) do { const int k0_ = (tt_) * 64; \
        kreg##S = *(const u32x4*)(Kg + (size_t)(k0_ + krow) * pitch + 8 * kch); vreg##S = *(const u32x4*)(Vg + (size_t)(k0_ + vrow) * pitch + 8 * vch); \
        if (MODE == 0 && tid < 64) creg##S = cseq[k0_ + tid]; } while (0)
#define A64_STORE(S, b_) do { unsigned char* B_ = ldsb + (b_) * BUF; *(u32x4*)(B_ + krow * KP + kch * 16) = kreg##S; \
        bf16_t* vd = (bf16_t*)(B_ + 64 * KP + (8 * vch) * VP + vperm * 2); const u32x4 v = vreg##S; \
        vd[0 * 72] = (bf16_t)(v.x & 0xffffu); vd[1 * 72] = (bf16_t)(v.x >> 16); vd[2 * 72] = (bf16_t)(v.y & 0xffffu); vd[3 * 72] = (bf16_t)(v.y >> 16); \
        vd[4 * 72] = (bf16_t)(v.z & 0xffffu); vd[5 * 72] = (bf16_t)(v.z >> 16); vd[6 * 72] = (bf16_t)(v.w & 0xffffu); vd[7 * 72] = (bf16_t)(v.w >> 16); \
        if (MODE == 0 && tid < 64) ((float*)(B_ + 64 * KP + 64 * VP))[tid] = creg##S; } while (0)
    int t = ntiles - 1;
    const int dt_ = -1;
    A64_ISSUE(A, t);
    A64_ISSUE(B, t + dt_);
    A64_STORE(A, 0);
    A64_ISSUE(A, t + 2 * dt_);
    int* vt = (int*)(ldsb + 2 * BUF + 512);
    BAR_LGKM();
    bool leave = false; bool wdone = false;
    for (int it0 = 0; it0 < ntiles && !leave; it0 += 2) {
#pragma unroll
    for (int half = 0; half < 2; ++half) { const int it_ = it0 + half;
        const unsigned char* Bc = ldsb + half * BUF; const unsigned char* Ks = Bc; const unsigned char* Vts = Bc + 64 * KP; const float* cs = (const float*)(Bc + 64 * KP + 64 * VP);
        { const int tn3 = (t - 3 > 0) ? t - 3 : 0;
          if (half) { A64_STORE(A, 0); A64_ISSUE(A, tn3); } else { A64_STORE(B, 1); A64_ISSUE(B, tn3); } }
        const int k0 = t * 64;
        if (k0 <= qlo + 31 && !wdone) {
            f32x16 p0, p1;
#pragma unroll
            for (int r = 0; r < 16; ++r) { p0[r] = 0.f; p1[r] = 0.f; }
#pragma unroll
            for (int ks = 0; ks < 4; ++ks) {
                const bf16x8 a0 = *(const bf16x8*)(Ks + r32 * KP + (16 * ks + 8 * hi) * 2), a1 = *(const bf16x8*)(Ks + (32 + r32) * KP + (16 * ks + 8 * hi) * 2);
                p0 = __builtin_amdgcn_mfma_f32_32x32x16_bf16(a0, qf[ks], p0, 0, 0, 0); p1 = __builtin_amdgcn_mfma_f32_32x32x16_bf16(a1, qf[ks], p1, 0, 0, 0); }
            const bool diag = (k0 + 63 >= qlo);
            bool skip_pv = false;
            if (MODE == 0) {
#pragma unroll
                for (int g = 0; g < 4; ++g) { const f32x4 c0 = *(const f32x4*)(cs + 8 * g + 4 * hi), c1 = *(const f32x4*)(cs + 32 + 8 * g + 4 * hi);
#pragma unroll
                    for (int i = 0; i < 4; ++i) { p0[4 * g + i] = __builtin_fmaf(p0[4 * g + i], scale, cq - c0[i]); p1[4 * g + i] = __builtin_fmaf(p1[4 * g + i], scale, cq - c1[i]); } }
                if (diag) {
#pragma unroll
                    for (int r = 0; r < 16; ++r) { const int kv = k0 + crow_(r, hi); if (kv > qrow) p0[r] = -INFINITY; if (kv + 32 > qrow) p1[r] = -INFINITY; }
                }
                float tmax = fmaxf(p0[0], p1[0]);
#pragma unroll
                for (int r = 1; r < 16; ++r) tmax = fmaxf(tmax, fmaxf(p0[r], p1[r]));
                tmax = fmaxf(tmax, __shfl_xor(tmax, 32));
                skip_pv = __all(tmax < m_run - 40.0f);
                if (!skip_pv) {
                    const float mnew = fmaxf(m_run, tmax); const float mref = (mnew == -INFINITY) ? 0.f : mnew; const float alpha = __builtin_amdgcn_exp2f(m_run - mref); m_run = mnew;
                    float ps = 0.f;
#pragma unroll
                    for (int r = 0; r < 16; ++r) { p0[r] = __builtin_amdgcn_exp2f(p0[r] - mref); p1[r] = __builtin_amdgcn_exp2f(p1[r] - mref); ps += p0[r] + p1[r]; }
                    l_part = l_part * alpha + ps;
                    o0 = o0 * alpha; o1 = o1 * alpha;
                }
            } else {
                float G[8]; f32x16 l0, l1;
#pragma unroll
                for (int r = 0; r < 16; ++r) { l0[r] = p0[r] * scale; l1[r] = p1[r] * scale; p0[r] = logsigmoidf_(l0[r]); p1[r] = logsigmoidf_(l1[r]);
                    const int kv = k0 + crow_(r, hi); l0[r] = (kv < qrow) ? p0[r] - l0[r] : 0.f; l1[r] = (kv + 32 < qrow) ? p1[r] - l1[r] : 0.f; }
#pragma unroll
                for (int g = 0; g < 4; ++g) { G[g] = (l0[4 * g] + l0[4 * g + 1]) + (l0[4 * g + 2] + l0[4 * g + 3]); G[4 + g] = (l1[4 * g] + l1[4 * g + 1]) + (l1[4 * g + 2] + l1[4 * g + 3]); }
                float suffix = Rtot;
#pragma unroll
                for (int th = 1; th >= 0; --th)
#pragma unroll
                    for (int g = 3; g >= 0; --g) { const float mine = G[th * 4 + g]; const float other = __shfl_xor(mine, 32);
                        float run = suffix + (hi == 0 ? other : 0.f);
#pragma unroll
                        for (int i = 3; i >= 0; --i) { const int r = 4 * g + i; const bool valid = (k0 + 32 * th + crow_(r, hi)) < qrow;
                            const float lsg = th ? p1[r] : p0[r]; const float lrr = th ? l1[r] : l0[r];
                            const float att = valid ? __expf(lsg + run) : 0.f; run += lrr; if (th) p1[r] = att; else p0[r] = att; }
                        suffix += mine + other; }
                Rtot = suffix;
            }
            if (!skip_pv) {
            bf16x8 pf[4];
#pragma unroll
            for (int s = 0; s < 4; ++s) { u32x4 w;
                if (s < 2) { const int b8 = 8 * s; w.x = pg8::cvt_pk_bf16(p0[b8], p0[b8 + 1]); w.y = pg8::cvt_pk_bf16(p0[b8 + 2], p0[b8 + 3]); w.z = pg8::cvt_pk_bf16(p0[b8 + 4], p0[b8 + 5]); w.w = pg8::cvt_pk_bf16(p0[b8 + 6], p0[b8 + 7]); }
                else { const int b8 = 8 * (s - 2); w.x = pg8::cvt_pk_bf16(p1[b8], p1[b8 + 1]); w.y = pg8::cvt_pk_bf16(p1[b8 + 2], p1[b8 + 3]); w.z = pg8::cvt_pk_bf16(p1[b8 + 4], p1[b8 + 5]); w.w = pg8::cvt_pk_bf16(p1[b8 + 6], p1[b8 + 7]); }
                pf[s] = __builtin_bit_cast(bf16x8, w); }
#pragma unroll
            for (int s = 0; s < 4; ++s) {
                const bf16x8 v0 = *(const bf16x8*)(Vts + r32 * VP + (16 * s + 8 * hi) * 2), v1 = *(const bf16x8*)(Vts + (32 + r32) * VP + (16 * s + 8 * hi) * 2);
                o0 = __builtin_amdgcn_mfma_f32_32x32x16_bf16(v0, pf[s], o0, 0, 0, 0); o1 = __builtin_amdgcn_mfma_f32_32x32x16_bf16(v1, pf[s], o1, 0, 0, 0); }
            }
        }
        bool done = false;
        if (MODE == 1) done = Rtot < -105.0f;
        else if (t > 0) {
            const float bnd = qs * pmx[t - 1] + (cq - pmx[64 + t]); done = bnd < m_run - 40.0f; }
        { const int wall = __all(done) ? 1 : 0; wdone = wall != 0; if (lane == 0) vt[(it_ & 1) * 8 + wave] = wall;
          BAR_LGKM();
          const int* vv = vt + (it_ & 1) * 8; const int all8 = (vv[0] & vv[1]) & (vv[2] & vv[3]) & (vv[4] & vv[5]) & (vv[6] & vv[7]);
          if (all8) { leave = true; break; } }
        t += dt_;
    }
    }
    float inv = 1.0f;
    if (MODE == 0) { float lt = l_part; lt += __shfl_xor(lt, 32); inv = 1.0f / lt; }
#pragma unroll
    for (int g = 0; g < 4; ++g) {
        u32x2 w0, w1; w0.x = pg8::cvt_pk_bf16(o0[4 * g] * inv, o0[4 * g + 1] * inv); w0.y = pg8::cvt_pk_bf16(o0[4 * g + 2] * inv, o0[4 * g + 3] * inv);
        w1.x = pg8::cvt_pk_bf16(o1[4 * g] * inv, o1[4 * g + 1] * inv); w1.y = pg8::cvt_pk_bf16(o1[4 * g + 2] * inv, o1[4 * g + 3] * inv);
        if (store) { *(u32x2*)(Og + (size_t)qrow * pitch + 8 * g + 4 * hi) = w0; *(u32x2*)(Og + (size_t)qrow * pitch + 32 + 8 * g + 4 * hi) = w1; } }
    __syncthreads();
#undef A64_ISSUE
#undef A64_STORE
}

#define GAS __attribute__((address_space(1)))
#define LAS __attribute__((address_space(3)))
#define RLX_AGENT __ATOMIC_RELAXED, __HIP_MEMORY_SCOPE_AGENT
#define XB_TMO      128
#define XB_XCNT(j)  (256  + 64 * (j))
#define XB_XSUB(j)  (1280 + 64 * (j))
#define XB_XGEN(j)  (2304 + 64 * (j))
#define XB_TOP      3328
#define XB_TOPGEN   3392
#define XCD_BAR_WORDS 3456
#define XB_SPIN_CAP (1u << 18)

__device__ __forceinline__ unsigned xb_ld(unsigned* p)              { return __hip_atomic_load(p, __ATOMIC_RELAXED, __HIP_MEMORY_SCOPE_AGENT); }
__device__ __forceinline__ unsigned xb_add(unsigned* p, unsigned v) { return __hip_atomic_fetch_add(p, v, __ATOMIC_RELAXED, __HIP_MEMORY_SCOPE_AGENT); }
__device__ __forceinline__ unsigned xb_xcc_id() { return (unsigned)__builtin_amdgcn_s_getreg((3 << 11) | 20) & 0xFu; }
#define XB_SPIN(cond, bar) do { unsigned _sp = 0; while (cond) { __builtin_amdgcn_s_sleep(1); \
    if ((++_sp & 255u) == 0u) { if (xb_ld(&(bar)[XB_TMO])) break; if (_sp > XB_SPIN_CAP) { atomicAdd(&(bar)[XB_TMO], 1u); break; } } } } while (0)

struct XcdBarrier {
    unsigned* bar; unsigned x;
    volatile LAS unsigned* st;
};

__device__ __forceinline__ XcdBarrier xcd_barrier_post(unsigned* bar, volatile LAS unsigned* st) {
    XcdBarrier b; b.bar = bar; b.x = xb_xcc_id(); b.st = st;
    if (threadIdx.x == 0) (void)xb_add(&bar[XB_XCNT(b.x)], 1u);
    return b;
}
__device__ __forceinline__ void xcd_barrier_complete(unsigned* bar, unsigned x, unsigned& nloc, unsigned& nx) {
    const unsigned G = gridDim.x * gridDim.y * gridDim.z;
    unsigned sum, cnt, mine, sp = 0u;
    for (;;) {
        sum = 0u; cnt = 0u; mine = 0u;
#pragma unroll
        for (unsigned j = 0; j < 16; ++j) { const unsigned c = xb_ld(&bar[XB_XCNT(j)]); sum += c; cnt += (c > 0u) ? 1u : 0u; mine = (j == x) ? c : mine; }
        if (sum == G) break;
        __builtin_amdgcn_s_sleep(1);
        if ((++sp & 255u) == 0u) { if (xb_ld(&bar[XB_TMO])) break; if (sp > XB_SPIN_CAP) { atomicAdd(&bar[XB_TMO], 1u); break; } }
    }
    nloc = mine > 0u ? mine : 1u; nx = cnt > 0u ? cnt : 1u;
}

__device__ __forceinline__ void xcd_barrier(const XcdBarrier& b) {
    asm volatile("s_waitcnt vmcnt(0)" ::: "memory");
    __syncthreads();
    if (threadIdx.x == 0) {
        unsigned* bar = b.bar;
        __builtin_amdgcn_s_waitcnt(0);
        unsigned nloc = b.st[0], nx = b.st[1];
        if (nloc == 0u) { xcd_barrier_complete(bar, b.x, nloc, nx); b.st[0] = nloc; b.st[1] = nx; }
        const unsigned old = xb_add(&bar[XB_XSUB(b.x)], 1u);
        const unsigned gen = old / nloc;
        if (old + 1u == (gen + 1u) * nloc) {
            __builtin_amdgcn_fence(__ATOMIC_RELEASE, "agent");
            asm volatile("s_waitcnt vmcnt(0)" ::: "memory");
            const unsigned og = xb_add(&bar[XB_TOP], 1u);
            const unsigned tg = og / nx;
            if (og + 1u == (tg + 1u) * nx) xb_add(&bar[XB_TOPGEN], 1u);
            else XB_SPIN(xb_ld(&bar[XB_TOPGEN]) == tg, bar);
            __builtin_amdgcn_fence(__ATOMIC_ACQUIRE, "agent");
            xb_add(&bar[XB_XGEN(b.x)], 1u);
            asm volatile("s_waitcnt vmcnt(0)" ::: "memory");
        } else {
            XB_SPIN(xb_ld(&bar[XB_XGEN(b.x)]) == gen, bar);
            __builtin_amdgcn_fence(__ATOMIC_ACQUIRE, "agent");
            asm volatile("s_waitcnt vmcnt(0)" ::: "memory");
        }
    }
    __syncthreads();
}

__global__ void __launch_bounds__(NTHREADS, 2) fwd_megakernel(Params p) {
    extern __shared__ __attribute__((aligned(16))) unsigned char lds[];
    cg::grid_group grid = cg::this_grid();
    __shared__ int s_unit;
    __shared__ unsigned s_bst[2];
    if (threadIdx.x < 2) s_bst[threadIdx.x] = 0u;
    __syncthreads();
    (void)xcd_barrier_post((unsigned*)(p.ws + WS_CTL) + 4096, (volatile LAS unsigned*)s_bst);
#define FRESH() const int tid = fresh_tid(), lane = tid & 63, wave = __builtin_amdgcn_readfirstlane(tid >> 6); const int bx = fresh_s((int)blockIdx.x), G = fresh_s((int)gridDim.x); \
    const int gw = bx * NWAVES + wave, ngw = G * NWAVES; unsigned char* ws = p.ws; PG8_LAS unsigned char* ldsl = (PG8_LAS unsigned char*)lds; \
    bf16_t* R1 = (bf16_t*)(ws + WS_R1); bf16_t* R2 = (bf16_t*)(ws + WS_R2); bf16_t* R3 = (bf16_t*)p.out; bf16_t* XB = (bf16_t*)(ws + WS_R3); bf16_t* MEMN = (bf16_t*)(ws + WS_MEMN); bf16_t* MKV = (bf16_t*)(ws + WS_MKV); float* xres = p.out; \
    (void)tid; (void)lane; (void)wave; (void)gw; (void)ngw; (void)ldsl; (void)R1; (void)R2; (void)R3; (void)XB; (void)MEMN; (void)MKV; (void)xres; (void)bx; (void)G;
#define NOSEG 1 << 30, 0, 1 << 30, 0
#ifdef PROBE_DUP_SYNC
#define GSYNC() do { xcd_barrier(xbar); xcd_barrier(xbar); } while (0)
#else
#define GSYNC() do { XcdBarrier xb_; xb_.bar = (unsigned*)(p.ws + WS_CTL) + 4096; xb_.x = xb_xcc_id(); xb_.st = (volatile LAS unsigned*)s_bst; xcd_barrier(xb_); } while (0)
#endif
#ifdef PROBE_DUP_GEMM
#define GEMM_REP for (int rep_ = 0; rep_ < 2; ++rep_)
#else
#define GEMM_REP
#endif
#ifdef PROBE_DUP_NORM
#define NORM_DRY(...) norm_rows(__VA_ARGS__)
#else
#define NORM_DRY(...)
#endif

    { FRESH();
#ifdef PROBE_DUP_CONV
      convert_weights(p, 0, lds, gw, ngw, lane, wave);
#endif
      convert_weights(p, 0, lds, gw, ngw, lane, wave);
      norm_rows<false, false>(gw, ngw, lane, MEMR, p.in[1], nullptr, nullptr, nullptr, p.in[23], MEMN);
      norm_rows<false, true>(gw, ngw, lane, M, p.in[0], nullptr, nullptr, XB, p.in[2], R3); }
    if (p.pad[1] == 0x5eed) grid.sync();
    GSYNC();

    for (int l = 0; l < 2; ++l) {
        { FRESH(); pg8::Gemm g{R3, (const bf16_t*)(ws + WS_WIN), M, ZP, D, D, NOSEG}; pg8::StaticOrder S; S.init(M, ZP, G, bx);
          pg8::EpiBf16 E{R1, ZP, (float*)(ws + WS_FL), 3328};
          GEMM_REP pg8::gemm_phase<pg8::EpiBf16, pg8::StaticOrder, true, true>(ldsl, g, S, E); }
        { FRESH(); pg8::Gemm g{MEMN, (const bf16_t*)(ws + WS_WKV), MEMR, D, D, D, NOSEG}; pg8::StaticOrder S; S.init(MEMR, D, G, bx);
          pg8::EpiBf16 E{MKV, 2 * D, nullptr, 0};
          GEMM_REP pg8::gemm_phase<pg8::EpiBf16, pg8::StaticOrder, true, true>(ldsl, g, S, E); }
        { FRESH(); pg8::Gemm g{MEMN, (const bf16_t*)(ws + WS_WKV) + (size_t)D * D, MEMR, D, D, D, NOSEG}; pg8::StaticOrder S; S.init(MEMR, D, G, (bx + G - 64) % G);
          pg8::EpiVT E{(bf16_t*)p.out + (size_t)32 * 1024 * 1024};
          GEMM_REP pg8::gemm_phase<pg8::EpiVT, pg8::StaticOrder, true, true>(ldsl, g, S, E); }
        GSYNC();
#ifdef PROBE_DUP_PRE
        { FRESH(); rwkv_pre(p, l, gw, ngw, lane); }
#endif
        { FRESH(); rwkv_pre(p, l, gw, ngw, lane); }
        GSYNC();
        { FRESH(); const int Kl = l ? 640 : 256, Nl = l ? 1536 : 1280;
          pg8::Gemm g{R3, (const bf16_t*)(ws + WS_WLORA), M, Nl, Kl, Kl, NOSEG}; pg8::StaticOrder S; S.init(M, Nl, G, bx);
          pg8::EpiBf16 E{R2, Nl, nullptr, 0};
          GEMM_REP pg8::gemm_phase<pg8::EpiBf16, pg8::StaticOrder, true, true>(ldsl, g, S, E); }
        GSYNC();
#ifdef PROBE_DUP_PREP2
        { FRESH(); rwkv_prep2(p, l, gw, ngw, lane, lds, wave); }
#endif
        { FRESH(); rwkv_prep2(p, l, gw, ngw, lane, lds, wave); }
        GSYNC();
#ifdef PROBE_DUP_SCAN
        { FRESH(); if (bx < 96) scan_unit(p, l, bx, lds, tid, lane, wave, p.pad[0] != 0); }
#endif
        { FRESH(); if (bx < 96) scan_unit(p, l, bx, lds, tid, lane, wave, true); }
#ifdef PROBE_DUP_ATT
        { FRESH(); unsigned* ctl = (unsigned*)(ws + WS_CTL);
        for (;;) {
            if (tid == 0) s_unit = (int)atomicAdd(&ctl[64 * (3 + l)], 1u);
            __syncthreads();
            const int u = s_unit;
            __syncthreads();
            if (u >= 768 + 512) break;
            if (u < 768) { const int qb = 7 - u / 96, bh = u % 96, b = bh / 6, h = bh % 6;
                bf16_t* base = R1 + (size_t)b * T * ZP + 1408 + h * 64;
                attn64_unit<0>(lds, base, base + 384, base + 768, ZP, base, qb * 256, (const float*)(ws + WS_CBUF) + (size_t)bh * T, 0.125f * LOG2E, tid, lane, wave, p.pad[0] != 0, (const float*)(ws + 512 * 1024) + bh * 32);
            } else { const int u2 = u - 768; const int qb = 7 - u2 / 64, bh = u2 % 64, b = bh / 4, h = bh % 4;
                bf16_t* base = R1 + (size_t)b * T * ZP + 2560 + h * 64;
                attn64_unit<1>(lds, base, base + 256, base + 512, ZP, base, qb * 256, nullptr, 0.125f, tid, lane, wave, p.pad[0] != 0);
            }
        } }
#endif
        { FRESH(); unsigned* ctl = (unsigned*)(ws + WS_CTL);
        for (;;) {
            if (tid == 0) s_unit = (int)atomicAdd(&ctl[64 * (1 + l)], 1u);
            __syncthreads();
            const int u = s_unit;
            __syncthreads();
            if (u >= 768 + 512) break;
            if (u < 768) { const int qb = 7 - u / 96, bh = u % 96, b = bh / 6, h = bh % 6;
                bf16_t* base = R1 + (size_t)b * T * ZP + 1408 + h * 64;
                attn64_unit<0>(lds, base, base + 384, base + 768, ZP, base, qb * 256, (const float*)(ws + WS_CBUF) + (size_t)bh * T, 0.125f * LOG2E, tid, lane, wave, true, (const float*)(ws + 512 * 1024) + bh * 32);
            } else { const int u2 = u - 768; const int qb = 7 - u2 / 64, bh = u2 % 64, b = bh / 4, h = bh % 4;
                bf16_t* base = R1 + (size_t)b * T * ZP + 2560 + h * 64;
                attn64_unit<1>(lds, base, base + 256, base + 512, ZP, base, qb * 256, nullptr, 0.125f, tid, lane, wave, true);
            }
        } }
        GSYNC();
        { FRESH(); pg8::Gemm g{R1, (const bf16_t*)(ws + WS_WOUT), M, D, D, ZP, 6, 2048, 12, 1536}; pg8::StaticOrder S; S.init(M, D, G, bx);
          pg8::EpiBf16 E{R2, D, nullptr, 0};
          GEMM_REP pg8::gemm_phase<pg8::EpiBf16, pg8::StaticOrder, true, true>(ldsl, g, S, E); }
        GSYNC();
        { FRESH(); norm_rows<true, true>(gw, ngw, lane, M, XB, R2, p.in[3] + l * D, XB, p.in[21] + l * D, R3); }
        GSYNC();
        { FRESH(); pg8::Gemm g{R3, (const bf16_t*)(ws + WS_WQ), M, D, D, D, NOSEG}; pg8::StaticOrder S; S.init(M, D, G, bx);
          pg8::EpiBf16 E{R1, D, nullptr, 0};
          GEMM_REP pg8::gemm_phase<pg8::EpiBf16, pg8::StaticOrder, true, true>(ldsl, g, S, E); }
        GSYNC();
#ifdef PROBE_DUP_MEM
        { FRESH();
        for (int u = bx; u < 1024; u += G) { const int qb = u & 15, bh = u >> 4, b = bh >> 2, hh = bh & 3;
            bf16_t* qbase = R1 + (size_t)b * T * D + hh * 256; const bf16_t* kbase = MKV + (size_t)b * 256 * (2 * D) + hh * 256;
            attn_unit<256, 2>(lds, qbase, D, kbase, (const bf16_t*)p.out + (size_t)32 * 1024 * 1024 + (size_t)bh * 65536, 2 * D, qbase, qb * 128, 256, nullptr, 0.0625f * LOG2E, tid, lane, wave, p.pad[0] != 0); } }
#endif
        { FRESH();
        for (int u = bx; u < 1024; u += G) { const int qb = u & 15, bh = u >> 4, b = bh >> 2, hh = bh & 3;
            bf16_t* qbase = R1 + (size_t)b * T * D + hh * 256; const bf16_t* kbase = MKV + (size_t)b * 256 * (2 * D) + hh * 256;
            attn_unit<256, 2>(lds, qbase, D, kbase, (const bf16_t*)p.out + (size_t)32 * 1024 * 1024 + (size_t)bh * 65536, 2 * D, qbase, qb * 128, 256, nullptr, 0.0625f * LOG2E, tid, lane, wave, true); } }
        GSYNC();
        { FRESH(); pg8::Gemm g{R1, (const bf16_t*)(ws + WS_WO), M, D, D, D, NOSEG}; pg8::StaticOrder S; S.init(M, D, G, bx);
          pg8::EpiBf16 E{R2, D, nullptr, 0};
          GEMM_REP pg8::gemm_phase<pg8::EpiBf16, pg8::StaticOrder, true, true>(ldsl, g, S, E); }
        GSYNC();
        { FRESH(); norm_rows<true, true>(gw, ngw, lane, M, XB, R2, p.in[22] + l * D, XB, p.in[27] + l * D, R3); }
        GSYNC();
        { FRESH(); pg8::Gemm g{R3, (const bf16_t*)(ws + WS_WGU), M, 2 * DFF, D, D, NOSEG}; pg8::StaticOrder S; S.init(M, 2 * DFF, G, bx);
          pg8::EpiSwiGLU E{R1, DFF};
          GEMM_REP pg8::gemm_phase<pg8::EpiSwiGLU, pg8::StaticOrder, true, true>(ldsl, g, S, E); }
        GSYNC();
        { FRESH(); pg8::Gemm g{R1, (const bf16_t*)(ws + WS_WDN), M, D, DFF, DFF, NOSEG}; pg8::StaticOrder S; S.init(M, D, G, bx);
          pg8::EpiBf16 E{R2, D, nullptr, 0};
          GEMM_REP pg8::gemm_phase<pg8::EpiBf16, pg8::StaticOrder, true, true>(ldsl, g, S, E); }
        GSYNC();
        if (l == 0) {
            { FRESH(); norm_rows<true, true>(gw, ngw, lane, M, XB, R2, p.in[28], XB, p.in[2] + D, R3);
#ifdef PROBE_DUP_CONV
              convert_weights(p, 1, lds, gw, ngw, lane, wave);
#endif
              convert_weights(p, 1, lds, gw, ngw, lane, wave);
              norm_rows<false, false>(gw, ngw, lane, MEMR, p.in[1], nullptr, nullptr, nullptr, p.in[23] + D, MEMN); }
            GSYNC();
        } else {
            { FRESH(); norm_rows<true, false>(gw, ngw, lane, M, XB, R2, p.in[28] + D, xres, nullptr, nullptr); }
        }
    }
}

extern "C" void kernel_launch(void* const* d_in, const int* in_sizes, int n_in, void* d_out, int out_size, void* d_ws, size_t ws_size, hipStream_t stream) {
    static int grid_blocks = 0;
    if (grid_blocks == 0) {
        if (n_in != 31 || out_size != M * D || ws_size < WS_END) { fprintf(stderr, "kernel_launch: unexpected shapes (n_in %d out %d ws %zu)\n", n_in, out_size, ws_size); grid_blocks = -1; return; }
        int dev = 0, cus = 0, per_cu = 0;
        hipGetDevice(&dev); hipDeviceGetAttribute(&cus, hipDeviceAttributeMultiprocessorCount, dev);
        if (hipFuncSetAttribute((const void*)fwd_megakernel, hipFuncAttributeMaxDynamicSharedMemorySize, LDS_BYTES) != hipSuccess) { fprintf(stderr, "kernel_launch: hipFuncSetAttribute failed\n"); grid_blocks = -1; return; }
        if (hipOccupancyMaxActiveBlocksPerMultiprocessor(&per_cu, (const void*)fwd_megakernel, NTHREADS, LDS_BYTES) != hipSuccess || per_cu < 1) { fprintf(stderr, "kernel_launch: occupancy query gave %d\n", per_cu); per_cu = 1; }
        (void)hipGetLastError();
        grid_blocks = cus * 1;
    }
    if (grid_blocks < 0) return;
    (void)hipMemsetAsync((char*)d_ws + WS_CTL, 0, 65536, stream);
    Params p{};
    for (int i = 0; i < 31; ++i) p.in[i] = (const float*)d_in[i];
    p.out = (float*)d_out; p.ws = (unsigned char*)d_ws;
    void* args[] = {&p};
    hipError_t e = hipLaunchCooperativeKernel((const void*)fwd_megakernel, dim3(grid_blocks), dim3(NTHREADS), args, LDS_BYTES, stream);
    if (e != hipSuccess) fprintf(stderr, "cooperative launch failed: %s (grid %d)\n", hipGetErrorString(e), grid_blocks);
}
```
